# Optimizing an MI355X kernel written in HIP

```python
import math
import jax, jax.numpy as jnp
from jax import lax
import numpy as np

D_MODEL = 1024
BATCH = 16
SEQ = 4096
DEPTH = 2
DEC_BATCH = 2
DEC_SEQ = 8192
PAST_LEN = 128

D_FF = 2816
MIX_WIDTH = D_MODEL
RG_WIDTH = D_MODEL // 4
RG_HEADS = 4
RG_BW = RG_WIDTH // RG_HEADS
RG_C = 8.0
CONV_W = 4
CONV_LEFT = 2
ATT_HEADS = 4
HEAD_DIM = D_MODEL // 16
ATT_WIDTH = ATT_HEADS * 2 * HEAD_DIM
F_WIDTH = MIX_WIDTH - RG_WIDTH - ATT_WIDTH
F_GROUPS = 4
F_GW = F_WIDTH // F_GROUPS
Q_BLOCK = 128
SPLITS = [RG_WIDTH, 2 * RG_WIDTH, 2 * RG_WIDTH + ATT_WIDTH, 2 * RG_WIDTH + 2 * ATT_WIDTH, 2 * RG_WIDTH + 3 * ATT_WIDTH]
V_OFF = 2 * RG_WIDTH + 2 * ATT_WIDTH
IN_WIDTH = 2 * RG_WIDTH + 3 * ATT_WIDTH + F_WIDTH
ALPHA = (2.0 * DEPTH) ** 0.25
BETA = (8.0 * DEPTH) ** -0.25
LN_EPS = 1e-5
NORM_EPS = 1e-5

kernel_name = 'hymba_rglru_diffattn_fnet_macaron_encoder'


def layer_norm(x, g, b):
    xf = x.astype(jnp.float32)
    mu = jnp.mean(xf, -1, keepdims=True)
    xc = xf - mu
    var = jnp.mean(xc * xc, -1, keepdims=True)
    return (xc * lax.rsqrt(var + LN_EPS) * g.astype(jnp.float32) + b.astype(jnp.float32)).astype(x.dtype)


def swiglu(x, wg, wu, wd):
    hg = jnp.einsum('bsd,df->bsf', x, wg)
    hu = jnp.einsum('bsd,df->bsf', x, wu)
    return jnp.einsum('bsf,fd->bsd', jax.nn.silu(hg) * hu, wd)


def centred_dwconv(x, w, b):
    S = x.shape[1]
    xp = jnp.pad(x, ((0, 0), (CONV_LEFT, CONV_W - 1 - CONV_LEFT), (0, 0)))
    y = b
    for j in range(CONV_W):
        y = y + xp[:, j:j + S, :] * w[j]
    return y


def linear_scan(a, u):
    def combine(left, right):
        a_l, u_l = left
        a_r, u_r = right
        return a_l * a_r, a_r * u_l + u_r
    _, h = lax.associative_scan(combine, (a, u), axis=1)
    return h


def rglru_direction(x, wa, ba, wx, bx, lam):
    B, S, _ = x.shape
    xh = x.reshape(B, S, RG_HEADS, RG_BW)
    r = jax.nn.sigmoid(jnp.einsum('bshi,hij->bshj', xh, wa.astype(jnp.float32)).reshape(B, S, RG_WIDTH) + ba.astype(jnp.float32))
    i = jax.nn.sigmoid(jnp.einsum('bshi,hij->bshj', xh, wx.astype(jnp.float32)).reshape(B, S, RG_WIDTH) + bx.astype(jnp.float32))
    log_a = -RG_C * jax.nn.softplus(-lam.astype(jnp.float32)) * r
    a = jnp.exp(log_a)
    mult = jnp.sqrt(-jnp.expm1(2.0 * log_a))
    return linear_scan(a, mult * (i * x))


def bidir_rglru(x, wa, ba, wx, bx, lam):
    fwd = rglru_direction(x, wa[0], ba[0], wx[0], bx[0], lam[0])
    bwd = jnp.flip(rglru_direction(jnp.flip(x, 1), wa[1], ba[1], wx[1], bx[1], lam[1]), 1)
    return fwd + bwd


def diff_attention(q, k, v, lam, subln_g, lam_init):
    B, S = q.shape[0], q.shape[1]
    nb = S // Q_BLOCK
    slopes = 2.0 ** (-8.0 * jnp.arange(1, ATT_HEADS + 1, dtype=jnp.float32) / ATT_HEADS)
    scale = HEAD_DIM ** -0.5
    pos_k = jnp.arange(S, dtype=jnp.int32)
    qb = jnp.moveaxis(q.reshape(B, nb, Q_BLOCK, ATT_HEADS, 2, HEAD_DIM), 1, 0)
    starts = jnp.arange(nb, dtype=jnp.int32) * Q_BLOCK

    def block(args):
        qi, start = args
        pos_q = start + jnp.arange(Q_BLOCK, dtype=jnp.int32)
        dist = jnp.abs(pos_q[:, None] - pos_k[None, :]).astype(jnp.float32)
        bias = -slopes[:, None, None] * dist
        s = jnp.einsum('bqhcd,bkhcd->bhcqk', qi, k, preferred_element_type=jnp.float32) * scale + bias[None, :, None]
        p = jax.nn.softmax(s, axis=-1)
        w = p[:, :, 0] - lam * p[:, :, 1]
        return jnp.einsum('bhqk,bkhe->bqhe', w.astype(v.dtype), v, preferred_element_type=jnp.float32)

    o = lax.map(block, (qb, starts))
    o = jnp.moveaxis(o, 0, 1).reshape(B, S, ATT_HEADS, 2 * HEAD_DIM)
    o = o * lax.rsqrt(jnp.mean(o * o, -1, keepdims=True) + NORM_EPS) * subln_g.astype(jnp.float32) * (1.0 - lam_init)
    return o.reshape(B, S, ATT_WIDTH)


def fourier_mix(f):
    B, S, _ = f.shape
    fg = f.astype(jnp.float32).reshape(B, S, F_GROUPS, F_GW)
    out = jnp.fft.fft2(fg, axes=(1, 3), norm='ortho').real
    return out.reshape(B, S, F_WIDTH)


def hybrid_mixer(h, w_in, conv_w, conv_b, rg_wa, rg_ba, rg_wx, rg_bx, rg_lambda, lambda_qk, subln_g, w_out, lam_init):
    B, S, _ = h.shape
    proj = jnp.einsum('bsd,de->bse', h, w_in)
    rx, rgate, q, k, v, fx = jnp.split(proj, SPLITS, axis=-1)
    xc = centred_dwconv(rx, conv_w, conv_b).astype(jnp.float32)
    out_a = jax.nn.gelu(rgate.astype(jnp.float32)) * bidir_rglru(xc, rg_wa, rg_ba, rg_wx, rg_bx, rg_lambda)
    lq = lambda_qk.astype(jnp.float32)
    lam = jnp.exp(jnp.sum(lq[0] * lq[1])) - jnp.exp(jnp.sum(lq[2] * lq[3])) + lam_init
    out_b = diff_attention(q.reshape(B, S, ATT_HEADS, 2, HEAD_DIM), k.reshape(B, S, ATT_HEADS, 2, HEAD_DIM),
                           v.reshape(B, S, ATT_HEADS, 2 * HEAD_DIM), lam, subln_g, lam_init)
    out_c = fourier_mix(fx)
    y = jnp.concatenate([out_a, out_b, out_c], axis=-1).astype(h.dtype)
    return jnp.einsum('bse,ed->bsd', y, w_out)


def encoder_trunk(x, ln_g, ln_b, ffn1_wg, ffn1_wu, ffn1_wd, ffn2_wg, ffn2_wu, ffn2_wd, w_in, conv_w, conv_b,
                  rg_wa, rg_ba, rg_wx, rg_bx, rg_lambda, lambda_qk, subln_g, w_out):
    for l in range(DEPTH):
        lam_init = 0.8 - 0.6 * math.exp(-0.3 * l)
        x = layer_norm(ALPHA * x + 0.5 * swiglu(x, ffn1_wg[l], ffn1_wu[l], ffn1_wd[l]), ln_g[l, 0], ln_b[l, 0])
        x = layer_norm(ALPHA * x + hybrid_mixer(x, w_in[l], conv_w[l], conv_b[l], rg_wa[l], rg_ba[l], rg_wx[l], rg_bx[l],
                                                rg_lambda[l], lambda_qk[l], subln_g[l], w_out[l], lam_init),
                       ln_g[l, 1], ln_b[l, 1])
        x = layer_norm(ALPHA * x + 0.5 * swiglu(x, ffn2_wg[l], ffn2_wu[l], ffn2_wd[l]), ln_g[l, 2], ln_b[l, 2])
    return x


def setup_inputs(seed: int = 0) -> dict:
    key = jax.random.key(seed)
    ks = jax.random.split(key, 24)
    f32 = jnp.float32

    def nrm(k, shape, scale):
        return jax.random.normal(k, shape, f32) * scale

    x_prompt = nrm(ks[0], (BATCH, SEQ, D_MODEL), 1.0)
    x_sample = nrm(ks[1], (DEC_BATCH, DEC_SEQ, D_MODEL), 1.0)
    ln_g = 1.0 + nrm(ks[2], (DEPTH, 3, D_MODEL), 0.02)
    ln_b = nrm(ks[3], (DEPTH, 3, D_MODEL), 0.02)
    ffn1_wg = nrm(ks[4], (DEPTH, D_MODEL, D_FF), D_MODEL ** -0.5)
    ffn1_wu = nrm(ks[5], (DEPTH, D_MODEL, D_FF), D_MODEL ** -0.5)
    ffn1_wd = nrm(ks[6], (DEPTH, D_FF, D_MODEL), D_FF ** -0.5 * BETA)
    ffn2_wg = nrm(ks[7], (DEPTH, D_MODEL, D_FF), D_MODEL ** -0.5)
    ffn2_wu = nrm(ks[8], (DEPTH, D_MODEL, D_FF), D_MODEL ** -0.5)
    ffn2_wd = nrm(ks[9], (DEPTH, D_FF, D_MODEL), D_FF ** -0.5 * BETA)
    col_scale = jnp.ones((IN_WIDTH,), f32).at[V_OFF:V_OFF + ATT_WIDTH].set(BETA)
    w_in = nrm(ks[10], (DEPTH, D_MODEL, IN_WIDTH), D_MODEL ** -0.5) * col_scale
    conv_w = nrm(ks[11], (DEPTH, CONV_W, RG_WIDTH), CONV_W ** -0.5)
    conv_b = nrm(ks[12], (DEPTH, RG_WIDTH), 0.01)
    rg_wa = nrm(ks[13], (DEPTH, 2, RG_HEADS, RG_BW, RG_BW), RG_BW ** -0.5)
    rg_ba = nrm(ks[14], (DEPTH, 2, RG_WIDTH), 0.01)
    rg_wx = nrm(ks[15], (DEPTH, 2, RG_HEADS, RG_BW, RG_BW), RG_BW ** -0.5)
    rg_bx = nrm(ks[16], (DEPTH, 2, RG_WIDTH), 0.01)
    a_target = jax.random.uniform(ks[17], (DEPTH, 2, RG_WIDTH), f32, minval=0.9, maxval=0.999)
    base = a_target ** (1.0 / RG_C)
    rg_lambda = jnp.log(base) - jnp.log1p(-base)
    lambda_qk = nrm(ks[18], (DEPTH, 4, HEAD_DIM), 0.1)
    subln_g = 1.0 + nrm(ks[19], (DEPTH, 2 * HEAD_DIM), 0.02)
    w_out = nrm(ks[20], (DEPTH, MIX_WIDTH, D_MODEL), MIX_WIDTH ** -0.5 * BETA)
    return {'x_prompt': x_prompt, 'x_sample': x_sample, 'ln_g': ln_g, 'ln_b': ln_b,
            'ffn1_wg': ffn1_wg, 'ffn1_wu': ffn1_wu, 'ffn1_wd': ffn1_wd,
            'ffn2_wg': ffn2_wg, 'ffn2_wu': ffn2_wu, 'ffn2_wd': ffn2_wd,
            'w_in': w_in, 'conv_w': conv_w, 'conv_b': conv_b,
            'rg_wa': rg_wa, 'rg_ba': rg_ba, 'rg_wx': rg_wx, 'rg_bx': rg_bx, 'rg_lambda': rg_lambda,
            'lambda_qk': lambda_qk, 'subln_g': subln_g, 'w_out': w_out}


def reference(x_prompt, x_sample, ln_g, ln_b, ffn1_wg, ffn1_wu, ffn1_wd, ffn2_wg, ffn2_wu, ffn2_wd, w_in, conv_w, conv_b,
              rg_wa, rg_ba, rg_wx, rg_bx, rg_lambda, lambda_qk, subln_g, w_out):
    y_prompt = encoder_trunk(x_prompt, ln_g, ln_b, ffn1_wg, ffn1_wu, ffn1_wd, ffn2_wg, ffn2_wu, ffn2_wd, w_in, conv_w, conv_b,
                             rg_wa, rg_ba, rg_wx, rg_bx, rg_lambda, lambda_qk, subln_g, w_out)
    y_sample = encoder_trunk(x_sample, ln_g, ln_b, ffn1_wg, ffn1_wu, ffn1_wd, ffn2_wg, ffn2_wu, ffn2_wd, w_in, conv_w, conv_b,
                             rg_wa, rg_ba, rg_wx, rg_bx, rg_lambda, lambda_qk, subln_g, w_out)
    return (y_prompt, y_sample)
```

```cpp
#include <hip/hip_runtime.h>
#include <hip/hip_cooperative_groups.h>
#include <hip/hip_bf16.h>
#include <cstdio>
#include <cstdint>
#include <cmath>
namespace cg = cooperative_groups;
namespace pg8 {
#define PG8_LAS __attribute__((address_space(3)))
typedef unsigned short bf16_t;
typedef short bf16x8 __attribute__((ext_vector_type(8)));
typedef float f32x4 __attribute__((ext_vector_type(4)));
typedef unsigned u32x4 __attribute__((ext_vector_type(4)));
constexpr int BM = 256, BK = 64, HALF = 128, HTB = HALF * BK * 2  , STAGE_BYTES = 8 * HTB, NXCD = 8, WGM = 8;

__host__ __device__ __forceinline__ int lds_byte(int r, int c) { const int st = (r >> 4) * 2 + (c >> 5), rr = r & 15, cc = c & 31, ob = rr * 64 + cc * 2; return st * 1024 + (ob ^ (((ob >> 9) & 1) << 5)); }
__host__ __device__ __forceinline__ void stage_rc(int b, int& R, int& C) { const int st = b / 1024, sb = b % 1024, swz = sb ^ (((sb >> 9) & 1) << 5); R = (st >> 1) * 16 + swz / 64; C = (st & 1) * 32 + (swz % 64) / 2; }
__host__ __device__ __forceinline__ int perm32(int rho) { const int n = rho >> 4, i = rho & 15; return 8 * (i >> 2) + 4 * n + (i & 3); }

struct Unit { int pm, pn, z; };
struct Gemm { const bf16_t* A; const bf16_t* Bt; int K, lda, ldb; size_t zA, zB; };

struct StaticOrder {
    int nM, nN, nwg, G, c;
    __host__ __device__ void init(int M, int N, int G_, int c_) { nM = M / BM; nN = N / BM; nwg = nM * nN; G = G_; c = c_; }
    __host__ __device__ bool next(int i, Unit& u) const {
        const long L = (long)i * G + c; if (L >= nwg) return false;
        int wgid = (int)L; { const int q = nwg / NXCD, r = nwg % NXCD, xcd = wgid % NXCD, off = wgid / NXCD; wgid = (xcd < r ? xcd * (q + 1) : r * (q + 1) + (xcd - r) * q) + off; }
        const int nig = WGM * nN, gid = wgid / nig, fm = gid * WGM, gsz = (nM - fm) < WGM ? (nM - fm) : WGM;
        u.pm = fm + ((wgid % nig) % gsz); u.pn = (wgid % nig) / gsz; u.z = 0; return true;
    }
    __device__ __forceinline__ void a_ready(const Unit&) const {}
    __device__ __forceinline__ void done(const Unit&) const {}
};

__device__ __forceinline__ unsigned cvt_pk_bf16(float lo, float hi) { unsigned r; asm volatile("v_cvt_pk_bf16_f32 %0, %1, %2" : "=v"(r) : "v"(lo), "v"(hi)); return r; }
typedef float f32x2 __attribute__((ext_vector_type(2)));
__device__ __forceinline__ f32x2 gelu_pk(f32x2 v) {
    const f32x2 av = __builtin_elementwise_abs(v), d = av * 0.2316418882f + 1.0f;
    f32x2 t; t.x = __builtin_amdgcn_rcpf(d.x); t.y = __builtin_amdgcn_rcpf(d.y);
    f32x2 q = t * 0.5307027145f + (-0.7265760135f); q = q * t + 0.7107068705f; q = q * t + (-0.142248368f); q = q * t + 0.127414796f; q = q * t;
    const f32x2 s = (v * v) * (-0.72134752044f);
    f32x2 e; e.x = __builtin_amdgcn_exp2f(s.x); e.y = __builtin_amdgcn_exp2f(s.y);
    const f32x2 m = v * (q * e), r = v - m;
    f32x2 o; o.x = v.x < 0.f ? m.x : r.x; o.y = v.y < 0.f ? m.y : r.y; return o;
}

template <int ACT  > struct EpiBf16 {
    static constexpr bool PERM = true, AFTER_DRAIN = false; static_assert(ACT == 0 || ACT == 1, "EpiBf16: ACT is 0 (none) or 1 (gelu_pk)");
    bf16_t* O; int ldc; const float* bias; int split_cols; size_t split_stride; float scale0;
    __device__ __forceinline__ void operator()(const f32x4 (&acc)[2][2][4][2], const Unit& u, int wr, int wc, int fr, int fq) const {
        const int row0 = u.pm * BM + wr * 64 + fr; int colt = u.pn * BM; bf16_t* base = O;
        float sc = 1.f; if (split_cols) { const int t = colt / split_cols; base += (size_t)t * split_stride; colt -= t * split_cols; if (t == 0) sc = scale0; }
        const int col0 = colt + wc * 32 + 8 * fq, bcol0 = u.pn * BM + wc * 32 + 8 * fq;
        f32x4 bv[2][2];
#pragma unroll
        for (int bj = 0; bj < 2; ++bj)
#pragma unroll
            for (int n = 0; n < 2; ++n) bv[bj][n] = bias ? *(const f32x4*)(bias + bcol0 + bj * HALF + 4 * n) : (f32x4){0.f, 0.f, 0.f, 0.f};
#pragma unroll
        for (int ai = 0; ai < 2; ++ai)
#pragma unroll
            for (int m = 0; m < 4; ++m) { bf16_t* rowp = base + (size_t)(row0 + ai * HALF + m * 16) * ldc + col0;
#pragma unroll
                for (int bj = 0; bj < 2; ++bj) { f32x4 v0 = acc[ai][bj][m][0] + bv[bj][0], v1 = acc[ai][bj][m][1] + bv[bj][1];
                    if (ACT == 1) { f32x2 a = gelu_pk((f32x2){v0[0], v0[1]}), b = gelu_pk((f32x2){v0[2], v0[3]}), c = gelu_pk((f32x2){v1[0], v1[1]}), d = gelu_pk((f32x2){v1[2], v1[3]});
                        v0 = (f32x4){a.x, a.y, b.x, b.y}; v1 = (f32x4){c.x, c.y, d.x, d.y}; }
                    v0 = v0 * sc; v1 = v1 * sc; u32x4 w; w.x = cvt_pk_bf16(v0[0], v0[1]); w.y = cvt_pk_bf16(v0[2], v0[3]); w.z = cvt_pk_bf16(v1[0], v1[1]); w.w = cvt_pk_bf16(v1[2], v1[3]);
                    *(u32x4*)(rowp + bj * HALF) = w; } }
    }
};

template <class Epi, class Sched, bool ALIGN_EPI, bool SP2, int KK, int LDA, int LDB>
__device__ __forceinline__ void gemm_phase(PG8_LAS unsigned char* lds, const Gemm g, const Sched& S, const Epi& E) {
    int tid_ = threadIdx.x; asm volatile("" : "+v"(tid_));
    const int tid = tid_, wid = __builtin_amdgcn_readfirstlane(tid >> 6), lane = tid & 63, wr = wid >> 2, wc = wid & 3, fr = lane & 15, fq = lane >> 4;
    constexpr int K = KK, nt = K / BK;
    unsigned voffA[2], voffB[2];
#pragma unroll
    for (int i = 0; i < 2; ++i) { int R, C; stage_rc(tid * 16 + i * 8192, R, C); const int Rb = Epi::PERM ? ((R & ~31) + perm32(R & 31)) : R;
        voffA[i] = (unsigned)(R * LDA + C) * 2u; voffB[i] = (unsigned)(Rb * LDB + C) * 2u; }
    constexpr size_t kstep = (size_t)(BK * 2);
    constexpr size_t hstepA = (size_t)HALF * LDA * 2, hstepB = (size_t)HALF * LDB * 2;
    constexpr size_t tstepA = 2 * hstepA, tstepB = 2 * hstepB;
    const unsigned ldsw = (unsigned)wid * 1024u;
    const int aoff = lds_byte(wr * 64 + fr, fq * 8), boff = lds_byte(wc * 32 + fr, fq * 8);
#define PG8_SA(b, h) (((b) * 2 + (h)) * HTB)
#define PG8_SB(b, h) ((4 + (b) * 2 + (h)) * HTB)
#define PG8_STAGE(bufoff, gbase, voff) do { _Pragma("unroll") for (int _i = 0; _i < 2; ++_i) \
        __builtin_amdgcn_global_load_lds((const unsigned*)((const char*)(gbase) + (voff)[_i]), (PG8_LAS unsigned*)(lds + (bufoff) + ldsw + _i * 8192), 16, 0, 0); } while (0)
#define PG8_LDA(dst, b, h) do { _Pragma("unroll") for (int m = 0; m < 4; ++m) _Pragma("unroll") for (int k = 0; k < 2; ++k) dst[m][k] = *(const PG8_LAS bf16x8*)(lds + PG8_SA(b, h) + aoff + m * 2048 + k * 1024); } while (0)
#define PG8_LDB(dst, b, h) do { _Pragma("unroll") for (int n = 0; n < 2; ++n) _Pragma("unroll") for (int k = 0; k < 2; ++k) dst[n][k] = *(const PG8_LAS bf16x8*)(lds + PG8_SB(b, h) + boff + n * 2048 + k * 1024); } while (0)
#define PG8_MMA(ai, bj, At, Bt) do { __builtin_amdgcn_s_setprio(1); _Pragma("unroll") for (int m = 0; m < 4; ++m) _Pragma("unroll") for (int n = 0; n < 2; ++n) _Pragma("unroll") for (int k = 0; k < 2; ++k) \
        acc[ai][bj][m][n] = __builtin_amdgcn_mfma_f32_16x16x32_bf16(Bt[n][k], At[m][k], acc[ai][bj][m][n], 0, 0, 0); __builtin_amdgcn_s_setprio(0); } while (0)
#define PG8_WAIT_V(n) asm volatile("s_waitcnt vmcnt(" #n ")" ::: "memory")
#define PG8_WAIT_L(n) asm volatile("s_waitcnt lgkmcnt(" #n ")" ::: "memory")
#define PG8_BAR __builtin_amdgcn_s_barrier()
#define PG8_SCHED __builtin_amdgcn_sched_barrier(0)
    Unit cur, nxt; int ui = 0;
    if (!S.next(0, cur)) return;
    f32x4 acc[2][2][4][2];
#pragma unroll
    for (int a = 0; a < 2; ++a)
#pragma unroll
        for (int b = 0; b < 2; ++b)
#pragma unroll
            for (int m = 0; m < 4; ++m)
#pragma unroll
                for (int n = 0; n < 2; ++n) acc[a][b][m][n] = (f32x4){0.f, 0.f, 0.f, 0.f};
    bf16x8 At[4][2], B0[2][2], B1[2][2];
    const char* cA = (const char*)g.A + (size_t)cur.z * g.zA * 2 + (size_t)cur.pm * tstepA; const char* cB = (const char*)g.Bt + (size_t)cur.z * g.zB * 2 + (size_t)cur.pn * tstepB;
    S.a_ready(cur);
    if constexpr (SP2) {
        PG8_STAGE(PG8_SB(0, 0), cB, voffB); PG8_STAGE(PG8_SB(0, 1), cB + hstepB, voffB); PG8_STAGE(PG8_SA(0, 0), cA, voffA); PG8_STAGE(PG8_SA(0, 1), cA + hstepA, voffA);
        if (wr == 1) PG8_BAR;
        PG8_WAIT_V(2); PG8_BAR;
        PG8_STAGE(PG8_SB(1, 0), cB + kstep, voffB); PG8_STAGE(PG8_SA(1, 0), cA + kstep, voffA); PG8_STAGE(PG8_SB(1, 1), cB + hstepB + kstep, voffB);
        PG8_WAIT_V(6); PG8_BAR;
    } else {
        PG8_STAGE(PG8_SB(0, 0), cB, voffB); PG8_STAGE(PG8_SA(0, 0), cA, voffA); PG8_STAGE(PG8_SB(0, 1), cB + hstepB, voffB); PG8_STAGE(PG8_SA(0, 1), cA + hstepA, voffA);
        if (wr == 1) PG8_BAR;
        PG8_WAIT_V(4); PG8_BAR;
        PG8_STAGE(PG8_SB(1, 0), cB + kstep, voffB); PG8_STAGE(PG8_SA(1, 0), cA + kstep, voffA); PG8_STAGE(PG8_SB(1, 1), cB + hstepB + kstep, voffB);
        PG8_WAIT_V(6); PG8_BAR;
    }
    for (;;) {
        const bool has_next = S.next(ui + 1, nxt);
        const char* nA = has_next ? (const char*)g.A + (size_t)nxt.z * g.zA * 2 + (size_t)nxt.pm * tstepA : cA; const char* nB = has_next ? (const char*)g.Bt + (size_t)nxt.z * g.zB * 2 + (size_t)nxt.pn * tstepB : cB;
        for (int t = 0; t < nt; t += 2) {
            const bool last = (t == nt - 2);
            const char* a1 = cA + (size_t)(t + 1) * kstep;
            const char* a2 = last ? nA : cA + (size_t)(t + 2) * kstep; const char* b2 = last ? nB : cB + (size_t)(t + 2) * kstep;
            const char* a3 = a2 + kstep; const char* b3 = b2 + kstep;
            if (last && has_next) S.a_ready(nxt);
            if constexpr (SP2) {
            PG8_LDB(B0, 0, 0); PG8_LDB(B1, 0, 1); PG8_SCHED; PG8_LDA(At, 0, 0); PG8_STAGE(PG8_SA(1, 1), a1 + hstepA, voffA);
            PG8_WAIT_V(8); PG8_WAIT_L(0); PG8_BAR; PG8_MMA(0, 0, At, B0); PG8_MMA(0, 1, At, B1); PG8_BAR; PG8_SCHED;
            PG8_LDA(At, 0, 1); PG8_STAGE(PG8_SB(0, 0), b2, voffB); PG8_STAGE(PG8_SB(0, 1), b2 + hstepB, voffB); PG8_STAGE(PG8_SA(0, 0), a2, voffA);
            PG8_WAIT_V(8); PG8_WAIT_L(0); PG8_BAR; PG8_MMA(1, 0, At, B0); PG8_MMA(1, 1, At, B1); PG8_BAR; PG8_SCHED;
            PG8_LDB(B0, 1, 0); PG8_LDB(B1, 1, 1); PG8_SCHED; PG8_LDA(At, 1, 0); PG8_STAGE(PG8_SA(0, 1), a2 + hstepA, voffA);
            PG8_WAIT_V(8); PG8_WAIT_L(0); PG8_BAR; PG8_MMA(0, 0, At, B0); PG8_MMA(0, 1, At, B1); PG8_BAR; PG8_SCHED;
            PG8_LDA(At, 1, 1); PG8_STAGE(PG8_SB(1, 0), b3, voffB); PG8_STAGE(PG8_SB(1, 1), b3 + hstepB, voffB); PG8_STAGE(PG8_SA(1, 0), a3, voffA);
            PG8_WAIT_V(8); PG8_WAIT_L(0); PG8_BAR; PG8_MMA(1, 0, At, B0); PG8_MMA(1, 1, At, B1); PG8_BAR; PG8_SCHED;
            } else {
            PG8_LDB(B0, 0, 0); PG8_SCHED; PG8_LDA(At, 0, 0); PG8_STAGE(PG8_SA(1, 1), a1 + hstepA, voffA);
            PG8_WAIT_L(8); PG8_BAR; PG8_WAIT_L(0); PG8_MMA(0, 0, At, B0); PG8_BAR; PG8_SCHED;
            PG8_LDB(B1, 0, 1); PG8_STAGE(PG8_SB(0, 0), b2, voffB);
            PG8_BAR; PG8_WAIT_L(0); PG8_MMA(0, 1, At, B1); PG8_BAR;
            PG8_LDA(At, 0, 1); PG8_STAGE(PG8_SA(0, 0), a2, voffA);
            PG8_BAR; PG8_WAIT_L(0); PG8_MMA(1, 0, At, B0); PG8_BAR; PG8_SCHED;
            PG8_STAGE(PG8_SB(0, 1), b2 + hstepB, voffB);
            PG8_WAIT_V(6); PG8_BAR; PG8_MMA(1, 1, At, B1); PG8_BAR;
            PG8_LDB(B0, 1, 0); PG8_SCHED; PG8_LDA(At, 1, 0); PG8_STAGE(PG8_SA(0, 1), a2 + hstepA, voffA);
            PG8_WAIT_L(8); PG8_BAR; PG8_WAIT_L(0); PG8_MMA(0, 0, At, B0); PG8_BAR; PG8_SCHED;
            PG8_LDB(B1, 1, 1); PG8_STAGE(PG8_SB(1, 0), b3, voffB);
            PG8_BAR; PG8_WAIT_L(0); PG8_MMA(0, 1, At, B1); PG8_BAR;
            PG8_LDA(At, 1, 1); PG8_STAGE(PG8_SA(1, 0), a3, voffA);
            PG8_BAR; PG8_WAIT_L(0); PG8_MMA(1, 0, At, B0); PG8_BAR; PG8_SCHED;
            PG8_STAGE(PG8_SB(1, 1), b3 + hstepB, voffB);
            PG8_WAIT_V(6); PG8_BAR; PG8_MMA(1, 1, At, B1); PG8_BAR;
            }
        }
        if constexpr (ALIGN_EPI) { if (wr == 0) PG8_BAR; }
        if constexpr (!Epi::AFTER_DRAIN) { E(acc, cur, wr, wc, fr, fq); S.done(cur); }
        if (!has_next) break;
#pragma unroll
        for (int a = 0; a < 2; ++a)
#pragma unroll
            for (int b = 0; b < 2; ++b)
#pragma unroll
                for (int m = 0; m < 4; ++m)
#pragma unroll
                    for (int n = 0; n < 2; ++n) acc[a][b][m][n] = (f32x4){0.f, 0.f, 0.f, 0.f};
        cur = nxt; cA = nA; cB = nB; ++ui;
        if constexpr (ALIGN_EPI) { if (wr == 1) PG8_BAR; }
    }
    PG8_WAIT_V(0);
    if constexpr (!ALIGN_EPI) { if (wr == 0) PG8_BAR; }
    PG8_BAR;
    if constexpr (Epi::AFTER_DRAIN) { E.fused(acc, cur, wr, wc, fr, fq, lds, wid, lane); S.done(cur); }
#undef PG8_SA
#undef PG8_SB
#undef PG8_STAGE
#undef PG8_LDA
#undef PG8_LDB
#undef PG8_MMA
#undef PG8_WAIT_V
#undef PG8_WAIT_L
#undef PG8_BAR
#undef PG8_SCHED
}
}
#define DEV __device__ __forceinline__
#define LAS __attribute__((address_space(3)))
typedef unsigned short bf16;
typedef float f32x4 __attribute__((ext_vector_type(4)));
typedef float f32x2 __attribute__((ext_vector_type(2)));
typedef float f32x16 __attribute__((ext_vector_type(16)));
typedef unsigned u32x4 __attribute__((ext_vector_type(4)));
typedef unsigned u32x2 __attribute__((ext_vector_type(2)));
typedef short bf16x8 __attribute__((ext_vector_type(8)));
typedef short s16x4 __attribute__((ext_vector_type(4)));
typedef __bf16 bf16x2_t __attribute__((ext_vector_type(2)));

constexpr int DM = 1024, DFF = 2816, MTOK = 81920, MP = 65536, SP = 4096, SS = 8192;
constexpr int PROJW = 2048;
constexpr float LOG2E = 1.4426950408889634f;
constexpr float QSCALE = 0.125f * LOG2E;
constexpr float ALPHA = 1.4142135623730951f;
constexpr size_t MiB = 1u << 20;
constexpr size_t WS_PAR = 0;
constexpr size_t WS_NRM = 256 * 1024;
constexpr int NRM_KN = 2 * 320 * 8;
constexpr size_t WS_BAR = 512 * 1024;
constexpr size_t WS_WGU = 1 * MiB;
constexpr size_t WS_WD = 45 * MiB;
constexpr size_t WS_WIN = 67 * MiB;
constexpr size_t WS_WF = 75 * MiB;
constexpr size_t WS_WOUT = 77 * MiB;
constexpr size_t WS_WG = 81 * MiB;
constexpr size_t WS_DFT = 82 * MiB;
constexpr size_t WS_AGG = 210 * MiB;
constexpr size_t WS_STATS = 215 * MiB;
constexpr size_t WS_ONES = WS_STATS + 768 * 1024;
constexpr size_t WS_PROJ = 216 * MiB;
constexpr size_t WS_BTF = 536 * MiB;
constexpr size_t WS_XC = 632 * MiB;
constexpr size_t WS_YMIX = 672 * MiB;
constexpr size_t WS_AU = 832 * MiB;
constexpr size_t WS_XB = WS_AU;
constexpr size_t WS_H = WS_PROJ;
constexpr size_t WS_PART = 992 * MiB;
constexpr size_t WS_END = 1008 * MiB;
static_assert(WS_H + (size_t)MTOK * DFF * 2 <= WS_YMIX, "H overlay");
constexpr int LDS_BYTES = 147456;

DEV unsigned pk2(float lo, float hi) { f32x2 v = {lo, hi}; bf16x2_t b = __builtin_convertvector(v, bf16x2_t); return __builtin_bit_cast(unsigned, b); }
DEV float bf2f(unsigned short b) { return __uint_as_float((unsigned)b << 16); }
DEV float bflo(unsigned w) { return __uint_as_float(w << 16); }
DEV float bfhi(unsigned w) { return __uint_as_float(w & 0xffff0000u); }
DEV float lane_xor(float v, int lane, int o) { return __int_as_float(__builtin_amdgcn_ds_bpermute((lane ^ o) << 2, __float_as_int(v))); }
DEV float wave_sum(float v, int lane) {
#pragma unroll
    for (int o = 1; o < 64; o <<= 1) v += lane_xor(v, lane, o);
    return v;
}
DEV float sigmoidf_(float x) { return __builtin_amdgcn_rcpf(1.f + __builtin_amdgcn_exp2f(-LOG2E * x)); }

namespace epi {
using pg8::Unit; using pg8::HALF; using pg8::BM;
struct SwiGLU {
    static constexpr bool PERM = true, AFTER_DRAIN = false;
    bf16* H;
    DEV void operator()(const f32x4 (&acc)[2][2][4][2], const Unit& u, int wr, int wc, int fr_, int fq_) const {
        int t__ = threadIdx.x; asm volatile("" : "+v"(t__)); const int fr = t__ & 15, fq = (t__ >> 4) & 3; (void)fr_; (void)fq_;
        const int col0 = u.pn * 128 + wc * 32 + 8 * fq;
#pragma unroll
        for (int ai = 0; ai < 2; ++ai)
#pragma unroll
            for (int m = 0; m < 4; ++m) {
                const int row = u.pm * BM + ai * HALF + wr * 64 + m * 16 + fr;
                float o[8];
#pragma unroll
                for (int n = 0; n < 2; ++n)
#pragma unroll
                    for (int e = 0; e < 4; ++e) { const float g = acc[ai][0][m][n][e], up = acc[ai][1][m][n][e]; o[4 * n + e] = g * sigmoidf_(g) * up; }
                u32x4 w; w.x = pk2(o[0], o[1]); w.y = pk2(o[2], o[3]); w.z = pk2(o[4], o[5]); w.w = pk2(o[6], o[7]);
                *(u32x4*)(H + (size_t)row * DFF + col0) = w; asm volatile("" ::: "memory");
            }
    }
};
struct Resid {
    static constexpr bool PERM = true, AFTER_DRAIN = false;
    float* X; float s; const float* stats; const float* g; const float* b; const float* r0; const float* r1; float al = ALPHA;
    DEV void operator()(const f32x4 (&acc)[2][2][4][2], const Unit& u, int wr, int wc, int fr_, int fq_) const {
        int t__ = threadIdx.x; asm volatile("" : "+v"(t__)); const int fr = t__ & 15, fq = (t__ >> 4) & 3; (void)fr_; (void)fq_;
        const int colb = u.pn * BM + wc * 32 + 8 * fq;
        const float* rsrc = (u.pm * BM < MP) ? r0 : r1 - (size_t)MP * DM;
        f32x4 gv[2][2], bv[2][2];
#pragma unroll
        for (int bj = 0; bj < 2; ++bj)
#pragma unroll
            for (int n = 0; n < 2; ++n) { gv[bj][n] = *(const f32x4*)(g + colb + bj * HALF + n * 4); bv[bj][n] = *(const f32x4*)(b + colb + bj * HALF + n * 4); }
#pragma unroll
        for (int ai = 0; ai < 2; ++ai)
#pragma unroll
            for (int m = 0; m < 4; ++m) {
                const size_t row = (size_t)(u.pm * BM + ai * HALF + wr * 64 + m * 16 + fr);
                const f32x2 st = *(const f32x2*)(stats + row * 2);
                float* rp = X + row * DM + colb; const float* rq = rsrc + row * DM + colb;
#pragma unroll
                for (int bj = 0; bj < 2; ++bj)
#pragma unroll
                    for (int n = 0; n < 2; ++n) { f32x4* p = (f32x4*)(rp + bj * HALF + n * 4); const f32x4 yv = *(const f32x4*)(rq + bj * HALF + n * 4); const f32x4 x = ((yv - st[0]) * st[1]) * gv[bj][n] + bv[bj][n]; *p = x * al + acc[ai][bj][m][n] * s; }
                asm volatile("" ::: "memory");
            }
    }
};
struct Proj {
    static constexpr bool PERM = true, AFTER_DRAIN = false;
    bf16* P;
    DEV void operator()(const f32x4 (&acc)[2][2][4][2], const Unit& u, int wr, int wc, int fr_, int fq_) const {
        int t__ = threadIdx.x; asm volatile("" : "+v"(t__)); const int fr = t__ & 15, fq = (t__ >> 4) & 3; (void)fr_; (void)fq_;
        const float sc = (u.pn == 2 || u.pn == 3) ? QSCALE : 1.f;
        const int col0 = u.pn * BM + wc * 32 + 8 * fq;
#pragma unroll
        for (int ai = 0; ai < 2; ++ai)
#pragma unroll
            for (int m = 0; m < 4; ++m) {
                bf16* rp = P + (size_t)(u.pm * BM + ai * HALF + wr * 64 + m * 16 + fr) * PROJW + col0;
#pragma unroll
                for (int bj = 0; bj < 2; ++bj) { const f32x4 v0 = acc[ai][bj][m][0] * sc, v1 = acc[ai][bj][m][1] * sc;
                    u32x4 w; w.x = pk2(v0[0], v0[1]); w.y = pk2(v0[2], v0[3]); w.z = pk2(v1[0], v1[1]); w.w = pk2(v1[2], v1[3]);
                    *(u32x4*)(rp + bj * HALF) = w; }
                asm volatile("" ::: "memory");
            }
    }
};
struct FT {
    static constexpr bool PERM = true, AFTER_DRAIN = false;
    bf16* BP;
    DEV void operator()(const f32x4 (&acc)[2][2][4][2], const Unit& u, int wr, int wc, int fr_, int fq_) const {
        int t__ = threadIdx.x; asm volatile("" : "+v"(t__)); const int fr = t__ & 15, fq = (t__ >> 4) & 3; (void)fr_; (void)fq_;
        const int which = u.pm;
#pragma unroll
        for (int ai = 0; ai < 2; ++ai)
#pragma unroll
            for (int m = 0; m < 4; ++m) {
                const int n = ai * HALF + wr * 64 + m * 16 + fr;
#pragma unroll
                for (int bj = 0; bj < 2; ++bj) {
                    const int t0 = u.pn * BM + bj * HALF + wc * 32 + 8 * fq;
                    const f32x4 v0 = acc[ai][bj][m][0], v1 = acc[ai][bj][m][1];
                    if (t0 < MP) {
                        const int seq = t0 >> 12, s = t0 & 4095;
                        u32x4 w; w.x = pk2(v0[0], v0[1]); w.y = pk2(v0[2], v0[3]); w.z = pk2(v1[0], v1[1]); w.w = pk2(v1[2], v1[3]);
                        *(u32x4*)(BP + ((size_t)seq * 256 + n) * 8192 + which * 4096 + s) = w;
                    } else {
                        const int tt = t0 - MP, seq2 = tt >> 13, s = tt & 8191;
                        u32x2 ev, od; ev.x = pk2(v0[0], v0[2]); ev.y = pk2(v1[0], v1[2]); od.x = pk2(v0[1], v0[3]); od.y = pk2(v1[1], v1[3]);
                        bf16* be = BP + ((size_t)(16 + seq2 * 2) * 256 + n) * 8192 + which * 4096 + (s >> 1);
                        *(u32x2*)be = ev; *(u32x2*)(be + (size_t)256 * 8192) = od;
                    }
                }
                asm volatile("" ::: "memory");
            }
    }
};
struct DFT {
    static constexpr bool PERM = true, AFTER_DRAIN = false;
    bf16* Y; float* PART; float scale;
    DEV void operator()(const f32x4 (&acc)[2][2][4][2], const Unit& u, int wr, int wc, int fr_, int fq_) const {
        int t__ = threadIdx.x; asm volatile("" : "+v"(t__)); const int fr = t__ & 15, fq = (t__ >> 4) & 3; (void)fr_; (void)fq_;
        const int col0 = wc * 32 + 8 * fq;
        if (u.z < 16) {
#pragma unroll
            for (int ai = 0; ai < 2; ++ai)
#pragma unroll
                for (int m = 0; m < 4; ++m) {
                    bf16* rp = Y + (size_t)(u.z * SP + u.pm * BM + ai * HALF + wr * 64 + m * 16 + fr) * DM + 768 + col0;
#pragma unroll
                    for (int bj = 0; bj < 2; ++bj) { const f32x4 v0 = acc[ai][bj][m][0] * scale, v1 = acc[ai][bj][m][1] * scale;
                        u32x4 w; w.x = pk2(v0[0], v0[1]); w.y = pk2(v0[2], v0[3]); w.z = pk2(v1[0], v1[1]); w.w = pk2(v1[2], v1[3]);
                        *(u32x4*)(rp + bj * HALF) = w; }
                    asm volatile("" ::: "memory");
                }
        } else {
#pragma unroll
            for (int ai = 0; ai < 2; ++ai)
#pragma unroll
                for (int m = 0; m < 4; ++m) {
                    float* rp = PART + ((size_t)(u.z - 16) * 4096 + (u.pm & 15) * BM + ai * HALF + wr * 64 + m * 16 + fr) * 256 + col0;
#pragma unroll
                    for (int bj = 0; bj < 2; ++bj) { *(f32x4*)(rp + bj * HALF) = acc[ai][bj][m][0]; *(f32x4*)(rp + bj * HALF + 4) = acc[ai][bj][m][1]; }
                    asm volatile("" ::: "memory");
                }
        }
    }
};
struct DftOrder {
    int G, c;
    DEV bool next(int i, Unit& u) const { const int L = i * G + c; if (L >= 320) return false; u.pn = 0;
        if (L < 288) { const int pmA = L / 18, zi = L - pmA * 18; u.pm = pmA; u.z = zi < 16 ? zi : 16 + 2 * (zi - 16); }
        else { const int L2 = L - 288; u.pm = 16 + (L2 >> 1); u.z = 17 + 2 * (L2 & 1); }
        return true; }
    DEV void a_ready(const Unit&) const {}
    DEV void done(const Unit&) const {}
};
struct Raw {
    static constexpr bool PERM = true, AFTER_DRAIN = false;
    bf16* P;
    DEV void operator()(const f32x4 (&acc)[2][2][4][2], const Unit& u, int wr, int wc, int fr_, int fq_) const {
        int t__ = threadIdx.x; asm volatile("" : "+v"(t__)); const int fr = t__ & 15, fq = (t__ >> 4) & 3; (void)fr_; (void)fq_;
        const int col0 = u.pn * BM + wc * 32 + 8 * fq;
#pragma unroll
        for (int ai = 0; ai < 2; ++ai)
#pragma unroll
            for (int m = 0; m < 4; ++m) {
                bf16* rp = P + (size_t)(u.pm * BM + ai * HALF + wr * 64 + m * 16 + fr) * 1024 + col0;
#pragma unroll
                for (int bj = 0; bj < 2; ++bj) { const f32x4 v0 = acc[ai][bj][m][0], v1 = acc[ai][bj][m][1];
                    u32x4 w; w.x = pk2(v0[0], v0[1]); w.y = pk2(v0[2], v0[3]); w.z = pk2(v1[0], v1[1]); w.w = pk2(v1[2], v1[3]);
                    *(u32x4*)(rp + bj * HALF) = w; }
                asm volatile("" ::: "memory");
            }
    }
};
struct BatchOrder {
    int lz, nM, G, c;
    DEV bool next(int i, Unit& u) const { const int L = i * G + c; if (L >= (nM << lz)) return false; u.pm = L >> lz; u.z = L & ((1 << lz) - 1); u.pn = 0; return true; }
    DEV void a_ready(const Unit&) const {}
    DEV void done(const Unit&) const {}
};
}
struct Ctx {
    const float* const* in; float* out; unsigned char* ws;
    int tid, lane, wave, G, bid;
};
#ifndef RPA
#define RPA 1
#endif
#ifndef RPB
#define RPB 1
#endif
#ifndef RPE
#define RPE 1
#endif
#ifndef RPF
#define RPF 1
#endif
DEV void transpose_item(const float* W, int ldw, int srccol0, bf16* WT, int ldo, int dstrow0, int k0, LAS float* scr, int lane) {
#pragma unroll 8
    for (int i = 0; i < 32; ++i) { const int kk = 2 * i + (lane >> 5); scr[kk * 33 + (lane & 31)] = W[(size_t)(k0 + kk) * ldw + srccol0 + (lane & 31)]; }
    asm volatile("s_waitcnt lgkmcnt(0)" ::: "memory");
    const int c = lane & 7;
#pragma unroll
    for (int j = 0; j < 4; ++j) { const int n = (lane >> 3) + 8 * j; const LAS float* s = scr + (8 * c) * 33 + n;
        u32x4 o; o.x = pk2(s[0 * 33], s[1 * 33]); o.y = pk2(s[2 * 33], s[3 * 33]); o.z = pk2(s[4 * 33], s[5 * 33]); o.w = pk2(s[6 * 33], s[7 * 33]);
        *(u32x4*)(WT + (size_t)(dstrow0 + n) * ldo + k0 + 8 * c) = o; }
    asm volatile("s_waitcnt lgkmcnt(0)" ::: "memory");
}
DEV void phase_prologue(const Ctx& C, LAS unsigned char* lds) {
    const int gw = C.bid * 8 + C.wave, NGW = C.G * 8;
    const long gt = (long)C.bid * 512 + C.tid, NGT = (long)C.G * 512;
    unsigned char* ws = C.ws;
for (int rp_ = 0; rp_ < RPA; ++rp_) {
    {
        LAS float* scr = (LAS float*)(lds + C.wave * 16384);
        for (int it = gw; it < 2 * 9984; it += NGW) {
            const int l = it / 9984, r = it % 9984; int j, q;
            if (r < 8448) { j = r / 1408; q = r % 1408; } else if (r < 9472) { j = 6; q = r - 8448; } else { j = 7; q = r - 9472; }
            const float* src; int ldw, K, N; bf16* dst; int inter = 0, ioff = 0;
            if (j == 0 || j == 1 || j == 3 || j == 4) { const int f = j >= 3; const int up = (j == 1 || j == 4);
                src = C.in[(f ? 7 : 4) + up] + (size_t)l * DM * DFF; ldw = DFF; K = DM; N = DFF; dst = (bf16*)(ws + WS_WGU) + (size_t)(l * 2 + f) * 5632 * 1024; inter = 1; ioff = up ? 128 : 0; }
            else if (j == 2 || j == 5) { const int f = j == 5; src = C.in[f ? 9 : 6] + (size_t)l * DFF * DM; ldw = DM; K = DFF; N = DM; dst = (bf16*)(ws + WS_WD) + (size_t)(l * 2 + f) * 1024 * 2816; }
            else if (j == 6) { src = C.in[10] + (size_t)l * DM * 2304; ldw = 2304; K = DM; N = 2048; dst = (bf16*)(ws + WS_WIN) + (size_t)l * 2048 * 1024; }
            else { src = C.in[20] + (size_t)l * DM * DM; ldw = DM; K = DM; N = DM; dst = (bf16*)(ws + WS_WOUT) + (size_t)l * 1024 * 1024; }
            const int nblk = N / 32, kb = q / nblk, nb = q % nblk, n0 = 32 * nb;
            const int drow = inter ? (256 * (n0 >> 7) + (n0 & 127) + ioff) : n0;
            transpose_item(src, ldw, n0, dst, K, drow, 64 * kb, scr, C.lane);
        }
    }
}
    for (int rp_ = 0; rp_ < RPB; ++rp_) {
    {
        LAS float* tw = (LAS float*)(lds + 8 * 16384);
        if (C.tid < 64) { float sn, cs; sincospif((float)C.tid * (1.0f / 32.0f), &sn, &cs); tw[C.tid] = cs; tw[64 + C.tid] = sn; }
        __syncthreads();
        for (long it = gt; it < 2L * 512 * 128; it += NGT) {
            const int l = (int)(it / (512 * 128)), r = (int)(it % (512 * 128)), nrow = r >> 7, k0 = (r & 127) * 8;
            const int which = nrow >> 8, g = (nrow >> 6) & 3, cp = nrow & 63;
            const float* wsrc = C.in[10] + (size_t)l * DM * 2304 + 2048 + 64 * g;
            float o[8];
#pragma unroll
            for (int kk = 0; kk < 8; ++kk) {
                const float* wr_ = wsrc + (size_t)(k0 + kk) * 2304; float a = 0.f;
                for (int c = 0; c < 64; c += 4) { const f32x4 w4 = *(const f32x4*)(wr_ + c);
                    a += w4[0] * tw[which * 64 + (((c + 0) * cp) & 63)] + w4[1] * tw[which * 64 + (((c + 1) * cp) & 63)] + w4[2] * tw[which * 64 + (((c + 2) * cp) & 63)] + w4[3] * tw[which * 64 + (((c + 3) * cp) & 63)]; }
                o[kk] = a;
            }
            u32x4 w; w.x = pk2(o[0], o[1]); w.y = pk2(o[2], o[3]); w.z = pk2(o[4], o[5]); w.w = pk2(o[6], o[7]);
            *(u32x4*)((bf16*)(ws + WS_WF) + ((size_t)l * 512 + nrow) * 1024 + k0) = w;
        }
    }
}
    for (long it = gt; it < 2L * 1024 * 32; it += NGT) {
        const int l = (int)(it / (1024 * 32)), r = (int)(it % (1024 * 32)), n = r >> 5, k0 = (r & 31) * 8;
        const int tn = n >> 8, dir = tn >> 1, chh = tn & 1, within = n & 255, gate = within >> 7, ch = chh * 128 + (within & 127), hb = ch >> 6, jj = ch & 63;
        u32x4 w = {0u, 0u, 0u, 0u};
        if ((k0 >> 6) == hb) {
            const float* src = C.in[gate ? 15 : 13] + ((size_t)((l * 2 + dir) * 4 + hb) * 64) * 64 + jj;
            float o[8];
#pragma unroll
            for (int kk = 0; kk < 8; ++kk) o[kk] = src[(size_t)((k0 & 63) + kk) * 64];
            w.x = pk2(o[0], o[1]); w.y = pk2(o[2], o[3]); w.z = pk2(o[4], o[5]); w.w = pk2(o[6], o[7]);
        }
        *(u32x4*)((bf16*)(ws + WS_WG) + ((size_t)l * 1024 + n) * 256 + k0) = w;
    }
    if (gt < 1024) { const float lam = C.in[17][gt]; ((float*)(ws + WS_PAR))[gt] = 8.f * log1pf(expf(-lam)); }
    if (gt >= 1024 && gt < 1026) { const int l = (int)gt - 1024; const float* lq = C.in[18] + l * 256; float s1 = 0.f, s2 = 0.f;
        for (int i = 0; i < 64; ++i) { s1 += lq[i] * lq[64 + i]; s2 += lq[128 + i] * lq[192 + i]; }
        const float li = 0.8f - 0.6f * expf(-0.3f * (float)l);
        ((float*)(ws + WS_PAR))[1024 + l] = expf(s1) - expf(s2) + li; ((float*)(ws + WS_PAR))[1026 + l] = li; }
    if (gt < NRM_KN + 2 * 18 * 8) ((unsigned*)(ws + WS_NRM))[gt] = 0u;
    if (gt < MTOK) *(f32x2*)((float*)(ws + WS_STATS) + gt * 2) = (f32x2){0.f, 1.f};
    if (gt < 2048) ((float*)(ws + WS_ONES))[gt] = gt < 1024 ? 1.f : 0.f;
for (int rp_ = 0; rp_ < RPE; ++rp_) {
for (int rp_ = 0; rp_ < RPE; ++rp_) {
    for (long it = gt; it < 8192L * 1024; it += NGT) {
        const int row = (int)(it >> 10), k0 = (int)(it & 1023) * 8, odd = row >> 12, sp = row & 4095, neg = k0 >> 12, nb = k0 & 4095;
        float o[8];
#pragma unroll
        for (int e = 0; e < 8; ++e) { const int n = nb + e; float sn, cs;
            if (!odd) { const int idx = (n * sp) & 4095; sincospif((float)idx * (1.0f / 2048.0f), &sn, &cs); }
            else { const int idx = ((2 * n + 1) * sp) & 8191; sincospif((float)idx * (1.0f / 4096.0f), &sn, &cs); }
            o[e] = neg ? -sn : cs; }
        u32x4 w; w.x = pk2(o[0], o[1]); w.y = pk2(o[2], o[3]); w.z = pk2(o[4], o[5]); w.w = pk2(o[6], o[7]);
        *(u32x4*)((bf16*)(ws + WS_DFT) + (size_t)row * 8192 + k0) = w;
    }
}
    {
        const f32x4* xp = (const f32x4*)C.in[0]; const f32x4* xs = (const f32x4*)C.in[1]; u32x2* xb = (u32x2*)(ws + WS_XB);
        const long NP = (long)MP * 256, NT = (long)MTOK * 256;
        for (long it = gt; it < NT; it += NGT) { const f32x4 v = it < NP ? xp[it] : xs[it - NP]; u32x2 w; w.x = pk2(v[0], v[1]); w.y = pk2(v[2], v[3]); xb[it] = w; }
    }
}
}
DEV void ln_row(const f32x4 (&cur)[4], const f32x4 (&gv)[4], const f32x4 (&bv)[4], int m, int lane, float* out, unsigned char* ws, bool final_) {
    float s = 0.f, q = 0.f;
#pragma unroll
    for (int j = 0; j < 4; ++j) { s += (cur[j][0] + cur[j][1]) + (cur[j][2] + cur[j][3]); q += (cur[j][0] * cur[j][0] + cur[j][1] * cur[j][1]) + (cur[j][2] * cur[j][2] + cur[j][3] * cur[j][3]); }
#pragma unroll
    for (int o = 1; o < 64; o <<= 1) { const float s2 = lane_xor(s, lane, o), q2 = lane_xor(q, lane, o); s += s2; q += q2; }
    const float mean = s * (1.f / DM), var = __builtin_fmaxf(q * (1.f / DM) - mean * mean, 0.f), rstd = 1.f / sqrtf(var + 1e-5f);
    if (final_) {
        f32x4* xr = (f32x4*)(out + (size_t)m * DM) + lane;
#pragma unroll
        for (int j = 0; j < 4; ++j) xr[64 * j] = (cur[j] - mean) * rstd * gv[j] + bv[j];
    } else {
        u32x2* o8 = (u32x2*)((bf16*)(ws + WS_XB) + (size_t)m * DM) + lane;
#pragma unroll
        for (int j = 0; j < 4; ++j) { const f32x4 y = (cur[j] - mean) * rstd * gv[j] + bv[j]; u32x2 w; w.x = pk2(y[0], y[1]); w.y = pk2(y[2], y[3]); o8[64 * j] = w; }
        if (lane == 0) *(f32x2*)((float*)(ws + WS_STATS) + (size_t)m * 2) = (f32x2){mean, rstd};
    }
}
DEV void phase_ln(const Ctx& C, const float* g, const float* b, bool final_) {
    const int gw = C.bid * 8 + C.wave, NGW = C.G * 8, lane = C.lane;
    f32x4 gv[4], bv[4];
#pragma unroll
    for (int j = 0; j < 4; ++j) { gv[j] = ((const f32x4*)g)[lane + 64 * j]; bv[j] = ((const f32x4*)b)[lane + 64 * j]; }
    f32x4 c0[4], c1[4], n0[4], n1[4];
    auto ld = [&](f32x4 (&d)[4], int m) { const int mm = m < MTOK ? m : gw;
#pragma unroll
        for (int j = 0; j < 4; ++j) d[j] = ((const f32x4*)(C.out + (size_t)mm * DM))[lane + 64 * j]; };
    ld(c0, gw); ld(c1, gw + NGW);
    for (int m = gw; m < MTOK; m += 2 * NGW) {
        ld(n0, m + 2 * NGW); ld(n1, m + 3 * NGW);
        ln_row(c0, gv, bv, m, lane, C.out, C.ws, final_);
        if (m + NGW < MTOK) ln_row(c1, gv, bv, m + NGW, lane, C.out, C.ws, final_);
#pragma unroll
        for (int j = 0; j < 4; ++j) { c0[j] = n0[j]; c1[j] = n1[j]; }
    }
}
DEV void phase_dft_combine(const Ctx& C) {
    const long gt = (long)C.bid * 512 + C.tid, NGT = (long)C.G * 512;
    const float* PART = (const float*)(C.ws + WS_PART); bf16* Y = (bf16*)(C.ws + WS_YMIX); const float sc = 0.001381067932004976f;
    for (long it = gt; it < 2L * 4096 * 64; it += NGT) {
        const int seq2 = (int)(it >> 18), r = (int)(it & 262143), sp = r >> 6, c = (r & 63) * 4;
        const f32x4 p1 = *(const f32x4*)(PART + ((size_t)(seq2 * 2) * 4096 + sp) * 256 + c), p2 = *(const f32x4*)(PART + ((size_t)(seq2 * 2 + 1) * 4096 + sp) * 256 + c);
        const f32x4 lo = (p1 + p2) * sc, hi = (p1 - p2) * sc;
        u32x2 wl, wh; wl.x = pk2(lo[0], lo[1]); wl.y = pk2(lo[2], lo[3]); wh.x = pk2(hi[0], hi[1]); wh.y = pk2(hi[2], hi[3]);
        bf16* yl = Y + (size_t)(MP + seq2 * SS + sp) * DM + 768 + c;
        *(u32x2*)yl = wl; *(u32x2*)(yl + (size_t)4096 * DM) = wh;
    }
}
DEV void phase_conv(const Ctx& C, int l) {
    const long gt = (long)C.bid * 512 + C.tid, NGT = (long)C.G * 512;
    const bf16* P = (const bf16*)(C.ws + WS_PROJ); bf16* XC = (bf16*)(C.ws + WS_XC);
    const float* cw = C.in[11] + l * 4 * 256; const float* cb = C.in[12] + l * 256;
    for (long it = gt; it < (long)MTOK * 32; it += NGT) {
        const int tok = (int)(it >> 5), c0 = (int)(it & 31) * 8;
        const int pos = tok < MP ? (tok & 4095) : ((tok - MP) & 8191), S = tok < MP ? SP : SS;
        float a[8];
        { const f32x4 b0 = *(const f32x4*)(cb + c0), b1 = *(const f32x4*)(cb + c0 + 4); a[0] = b0[0]; a[1] = b0[1]; a[2] = b0[2]; a[3] = b0[3]; a[4] = b1[0]; a[5] = b1[1]; a[6] = b1[2]; a[7] = b1[3]; }
#pragma unroll
        for (int j = 0; j < 4; ++j) { const int tt = pos - 2 + j;
            if (tt >= 0 && tt < S) { const u32x4 xw = *(const u32x4*)(P + (size_t)(tok - 2 + j) * PROJW + c0);
                const f32x4 w0 = *(const f32x4*)(cw + j * 256 + c0), w1 = *(const f32x4*)(cw + j * 256 + c0 + 4);
                a[0] += w0[0] * bflo(xw.x); a[1] += w0[1] * bfhi(xw.x); a[2] += w0[2] * bflo(xw.y); a[3] += w0[3] * bfhi(xw.y);
                a[4] += w1[0] * bflo(xw.z); a[5] += w1[1] * bfhi(xw.z); a[6] += w1[2] * bflo(xw.w); a[7] += w1[3] * bfhi(xw.w); } }
        u32x4 w; w.x = pk2(a[0], a[1]); w.y = pk2(a[2], a[3]); w.z = pk2(a[4], a[5]); w.w = pk2(a[6], a[7]);
        *(u32x4*)(XC + (size_t)tok * 256 + c0) = w;
    }
    unsigned* QN = (unsigned*)(C.ws + WS_NRM) + l * 320 * 8; unsigned* KN = (unsigned*)(C.ws + WS_NRM) + NRM_KN + l * 18 * 8;
    for (long it = gt; it < (long)MTOK * 8; it += NGT) {
        const int tok = (int)(it >> 3), hm = (int)(it & 7);
        const bf16* qp = P + (size_t)tok * PROJW + 512 + hm * 64; float sq = 0.f, sk = 0.f;
#pragma unroll
        for (int j = 0; j < 8; ++j) { const u32x4 a = *(const u32x4*)(qp + 8 * j), k4 = *(const u32x4*)(qp + 512 + 8 * j);
            sq += bflo(a.x) * bflo(a.x) + bfhi(a.x) * bfhi(a.x) + bflo(a.y) * bflo(a.y) + bfhi(a.y) * bfhi(a.y) + bflo(a.z) * bflo(a.z) + bfhi(a.z) * bfhi(a.z) + bflo(a.w) * bflo(a.w) + bfhi(a.w) * bfhi(a.w);
            sk += bflo(k4.x) * bflo(k4.x) + bfhi(k4.x) * bfhi(k4.x) + bflo(k4.y) * bflo(k4.y) + bfhi(k4.y) * bfhi(k4.y) + bflo(k4.z) * bflo(k4.z) + bfhi(k4.z) * bfhi(k4.z) + bflo(k4.w) * bflo(k4.w) + bfhi(k4.w) * bfhi(k4.w); }
#pragma unroll
        for (int o = 8; o < 64; o <<= 1) { sq = fmaxf(sq, lane_xor(sq, C.lane, o)); sk = fmaxf(sk, lane_xor(sk, C.lane, o)); }
        if (C.lane < 8) { const int seq = tok < MP ? (tok >> 12) : 16 + ((tok - MP) >> 13);
            atomicMax(QN + (tok >> 8) * 8 + hm, __float_as_uint(sq)); atomicMax(KN + seq * 8 + hm, __float_as_uint(sk)); }
    }
}
DEV float fsig(float x) { return __builtin_amdgcn_rcpf(1.f + __builtin_amdgcn_exp2f(-LOG2E * x)); }
DEV void gate_eval(float rp, float ip, float xc, float ba, float bx, float sp8, float& la2, float& u) {
    const float r = fsig(rp + ba), ig = fsig(ip + bx);
    la2 = -sp8 * r * LOG2E;
    const float em = __builtin_fmaxf(1.f - __builtin_amdgcn_exp2f(2.f * la2), 0.f);
    u = __builtin_amdgcn_sqrtf(em) * ig * xc;
}
DEV float gelu_tanh(float x) { const float z = 0.7978845608028654f * (x + 0.044715f * x * x * x); const float e = __builtin_amdgcn_exp2f(2.f * LOG2E * z); return 0.5f * x * (2.f - 2.f * __builtin_amdgcn_rcpf(e + 1.f)); }
constexpr int SROW = 68;
typedef _Float16 h16x2 __attribute__((ext_vector_type(2)));
DEV unsigned pkh(float a, float b) { return __builtin_bit_cast(unsigned, __builtin_amdgcn_cvt_pkrtz(a, b)); }
template <int DIRV> DEV void gate_stage(const bf16* gbase, const bf16* xcb, int chb, int tl, int cg, LAS unsigned* sl, const float* pba, const float* pbx, const float* par) {
    const int col = (DIRV * 2 + (chb >> 7)) * 256 + (chb & 127);
    float ba[8], bx[8], sp[8];
#pragma unroll
    for (int q = 0; q < 2; ++q) { const f32x4 a = *(const f32x4*)(pba + DIRV * 256 + chb + 4 * q), b = *(const f32x4*)(pbx + DIRV * 256 + chb + 4 * q), s = *(const f32x4*)(par + DIRV * 256 + chb + 4 * q);
#pragma unroll
        for (int e = 0; e < 4; ++e) { ba[4 * q + e] = a[e]; bx[4 * q + e] = b[e]; sp[4 * q + e] = s[e]; } }
#pragma unroll
    for (int j = 0; j < 8; ++j) {
        const int t = 8 * j + tl;
        const u32x4 rw = *(const u32x4*)(gbase + (size_t)t * 1024 + col), iw = *(const u32x4*)(gbase + (size_t)t * 1024 + col + 128), xw = *(const u32x4*)(xcb + (size_t)t * 256);
        const float rp[8] = {bflo(rw.x), bfhi(rw.x), bflo(rw.y), bfhi(rw.y), bflo(rw.z), bfhi(rw.z), bflo(rw.w), bfhi(rw.w)};
        const float ip[8] = {bflo(iw.x), bfhi(iw.x), bflo(iw.y), bfhi(iw.y), bflo(iw.z), bfhi(iw.z), bflo(iw.w), bfhi(iw.w)};
        const float xc[8] = {bflo(xw.x), bfhi(xw.x), bflo(xw.y), bfhi(xw.y), bflo(xw.z), bfhi(xw.z), bflo(xw.w), bfhi(xw.w)};
        unsigned w[8];
#pragma unroll
        for (int e = 0; e < 8; ++e) { float la, u; gate_eval(rp[e], ip[e], xc[e], ba[e], bx[e], sp[e], la, u); w[e] = pkh(la, u); }
        LAS u32x4* dst = (LAS u32x4*)(sl + t * SROW + cg * 8);
        dst[0] = (u32x4){w[0], w[1], w[2], w[3]}; dst[1] = (u32x4){w[4], w[5], w[6], w[7]};
    }
    asm volatile("s_waitcnt lgkmcnt(0)" ::: "memory");
}
template <bool FINAL> DEV void phase_scan(const Ctx& C, int l, LAS unsigned char* lds) {
    const int gw = C.bid * 8 + C.wave, NGW = C.G * 8, lane = C.lane, tl = lane >> 3, cg = lane & 7;
    const bf16* GP = (const bf16*)(C.ws + WS_AU); float* AGG = (float*)(C.ws + WS_AGG); const bf16* XC = (const bf16*)(C.ws + WS_XC);
    const bf16* P = (const bf16*)(C.ws + WS_PROJ); bf16* Y = (bf16*)(C.ws + WS_YMIX);
    const float* par = (const float*)(C.ws + WS_PAR) + l * 512; const float* pba = C.in[14] + l * 512; const float* pbx = C.in[16] + l * 512;
    LAS unsigned* sl = (LAS unsigned*)(lds + C.wave * (64 * SROW * 4));
    for (int it = gw; it < 1280 * 4; it += NGW) {
        const int cidx = it >> 2, g4 = it & 3, ch = g4 * 64 + lane, chb = g4 * 64 + cg * 8;
        const bf16* gbase = GP + (size_t)cidx * 64 * 1024; const bf16* xcb = XC + (size_t)cidx * 64 * 256 + chb;
        if (!FINAL) {
            gate_stage<0>(gbase, xcb, chb, tl, cg, sl, pba, pbx, par);
            { float Ps = 0.f, h = 0.f;
#pragma unroll 16
              for (int t = 0; t < 64; ++t) { const h16x2 w = __builtin_bit_cast(h16x2, sl[t * SROW + lane]); const float la = (float)w[0]; h = __builtin_amdgcn_exp2f(la) * h + (float)w[1]; Ps += la; }
              *(f32x2*)(AGG + ((size_t)(cidx * 2 + 0) * 256 + ch) * 2) = (f32x2){Ps, h}; }
            asm volatile("s_waitcnt lgkmcnt(0)" ::: "memory");
            gate_stage<1>(gbase, xcb, chb, tl, cg, sl, pba, pbx, par);
            { float Ps = 0.f, h = 0.f;
#pragma unroll 16
              for (int t = 63; t >= 0; --t) { const h16x2 w = __builtin_bit_cast(h16x2, sl[t * SROW + lane]); const float la = (float)w[0]; h = __builtin_amdgcn_exp2f(la) * h + (float)w[1]; Ps += la; }
              *(f32x2*)(AGG + ((size_t)(cidx * 2 + 1) * 256 + ch) * 2) = (f32x2){Ps, h}; }
            asm volatile("s_waitcnt lgkmcnt(0)" ::: "memory");
        } else {
            int c0, c1; if (cidx < 1024) { c0 = cidx & ~63; c1 = c0 + 64; } else { c0 = 1024 + ((cidx - 1024) & ~127); c1 = c0 + 128; }
            float hin = 0.f, hbin = 0.f;
#pragma unroll 16
            for (int c = c0; c < cidx; ++c) { const f32x2 a = *(const f32x2*)(AGG + ((size_t)(c * 2 + 0) * 256 + ch) * 2); hin = __builtin_amdgcn_exp2f(a[0]) * hin + a[1]; }
#pragma unroll 16
            for (int c = c1 - 1; c > cidx; --c) { const f32x2 a = *(const f32x2*)(AGG + ((size_t)(c * 2 + 1) * 256 + ch) * 2); hbin = __builtin_amdgcn_exp2f(a[0]) * hbin + a[1]; }
            gate_stage<0>(gbase, xcb, chb, tl, cg, sl, pba, pbx, par);
            float hf[64]; float h = hin;
#pragma unroll
            for (int t = 0; t < 64; ++t) { const h16x2 w = __builtin_bit_cast(h16x2, sl[t * SROW + lane]); h = __builtin_amdgcn_exp2f((float)w[0]) * h + (float)w[1]; hf[t] = h; }
            asm volatile("s_waitcnt lgkmcnt(0)" ::: "memory");
            gate_stage<1>(gbase, xcb, chb, tl, cg, sl, pba, pbx, par);
            h = hbin;
#pragma unroll
            for (int t = 63; t >= 0; --t) { const h16x2 w = __builtin_bit_cast(h16x2, sl[t * SROW + lane]); h = __builtin_amdgcn_exp2f((float)w[0]) * h + (float)w[1]; sl[t * SROW + lane] = __float_as_uint(hf[t] + h); }
            asm volatile("s_waitcnt lgkmcnt(0)" ::: "memory");
#pragma unroll
            for (int j = 0; j < 8; ++j) {
                const int t = 8 * j + tl; const size_t tok = (size_t)cidx * 64 + t;
                const LAS u32x4* src = (const LAS u32x4*)(sl + t * SROW + cg * 8); const u32x4 s0 = src[0], s1 = src[1];
                const u32x4 gw_ = *(const u32x4*)(P + tok * PROJW + 256 + chb);
                u32x4 o;
                o.x = pk2(gelu_tanh(bflo(gw_.x)) * __uint_as_float(s0.x), gelu_tanh(bfhi(gw_.x)) * __uint_as_float(s0.y));
                o.y = pk2(gelu_tanh(bflo(gw_.y)) * __uint_as_float(s0.z), gelu_tanh(bfhi(gw_.y)) * __uint_as_float(s0.w));
                o.z = pk2(gelu_tanh(bflo(gw_.z)) * __uint_as_float(s1.x), gelu_tanh(bfhi(gw_.z)) * __uint_as_float(s1.y));
                o.w = pk2(gelu_tanh(bflo(gw_.w)) * __uint_as_float(s1.z), gelu_tanh(bfhi(gw_.w)) * __uint_as_float(s1.w));
                *(u32x4*)(Y + tok * DM + chb) = o;
            }
            asm volatile("s_waitcnt lgkmcnt(0)" ::: "memory");
        }
    }
}
namespace att {
constexpr int KROW = 272, VROW = 320, KBUF = 32 * KROW, VBUF = 32 * VROW, LDS_K = 0, LDS_V = 2 * KBUF, LDS_Q = 2 * KBUF + 2 * VBUF;
static_assert(LDS_Q + 256 * KROW + 16 <= LDS_BYTES, "attention LDS");
typedef short v4i16_t __attribute__((ext_vector_type(4)));
DEV s16x4 vtr(const LAS unsigned char* p) { return __builtin_bit_cast(s16x4, __builtin_amdgcn_ds_read_tr16_b64_v4i16((LAS v4i16_t*)p)); }


DEV void attn_unit(const bf16* PROJ, bf16* YMIX, int tok0, int S, int head, int qb, float lam, float oscale, const float* subg, float Bnd, LAS unsigned char* lds) {
    int tid_ = threadIdx.x; asm volatile("" : "+v"(tid_));
    const int tid = tid_, lane = tid & 63, r32 = lane & 31, hi = lane >> 5, wid = __builtin_amdgcn_readfirstlane(tid >> 6);
    const int qpos = qb * 256 + wid * 32 + r32;
    LAS unsigned char* qlds = lds + LDS_Q + wid * 32 * KROW;
    { const bf16* qg = PROJ + (size_t)(tok0 + qb * 256 + wid * 32) * PROJW + 512 + head * 128;
#pragma unroll
      for (int i = 0; i < 8; ++i) { const int ch = lane + 64 * i, row = ch >> 4, c16 = ch & 15; const u32x4 v = *(const u32x4*)(qg + (size_t)row * PROJW + c16 * 8); *(LAS u32x4*)(qlds + row * KROW + c16 * 16) = v; } }
    const LAS unsigned char* qfb = qlds + r32 * KROW + hi * 16;
    bf16x8 qf0[4];
    { const bf16* qrow = PROJ + (size_t)(tok0 + qpos) * PROJW + 512 + head * 128 + hi * 8;
#pragma unroll
      for (int ds = 0; ds < 4; ++ds) qf0[ds] = *(const bf16x8*)(qrow + ds * 16); }
    const float sl2 = __builtin_amdgcn_exp2f(-2.f * (float)(head + 1)) * LOG2E;
    const int srow = tid >> 4, sc16 = tid & 15;
    const bf16* kg = PROJ + (size_t)(tok0 + srow) * PROJW + 1024 + head * 128 + sc16 * 8;
    const bf16* vg = kg + 512;
    LAS unsigned char* kst = lds + LDS_K + srow * KROW + sc16 * 16;
    LAS unsigned char* vst = lds + LDS_V + srow * VROW + sc16 * 16;
    const LAS unsigned char* kfb = lds + LDS_K + r32 * KROW + hi * 16;
    const int i16 = lane & 15, gq = i16 >> 2, gp = i16 & 3, g1 = (lane >> 4) & 1;
    const LAS unsigned char* vfb = lds + LDS_V + (4 * hi + gq) * VROW + (16 * g1 + 4 * gp) * 2;
    u32x4 kr0, vr0;
    { const size_t go0 = (size_t)(qb * 8) * 32 * PROJW; kr0 = *(const u32x4*)(kg + go0); vr0 = *(const u32x4*)(vg + go0); }
    *(LAS u32x4*)kst = kr0; *(LAS u32x4*)vst = vr0;
    __syncthreads();
    f32x16 O[2][4];
#pragma unroll
    for (int c = 0; c < 2; ++c)
#pragma unroll
        for (int d = 0; d < 4; ++d)
#pragma unroll
            for (int r = 0; r < 16; ++r) O[c][d][r] = 0.f;
    float mrun[2] = {-1e30f, -1e30f}, lrun[2] = {0.f, 0.f};
    const int ts = qb * 8, qw0 = qb * 256 + wid * 32;
    int t_lo = 0, t_hi = (S >> 5) - 1;
    { const float Df = (2.f * Bnd + 160.f) / sl2; if (Df < (float)S) { const int D = (int)Df + 1; const int a_ = (qb * 256 - D) >> 5, b_ = (qb * 256 + 255 + D) >> 5; t_lo = a_ > 0 ? a_ : 0; t_hi = b_ < t_hi ? b_ : t_hi; } }
    const int NT = t_hi - t_lo + 1;
    f32x16 bcv; float csign = 1.f;
#pragma unroll
    for (int r = 0; r < 16; ++r) { float cr_ = (float)((r & 3) + 8 * (r >> 2)); asm volatile("" : "+v"(cr_)); bcv[r] = sl2 * cr_; }
    for (int i = 0; i < NT; ++i) {
        int t = ts + i; if (t > t_hi) t -= NT;
        int tn = t + 1; if (tn > t_hi) tn -= NT;
        const int cur = i & 1, k0 = t * 32;
        const LAS unsigned char* kb = kfb + cur * KBUF; const LAS unsigned char* vb = vfb + cur * VBUF;
        const float dqf = (float)(qpos - k0 - 4 * hi);
        const bool diag = (k0 == qw0);
        if (!diag) { const float want = (k0 < qw0) ? 1.f : -1.f;
            if (want != csign) { csign = want;
#pragma unroll
                for (int r = 0; r < 16; ++r) bcv[r] = -bcv[r]; } }
        const float lt = diag ? 0.f : -csign * sl2 * dqf;
        bf16x8 pf[2][2];
#pragma unroll
        for (int c = 0; c < 2; ++c) {
            f32x16 p0 = bcv;
#pragma unroll
            for (int ds = 0; ds < 4; ++ds) {
                const bf16x8 k0f = *(const LAS bf16x8*)(kb + (c * 64 + ds * 16) * 2);
                const bf16x8 qv = (c == 0) ? qf0[ds] : *(const LAS bf16x8*)(qfb + (64 + ds * 16) * 2);
                p0 = __builtin_amdgcn_mfma_f32_32x32x16_bf16(k0f, qv, p0, 0, 0, 0);
            }
            if (diag) {
#pragma unroll
                for (int r = 0; r < 16; ++r) { float cr = (float)((r & 3) + 8 * (r >> 2)); asm volatile("" : "+v"(cr)); p0[r] = p0[r] - bcv[r] - sl2 * __builtin_fabsf(dqf - cr); }
            }
            float rm = p0[0];
#pragma unroll
            for (int r = 1; r < 16; ++r) rm = __builtin_fmaxf(rm, p0[r]);
            rm += lt;
            { auto rr = __builtin_amdgcn_permlane32_swap(__float_as_uint(rm), __float_as_uint(rm), false, false); rm = __builtin_fmaxf(__uint_as_float(rr[0]), __uint_as_float(rr[1])); }
            if (__any(rm > mrun[c] + 8.f)) {
                const float mnew = rm > mrun[c] + 8.f ? rm : mrun[c], alpha = __builtin_amdgcn_exp2f(mrun[c] - mnew);
                mrun[c] = mnew; lrun[c] *= alpha;
#pragma unroll
                for (int d = 0; d < 4; ++d)
#pragma unroll
                    for (int r = 0; r < 16; ++r) O[c][d][r] *= alpha;
            }
            const float mm = mrun[c] - lt;
            float rs = 0.f;
#pragma unroll
            for (int r = 0; r < 16; ++r) { p0[r] = __builtin_amdgcn_exp2f(p0[r] - mm); rs += p0[r]; }
            lrun[c] += rs;
#pragma unroll
            for (int s = 0; s < 2; ++s) {
                u32x4 a;
                a.x = pk2(p0[8 * s + 0], p0[8 * s + 1]); a.y = pk2(p0[8 * s + 2], p0[8 * s + 3]); a.z = pk2(p0[8 * s + 4], p0[8 * s + 5]); a.w = pk2(p0[8 * s + 6], p0[8 * s + 7]);
                pf[c][s] = __builtin_bit_cast(bf16x8, a);
            }
        }
        asm volatile("" ::: "memory");
        if (i + 1 < NT) { const size_t go = (size_t)tn * 32 * PROJW; kr0 = *(const u32x4*)(kg + go); vr0 = *(const u32x4*)(vg + go); }
#pragma unroll
        for (int d = 0; d < 4; ++d)
#pragma unroll
            for (int xs = 0; xs < 2; ++xs) {
                const s16x4 lo = vtr(vb + (16 * xs) * VROW + d * 64), hh = vtr(vb + (16 * xs + 8) * VROW + d * 64);
                const bf16x8 vf = {lo[0], lo[1], lo[2], lo[3], hh[0], hh[1], hh[2], hh[3]};
                O[0][d] = __builtin_amdgcn_mfma_f32_32x32x16_bf16(vf, pf[0][xs], O[0][d], 0, 0, 0);
                O[1][d] = __builtin_amdgcn_mfma_f32_32x32x16_bf16(vf, pf[1][xs], O[1][d], 0, 0, 0);
            }
        if (i + 1 < NT) { const int nb = cur ^ 1; *(LAS u32x4*)(kst + nb * KBUF) = kr0; *(LAS u32x4*)(vst + nb * VBUF) = vr0; }
        __syncthreads();
    }
    const float l0 = lrun[0] + lane_xor(lrun[0], lane, 32), l1 = lrun[1] + lane_xor(lrun[1], lane, 32);
    const float i0 = 1.f / l0, i1 = lam / l1;
    float ss = 0.f;
#pragma unroll
    for (int d = 0; d < 4; ++d)
#pragma unroll
        for (int r = 0; r < 16; ++r) { const float o = O[0][d][r] * i0 - O[1][d][r] * i1; O[0][d][r] = o; ss += o * o; }
    ss += lane_xor(ss, lane, 32);
    const float rn = oscale / sqrtf(ss * (1.f / 128.f) + 1e-5f);
    bf16* yrow = YMIX + (size_t)(tok0 + qpos) * DM + 256 + head * 128;
#pragma unroll
    for (int d = 0; d < 4; ++d)
#pragma unroll
        for (int rg = 0; rg < 4; ++rg) { const int d0 = 32 * d + 8 * rg + 4 * hi; const f32x4 g4 = *(const f32x4*)(subg + d0);
            u32x2 w; w.x = pk2(O[0][d][4 * rg + 0] * rn * g4[0], O[0][d][4 * rg + 1] * rn * g4[1]); w.y = pk2(O[0][d][4 * rg + 2] * rn * g4[2], O[0][d][4 * rg + 3] * rn * g4[3]);
            *(u32x2*)(yrow + d0) = w; }
}
DEV void attn_phase(const Ctx& C, int l, LAS unsigned char* lds, int rep = 0) {
    const bf16* P = (const bf16*)(C.ws + WS_PROJ); bf16* Y = (bf16*)(C.ws + WS_YMIX);
    const float lam = ((const float*)(C.ws + WS_PAR))[1024 + l], li = ((const float*)(C.ws + WS_PAR))[1026 + l];
    const float* subg = C.in[19] + l * 128;
    const float* QN = (const float*)(C.ws + WS_NRM) + l * 320 * 8; const float* KN = (const float*)(C.ws + WS_NRM) + NRM_KN + l * 18 * 8;
    unsigned* qcnt = (unsigned*)(C.ws + WS_BAR) + 16 + 16 * l + 4 * rep;
    volatile LAS int* ubox = (volatile LAS int*)(lds + LDS_Q + 256 * KROW);
    for (;;) {
        if (C.tid == 0) ubox[0] = (int)__hip_atomic_fetch_add(qcnt, 1u, __ATOMIC_RELAXED, __HIP_MEMORY_SCOPE_AGENT);
        __syncthreads();
        const int u = ubox[0];
        if (u >= 1280) break;
        const int head = 3 - u / 320, r = u % 320;
        int tok0, S, qb, seq;
        if (r < 64) { seq = 16 + (r >> 5); qb = r & 31; tok0 = MP + (r >> 5) * SS; S = SS; }
        else { const int v = r - 64; seq = v >> 4; qb = v & 15; tok0 = seq * SP; S = SP; }
        const int blk = (tok0 >> 8) + qb;
        const float b0 = sqrtf(QN[blk * 8 + head * 2] * KN[seq * 8 + head * 2]), b1 = sqrtf(QN[blk * 8 + head * 2 + 1] * KN[seq * 8 + head * 2 + 1]);
        const float Bnd = 1.02f * fmaxf(b0, b1) + 0.5f;
        attn_unit(P, Y, tok0, S, head, qb, lam, 1.f - li, subg, Bnd, lds);
    }
}
}
DEV void grid_barrier(unsigned* bar, unsigned epoch, unsigned G) {
    asm volatile("s_waitcnt vmcnt(0)" ::: "memory");
    __syncthreads();
    if (threadIdx.x == 0) {
        __builtin_amdgcn_fence(__ATOMIC_RELEASE, "agent");
        asm volatile("s_waitcnt vmcnt(0)" ::: "memory");
        __hip_atomic_fetch_add(bar, 1u, __ATOMIC_RELAXED, __HIP_MEMORY_SCOPE_AGENT);
        const unsigned target = epoch * G;
        while (__hip_atomic_load(bar, __ATOMIC_RELAXED, __HIP_MEMORY_SCOPE_AGENT) < target) __builtin_amdgcn_s_sleep(2);
        __builtin_amdgcn_fence(__ATOMIC_ACQUIRE, "agent");
        asm volatile("s_waitcnt vmcnt(0)" ::: "memory");
    }
    __syncthreads();
}
#ifndef REP_ATT
#define REP_ATT 1
#endif
#ifndef REP_FFNUP
#define REP_FFNUP 1
#endif
#ifndef REP_DFT
#define REP_DFT 1
#endif
#ifndef REP_BAR
#define REP_BAR 1
#endif
#ifndef REP_FFNDN
#define REP_FFNDN 1
#endif
#ifndef REP_GATE
#define REP_GATE 1
#endif
#ifndef REP_OUT
#define REP_OUT 1
#endif
#ifndef REP_LN
#define REP_LN 1
#endif
#ifndef REP_PROJ
#define REP_PROJ 1
#endif
#ifndef REP_SCANA
#define REP_SCANA 1
#endif
#ifndef REP_SCANC
#define REP_SCANC 1
#endif
#ifndef REP_CONV
#define REP_CONV 1
#endif
#ifndef REP_BAR
#define REP_BAR 1
#endif
#ifndef REP_FFNDN
#define REP_FFNDN 1
#endif
#ifndef REP_GATE
#define REP_GATE 1
#endif
#ifndef REP_OUT
#define REP_OUT 1
#endif
#ifndef REP_LN
#define REP_LN 1
#endif
#ifndef REP_PRO
#define REP_PRO 1
#endif
struct Args { const float* in[21]; float* out; unsigned char* ws; int ph_lo, ph_hi; };
constexpr int NPHASES = 27;
__global__ void __launch_bounds__(512, 2) mk_fwd(Args a) {
    extern __shared__ __attribute__((aligned(16))) unsigned char lds_raw[];
    LAS unsigned char* lds = (LAS unsigned char*)lds_raw;
    cg::grid_group grid = cg::this_grid();
    Ctx C;
C.in = a.in; C.out = a.out; C.ws = a.ws; C.tid = threadIdx.x; C.lane = C.tid & 63; C.wave = __builtin_amdgcn_readfirstlane(C.tid >> 6); C.G = gridDim.x; C.bid = blockIdx.x;
    unsigned char* ws = a.ws;
    const int lo = a.ph_lo, hi = a.ph_hi;
    int ph = 0; unsigned epoch = 0;
#define PH_BEGIN if (ph >= lo && ph < hi) { { int t_ = threadIdx.x; asm volatile("" : "+v"(t_)); C.tid = t_; C.lane = t_ & 63; C.wave = __builtin_amdgcn_readfirstlane(t_ >> 6); size_t z_ = 0; asm volatile("" : "+s"(z_)); ws = a.ws + z_; C.ws = ws; C.out = a.out + z_;     int g_ = gridDim.x, b_ = blockIdx.x; asm volatile("" : "+s"(g_), "+s"(b_)); C.G = g_; C.bid = b_; }
#define PH_END   if (ph + 1 < hi) { for (int rb_ = 0; rb_ < REP_BAR; ++rb_) grid_barrier((unsigned*)(a.ws + WS_BAR), ++epoch, gridDim.x); } } ++ph;
#define XB ((bf16*)(ws + WS_XB))
#define H ((bf16*)(ws + WS_H))
#define PROJ ((bf16*)(ws + WS_PROJ))
#define YMIX ((bf16*)(ws + WS_YMIX))
    if (ph >= lo && ph < hi) { { int t_ = threadIdx.x; asm volatile("" : "+v"(t_)); C.tid = t_; C.lane = t_ & 63; C.wave = __builtin_amdgcn_readfirstlane(t_ >> 6); }
#ifndef NO_PRO
 for (int rep_ = 0; rep_ < REP_PRO; ++rep_) { phase_prologue(C, lds); __syncthreads(); }
#endif
 __syncthreads(); if (ph + 1 < hi) grid.sync(); } ++ph;
    for (int l = 0; l < 2; ++l) {
        for (int f = 0; f < 2; ++f) {
            if (f == 1) {
                PH_BEGIN
                { pg8::Gemm g{XB, (const bf16*)(ws + WS_WIN) + (size_t)l * 2048 * 1024, 1024, 1024, 1024, 0, 0}; pg8::StaticOrder S; S.init(MTOK, 2048, C.G, C.bid);
                  epi::Proj E{PROJ};
#ifndef NO_PROJ
 for (int rep_ = 0; rep_ < REP_PROJ; ++rep_) pg8::gemm_phase<epi::Proj, pg8::StaticOrder, true, true, 1024, 1024, 1024>(lds, g, S, E);
#endif
 }
                { pg8::Gemm g{(const bf16*)(ws + WS_WF) + (size_t)l * 512 * 1024, XB, 1024, 1024, 1024, 0, 0}; pg8::StaticOrder S; S.init(512, MTOK, C.G, C.bid);
                  epi::FT E{(bf16*)(ws + WS_BTF)};
#ifndef NO_FT
 for (int rep_ = 0; rep_ < REP_PROJ; ++rep_) pg8::gemm_phase<epi::FT, pg8::StaticOrder, true, true, 1024, 1024, 1024>(lds, g, S, E);
#endif
 }
                PH_END
                PH_BEGIN for (int rep_ = 0; rep_ < REP_CONV; ++rep_) phase_conv(C, l); PH_END
                PH_BEGIN
                { pg8::Gemm g{(const bf16*)(ws + WS_XC), (const bf16*)(ws + WS_WG) + (size_t)l * 1024 * 256, 256, 256, 256, 0, 0}; pg8::StaticOrder S; S.init(MTOK, 1024, C.G, C.bid);
                  epi::Raw E{(bf16*)(ws + WS_AU)};
#ifndef NO_GATE
 for (int rep_ = 0; rep_ < REP_GATE; ++rep_) pg8::gemm_phase<epi::Raw, pg8::StaticOrder, true, true, 256, 256, 256>(lds, g, S, E);
#endif
 }
                PH_END
                PH_BEGIN
#ifndef NO_SCANA
 for (int rep_ = 0; rep_ < REP_SCANA; ++rep_) phase_scan<false>(C, l, lds);
 __syncthreads();
#endif
                { pg8::Gemm g{(const bf16*)(ws + WS_DFT), (const bf16*)(ws + WS_BTF), 8192, 8192, 8192, 0, (size_t)256 * 8192}; epi::DftOrder S{C.G, C.bid};
                  epi::DFT E{YMIX, (float*)(ws + WS_PART), 0.001953125f  };
#ifndef NO_DFT
 for (int rep_ = 0; rep_ < REP_DFT; ++rep_) pg8::gemm_phase<epi::DFT, epi::DftOrder, true, true, 8192, 8192, 8192>(lds, g, S, E);
#endif
 }
#ifndef NO_ATT
 for (int rep_ = 0; rep_ < REP_ATT; ++rep_) att::attn_phase(C, l, lds, rep_);
#endif
 PH_END
                PH_BEGIN
phase_dft_combine(C);
#ifndef NO_SCANC
 for (int rep_ = 0; rep_ < REP_SCANC; ++rep_) phase_scan<true>(C, l, lds);
#endif
 PH_END
                PH_BEGIN
                { pg8::Gemm g{YMIX, (const bf16*)(ws + WS_WOUT) + (size_t)l * 1024 * 1024, 1024, 1024, 1024, 0, 0}; pg8::StaticOrder S; S.init(MTOK, 1024, C.G, C.bid);
                  epi::Resid E{C.out, 1.0f, (const float*)(ws + WS_STATS), C.in[2] + (l * 3 + 0) * 1024, C.in[3] + (l * 3 + 0) * 1024, C.out, C.out + (size_t)MP * DM};
#ifndef NO_OUT
 for (int rep_ = 1; rep_ < REP_OUT; ++rep_) { epi::Resid E0{C.out, 0.f, (const float*)(ws + WS_STATS), (const float*)(ws + WS_ONES), (const float*)(ws + WS_ONES) + 1024, C.out, C.out + (size_t)MP * DM, 1.f}; pg8::gemm_phase<epi::Resid, pg8::StaticOrder, true, true, 1024, 1024, 1024>(lds, g, S, E0); }
 pg8::gemm_phase<epi::Resid, pg8::StaticOrder, true, true, 1024, 1024, 1024>(lds, g, S, E);
#endif
 }
                PH_END
                PH_BEGIN for (int rep_ = 0; rep_ < REP_LN; ++rep_) phase_ln(C, C.in[2] + (l * 3 + 1) * 1024, C.in[3] + (l * 3 + 1) * 1024, false); PH_END
            }
            PH_BEGIN
            { pg8::Gemm g{XB, (const bf16*)(ws + WS_WGU) + (size_t)(l * 2 + f) * 5632 * 1024, 1024, 1024, 1024, 0, 0}; pg8::StaticOrder S; S.init(MTOK, 5632, C.G, C.bid);
              epi::SwiGLU E{H};
#ifndef NO_FFNUP
 for (int rep_ = 0; rep_ < REP_FFNUP; ++rep_) pg8::gemm_phase<epi::SwiGLU, pg8::StaticOrder, true, true, 1024, 1024, 1024>(lds, g, S, E);
#endif
 }
            PH_END
            PH_BEGIN
            { pg8::Gemm g{H, (const bf16*)(ws + WS_WD) + (size_t)(l * 2 + f) * 1024 * 2816, 2816, 2816, 2816, 0, 0}; pg8::StaticOrder S; S.init(MTOK, 1024, C.G, C.bid);
              const bool ident_ = (l == 0 && f == 0); const int pidx_ = f == 1 ? l * 3 + 1 : (l - 1) * 3 + 2;
              epi::Resid E{C.out, 0.5f, (const float*)(ws + WS_STATS), ident_ ? (const float*)(ws + WS_ONES) : C.in[2] + pidx_ * 1024, ident_ ? (const float*)(ws + WS_ONES) + 1024 : C.in[3] + pidx_ * 1024, ident_ ? C.in[0] : C.out, ident_ ? C.in[1] : C.out + (size_t)MP * DM};
#ifndef NO_FFNDN
 for (int rep_ = 1; rep_ < REP_FFNDN; ++rep_) { epi::Resid E0{C.out, 0.f, (const float*)(ws + WS_STATS), (const float*)(ws + WS_ONES), (const float*)(ws + WS_ONES) + 1024, C.out, C.out + (size_t)MP * DM, 1.f}; pg8::gemm_phase<epi::Resid, pg8::StaticOrder, true, true, 2816, 2816, 2816>(lds, g, S, E0); }
 pg8::gemm_phase<epi::Resid, pg8::StaticOrder, true, true, 2816, 2816, 2816>(lds, g, S, E);
#endif
 }
            PH_END
            PH_BEGIN for (int rep_ = 0; rep_ < ((l == 1 && f == 1) ? 1 : REP_LN); ++rep_) phase_ln(C, C.in[2] + (l * 3 + 2 * f) * 1024, C.in[3] + (l * 3 + 2 * f) * 1024, l == 1 && f == 1); PH_END
        }
    }
}

#ifndef MK_COOP
#define MK_COOP 1
#endif
extern "C" void kernel_launch(void* const* d_in, const int* in_sizes, int n_in, void* d_out, int out_size, void* d_ws, size_t ws_size, hipStream_t stream) {
    static int grid = 0;
    if (grid == 0) {
        if (n_in != 21 || out_size != MTOK * DM || ws_size < WS_END) { fprintf(stderr, "kernel_launch: unexpected shapes (n_in %d out %d ws %zu)\n", n_in, out_size, ws_size); grid = -1; return; }
        int dev = 0, cus = 0, per_cu = 0;
        hipGetDevice(&dev); hipDeviceGetAttribute(&cus, hipDeviceAttributeMultiprocessorCount, dev);
        hipFuncSetAttribute((const void*)mk_fwd, hipFuncAttributeMaxDynamicSharedMemorySize, LDS_BYTES);
        hipOccupancyMaxActiveBlocksPerMultiprocessor(&per_cu, (const void*)mk_fwd, 512, LDS_BYTES);
        (void)hipGetLastError();
        if (per_cu < 1) per_cu = 1;
        grid = cus;
    }
    if (grid < 0) return;
    if (MK_COOP) (void)hipMemsetAsync((char*)d_ws + WS_BAR, 0, 256, stream);
    Args a{};
    for (int i = 0; i < 21; ++i) a.in[i] = (const float*)d_in[i];
    a.out = (float*)d_out; a.ws = (unsigned char*)d_ws;
#if MK_COOP
    a.ph_lo = 0; a.ph_hi = NPHASES;
    void* args[] = {&a};
    hipError_t e = hipLaunchCooperativeKernel((const void*)mk_fwd, dim3(grid), dim3(512), args, LDS_BYTES, stream);
    if (e != hipSuccess) fprintf(stderr, "cooperative launch failed: %s (grid %d)\n", hipGetErrorString(e), grid);
#else
    for (int p = 0; p < NPHASES; ++p) { a.ph_lo = p; a.ph_hi = p + 1; hipLaunchKernelGGL(mk_fwd, dim3(grid), dim3(512), LDS_BYTES, stream, a); }
#endif
}
```

```cpp
#include <hip/hip_runtime.h>
#include <hip/hip_cooperative_groups.h>
#include <hip/hip_bf16.h>
#include <cstdio>
#include <cstdint>
#include <cmath>
namespace cg = cooperative_groups;
namespace pg8 {
#define PG8_LAS __attribute__((address_space(3)))
typedef unsigned short bf16_t;
typedef short bf16x8 __attribute__((ext_vector_type(8)));
typedef float f32x4 __attribute__((ext_vector_type(4)));
typedef unsigned u32x4 __attribute__((ext_vector_type(4)));
constexpr int BM = 256, BK = 64, HALF = 128, HTB = HALF * BK * 2  , STAGE_BYTES = 8 * HTB, NXCD = 8, WGM = 8;

__host__ __device__ __forceinline__ int lds_byte(int r, int c) { const int st = (r >> 4) * 2 + (c >> 5), rr = r & 15, cc = c & 31, ob = rr * 64 + cc * 2; return st * 1024 + (ob ^ (((ob >> 9) & 1) << 5)); }
__host__ __device__ __forceinline__ void stage_rc(int b, int& R, int& C) { const int st = b / 1024, sb = b % 1024, swz = sb ^ (((sb >> 9) & 1) << 5); R = (st >> 1) * 16 + swz / 64; C = (st & 1) * 32 + (swz % 64) / 2; }
__host__ __device__ __forceinline__ int perm32(int rho) { const int n = rho >> 4, i = rho & 15; return 8 * (i >> 2) + 4 * n + (i & 3); }

struct Unit { int pm, pn, z; };
struct Gemm { const bf16_t* A; const bf16_t* Bt; int K, lda, ldb; size_t zA, zB; };

struct StaticOrder {
    int nM, nN, nwg, G, c;
    __host__ __device__ void init(int M, int N, int G_, int c_) { nM = M / BM; nN = N / BM; nwg = nM * nN; G = G_; c = c_; }
    __host__ __device__ bool next(int i, Unit& u) const {
        const long L = (long)i * G + c; if (L >= nwg) return false;
        int wgid = (int)L; { const int q = nwg / NXCD, r = nwg % NXCD, xcd = wgid % NXCD, off = wgid / NXCD; wgid = (xcd < r ? xcd * (q + 1) : r * (q + 1) + (xcd - r) * q) + off; }
        const int nig = WGM * nN, gid = wgid / nig, fm = gid * WGM, gsz = (nM - fm) < WGM ? (nM - fm) : WGM;
        u.pm = fm + ((wgid % nig) % gsz); u.pn = (wgid % nig) / gsz; u.z = 0; return true;
    }
    __device__ __forceinline__ void a_ready(const Unit&) const {}
    __device__ __forceinline__ void done(const Unit&) const {}
};

__device__ __forceinline__ unsigned cvt_pk_bf16(float lo, float hi) { unsigned r; asm volatile("v_cvt_pk_bf16_f32 %0, %1, %2" : "=v"(r) : "v"(lo), "v"(hi)); return r; }
typedef float f32x2 __attribute__((ext_vector_type(2)));
__device__ __forceinline__ f32x2 gelu_pk(f32x2 v) {
    const f32x2 av = __builtin_elementwise_abs(v), d = av * 0.2316418882f + 1.0f;
    f32x2 t; t.x = __builtin_amdgcn_rcpf(d.x); t.y = __builtin_amdgcn_rcpf(d.y);
    f32x2 q = t * 0.5307027145f + (-0.7265760135f); q = q * t + 0.7107068705f; q = q * t + (-0.142248368f); q = q * t + 0.127414796f; q = q * t;
    const f32x2 s = (v * v) * (-0.72134752044f);
    f32x2 e; e.x = __builtin_amdgcn_exp2f(s.x); e.y = __builtin_amdgcn_exp2f(s.y);
    const f32x2 m = v * (q * e), r = v - m;
    f32x2 o; o.x = v.x < 0.f ? m.x : r.x; o.y = v.y < 0.f ? m.y : r.y; return o;
}

template <int ACT  > struct EpiBf16 {
    static constexpr bool PERM = true, AFTER_DRAIN = false; static_assert(ACT == 0 || ACT == 1, "EpiBf16: ACT is 0 (none) or 1 (gelu_pk)");
    bf16_t* O; int ldc; const float* bias; int split_cols; size_t split_stride; float scale0;
    __device__ __forceinline__ void operator()(const f32x4 (&acc)[2][2][4][2], const Unit& u, int wr, int wc, int fr, int fq) const {
        const int row0 = u.pm * BM + wr * 64 + fr; int colt = u.pn * BM; bf16_t* base = O;
        float sc = 1.f; if (split_cols) { const int t = colt / split_cols; base += (size_t)t * split_stride; colt -= t * split_cols; if (t == 0) sc = scale0; }
        const int col0 = colt + wc * 32 + 8 * fq, bcol0 = u.pn * BM + wc * 32 + 8 * fq;
        f32x4 bv[2][2];
#pragma unroll
        for (int bj = 0; bj < 2; ++bj)
#pragma unroll
            for (int n = 0; n < 2; ++n) bv[bj][n] = bias ? *(const f32x4*)(bias + bcol0 + bj * HALF + 4 * n) : (f32x4){0.f, 0.f, 0.f, 0.f};
#pragma unroll
        for (int ai = 0; ai < 2; ++ai)
#pragma unroll
            for (int m = 0; m < 4; ++m) { bf16_t* rowp = base + (size_t)(row0 + ai * HALF + m * 16) * ldc + col0;
#pragma unroll
                for (int bj = 0; bj < 2; ++bj) { f32x4 v0 = acc[ai][bj][m][0] + bv[bj][0], v1 = acc[ai][bj][m][1] + bv[bj][1];
                    if (ACT == 1) { f32x2 a = gelu_pk((f32x2){v0[0], v0[1]}), b = gelu_pk((f32x2){v0[2], v0[3]}), c = gelu_pk((f32x2){v1[0], v1[1]}), d = gelu_pk((f32x2){v1[2], v1[3]});
                        v0 = (f32x4){a.x, a.y, b.x, b.y}; v1 = (f32x4){c.x, c.y, d.x, d.y}; }
                    v0 = v0 * sc; v1 = v1 * sc; u32x4 w; w.x = cvt_pk_bf16(v0[0], v0[1]); w.y = cvt_pk_bf16(v0[2], v0[3]); w.z = cvt_pk_bf16(v1[0], v1[1]); w.w = cvt_pk_bf16(v1[2], v1[3]);
                    *(u32x4*)(rowp + bj * HALF) = w; } }
    }
};

template <class Epi, class Sched, bool ALIGN_EPI, bool SP2, int KK, int LDA, int LDB>
__device__ __forceinline__ void gemm_phase(PG8_LAS unsigned char* lds, const Gemm g, const Sched& S, const Epi& E) {
    int tid_ = threadIdx.x; asm volatile("" : "+v"(tid_));
    const int tid = tid_, wid = __builtin_amdgcn_readfirstlane(tid >> 6), lane = tid & 63, wr = wid >> 2, wc = wid & 3, fr = lane & 15, fq = lane >> 4;
    constexpr int K = KK, nt = K / BK;
    unsigned voffA[2], voffB[2];
#pragma unroll
    for (int i = 0; i < 2; ++i) { int R, C; stage_rc(tid * 16 + i * 8192, R, C); const int Rb = Epi::PERM ? ((R & ~31) + perm32(R & 31)) : R;
        voffA[i] = (unsigned)(R * LDA + C) * 2u; voffB[i] = (unsigned)(Rb * LDB + C) * 2u; }
    constexpr size_t kstep = (size_t)(BK * 2);
    constexpr size_t hstepA = (size_t)HALF * LDA * 2, hstepB = (size_t)HALF * LDB * 2;
    constexpr size_t tstepA = 2 * hstepA, tstepB = 2 * hstepB;
    const unsigned ldsw = (unsigned)wid * 1024u;
    const int aoff = lds_byte(wr * 64 + fr, fq * 8), boff = lds_byte(wc * 32 + fr, fq * 8);
#define PG8_SA(b, h) (((b) * 2 + (h)) * HTB)
#define PG8_SB(b, h) ((4 + (b) * 2 + (h)) * HTB)
#define PG8_STAGE(bufoff, gbase, voff) do { _Pragma("unroll") for (int _i = 0; _i < 2; ++_i) \
        __builtin_amdgcn_global_load_lds((const unsigned*)((const char*)(gbase) + (voff)[_i]), (PG8_LAS unsigned*)(lds + (bufoff) + ldsw + _i * 8192), 16, 0, 0); } while (0)
#define PG8_LDA(dst, b, h) do { _Pragma("unroll") for (int m = 0; m < 4; ++m) _Pragma("unroll") for (int k = 0; k < 2; ++k) dst[m][k] = *(const PG8_LAS bf16x8*)(lds + PG8_SA(b, h) + aoff + m * 2048 + k * 1024); } while (0)
#define PG8_LDB(dst, b, h) do { _Pragma("unroll") for (int n = 0; n < 2; ++n) _Pragma("unroll") for (int k = 0; k < 2; ++k) dst[n][k] = *(const PG8_LAS bf16x8*)(lds + PG8_SB(b, h) + boff + n * 2048 + k * 1024); } while (0)
#define PG8_MMA(ai, bj, At, Bt) do { __builtin_amdgcn_s_setprio(1); _Pragma("unroll") for (int m = 0; m < 4; ++m) _Pragma("unroll") for (int n = 0; n < 2; ++n) _Pragma("unroll") for (int k = 0; k < 2; ++k) \
        acc[ai][bj][m][n] = __builtin_amdgcn_mfma_f32_16x16x32_bf16(Bt[n][k], At[m][k], acc[ai][bj][m][n], 0, 0, 0); __builtin_amdgcn_s_setprio(0); } while (0)
#define PG8_WAIT_V(n) asm volatile("s_waitcnt vmcnt(" #n ")" ::: "memory")
#define PG8_WAIT_L(n) asm volatile("s_waitcnt lgkmcnt(" #n ")" ::: "memory")
#define PG8_BAR __builtin_amdgcn_s_barrier()
#define PG8_SCHED __builtin_amdgcn_sched_barrier(0)
    Unit cur, nxt; int ui = 0;
    if (!S.next(0, cur)) return;
    f32x4 acc[2][2][4][2];
#pragma unroll
    for (int a = 0; a < 2; ++a)
#pragma unroll
        for (int b = 0; b < 2; ++b)
#pragma unroll
            for (int m = 0; m < 4; ++m)
#pragma unroll
                for (int n = 0; n < 2; ++n) acc[a][b][m][n] = (f32x4){0.f, 0.f, 0.f, 0.f};
    bf16x8 At[4][2], B0[2][2], B1[2][2];
    const char* cA = (const char*)g.A + (size_t)cur.z * g.zA * 2 + (size_t)cur.pm * tstepA; const char* cB = (const char*)g.Bt + (size_t)cur.z * g.zB * 2 + (size_t)cur.pn * tstepB;
    S.a_ready(cur);
    if constexpr (SP2) {
        PG8_STAGE(PG8_SB(0, 0), cB, voffB); PG8_STAGE(PG8_SB(0, 1), cB + hstepB, voffB); PG8_STAGE(PG8_SA(0, 0), cA, voffA); PG8_STAGE(PG8_SA(0, 1), cA + hstepA, voffA);
        if (wr == 1) PG8_BAR;
        PG8_WAIT_V(2); PG8_BAR;
        PG8_STAGE(PG8_SB(1, 0), cB + kstep, voffB); PG8_STAGE(PG8_SA(1, 0), cA + kstep, voffA); PG8_STAGE(PG8_SB(1, 1), cB + hstepB + kstep, voffB);
        PG8_WAIT_V(6); PG8_BAR;
    } else {
        PG8_STAGE(PG8_SB(0, 0), cB, voffB); PG8_STAGE(PG8_SA(0, 0), cA, voffA); PG8_STAGE(PG8_SB(0, 1), cB + hstepB, voffB); PG8_STAGE(PG8_SA(0, 1), cA + hstepA, voffA);
        if (wr == 1) PG8_BAR;
        PG8_WAIT_V(4); PG8_BAR;
        PG8_STAGE(PG8_SB(1, 0), cB + kstep, voffB); PG8_STAGE(PG8_SA(1, 0), cA + kstep, voffA); PG8_STAGE(PG8_SB(1, 1), cB + hstepB + kstep, voffB);
        PG8_WAIT_V(6); PG8_BAR;
    }
    for (;;) {
        const bool has_next = S.next(ui + 1, nxt);
        const char* nA = has_next ? (const char*)g.A + (size_t)nxt.z * g.zA * 2 + (size_t)nxt.pm * tstepA : cA; const char* nB = has_next ? (const char*)g.Bt + (size_t)nxt.z * g.zB * 2 + (size_t)nxt.pn * tstepB : cB;
        for (int t = 0; t < nt; t += 2) {
            const bool last = (t == nt - 2);
            const char* a1 = cA + (size_t)(t + 1) * kstep;
            const char* a2 = last ? nA : cA + (size_t)(t + 2) * kstep; const char* b2 = last ? nB : cB + (size_t)(t + 2) * kstep;
            const char* a3 = a2 + kstep; const char* b3 = b2 + kstep;
            if (last && has_next) S.a_ready(nxt);
            if constexpr (SP2) {
            PG8_LDB(B0, 0, 0); PG8_LDB(B1, 0, 1); PG8_SCHED; PG8_LDA(At, 0, 0); PG8_STAGE(PG8_SA(1, 1), a1 + hstepA, voffA);
            PG8_WAIT_V(8); PG8_WAIT_L(0); PG8_BAR; PG8_MMA(0, 0, At, B0); PG8_MMA(0, 1, At, B1); PG8_BAR; PG8_SCHED;
            PG8_LDA(At, 0, 1); PG8_STAGE(PG8_SB(0, 0), b2, voffB); PG8_STAGE(PG8_SB(0, 1), b2 + hstepB, voffB); PG8_STAGE(PG8_SA(0, 0), a2, voffA);
            PG8_WAIT_V(8); PG8_WAIT_L(0); PG8_BAR; PG8_MMA(1, 0, At, B0); PG8_MMA(1, 1, At, B1); PG8_BAR; PG8_SCHED;
            PG8_LDB(B0, 1, 0); PG8_LDB(B1, 1, 1); PG8_SCHED; PG8_LDA(At, 1, 0); PG8_STAGE(PG8_SA(0, 1), a2 + hstepA, voffA);
            PG8_WAIT_V(8); PG8_WAIT_L(0); PG8_BAR; PG8_MMA(0, 0, At, B0); PG8_MMA(0, 1, At, B1); PG8_BAR; PG8_SCHED;
            PG8_LDA(At, 1, 1); PG8_STAGE(PG8_SB(1, 0), b3, voffB); PG8_STAGE(PG8_SB(1, 1), b3 + hstepB, voffB); PG8_STAGE(PG8_SA(1, 0), a3, voffA);
            PG8_WAIT_V(8); PG8_WAIT_L(0); PG8_BAR; PG8_MMA(1, 0, At, B0); PG8_MMA(1, 1, At, B1); PG8_BAR; PG8_SCHED;
            } else {
            PG8_LDB(B0, 0, 0); PG8_SCHED; PG8_LDA(At, 0, 0); PG8_STAGE(PG8_SA(1, 1), a1 + hstepA, voffA);
            PG8_WAIT_L(8); PG8_BAR; PG8_WAIT_L(0); PG8_MMA(0, 0, At, B0); PG8_BAR; PG8_SCHED;
            PG8_LDB(B1, 0, 1); PG8_STAGE(PG8_SB(0, 0), b2, voffB);
            PG8_BAR; PG8_WAIT_L(0); PG8_MMA(0, 1, At, B1); PG8_BAR;
            PG8_LDA(At, 0, 1); PG8_STAGE(PG8_SA(0, 0), a2, voffA);
            PG8_BAR; PG8_WAIT_L(0); PG8_MMA(1, 0, At, B0); PG8_BAR; PG8_SCHED;
            PG8_STAGE(PG8_SB(0, 1), b2 + hstepB, voffB);
            PG8_WAIT_V(6); PG8_BAR; PG8_MMA(1, 1, At, B1); PG8_BAR;
            PG8_LDB(B0, 1, 0); PG8_SCHED; PG8_LDA(At, 1, 0); PG8_STAGE(PG8_SA(0, 1), a2 + hstepA, voffA);
            PG8_WAIT_L(8); PG8_BAR; PG8_WAIT_L(0); PG8_MMA(0, 0, At, B0); PG8_BAR; PG8_SCHED;
            PG8_LDB(B1, 1, 1); PG8_STAGE(PG8_SB(1, 0), b3, voffB);
            PG8_BAR; PG8_WAIT_L(0); PG8_MMA(0, 1, At, B1); PG8_BAR;
            PG8_LDA(At, 1, 1); PG8_STAGE(PG8_SA(1, 0), a3, voffA);
            PG8_BAR; PG8_WAIT_L(0); PG8_MMA(1, 0, At, B0); PG8_BAR; PG8_SCHED;
            PG8_STAGE(PG8_SB(1, 1), b3 + hstepB, voffB);
            PG8_WAIT_V(6); PG8_BAR; PG8_MMA(1, 1, At, B1); PG8_BAR;
            }
        }
        if constexpr (ALIGN_EPI) { if (wr == 0) PG8_BAR; }
        if constexpr (!Epi::AFTER_DRAIN) { E(acc, cur, wr, wc, fr, fq); S.done(cur); }
        if (!has_next) break;
#pragma unroll
        for (int a = 0; a < 2; ++a)
#pragma unroll
            for (int b = 0; b < 2; ++b)
#pragma unroll
                for (int m = 0; m < 4; ++m)
#pragma unroll
                    for (int n = 0; n < 2; ++n) acc[a][b][m][n] = (f32x4){0.f, 0.f, 0.f, 0.f};
        cur = nxt; cA = nA; cB = nB; ++ui;
        if constexpr (ALIGN_EPI) { if (wr == 1) PG8_BAR; }
    }
    PG8_WAIT_V(0);
    if constexpr (!ALIGN_EPI) { if (wr == 0) PG8_BAR; }
    PG8_BAR;
    if constexpr (Epi::AFTER_DRAIN) { E.fused(acc, cur, wr, wc, fr, fq, lds, wid, lane); S.done(cur); }
#undef PG8_SA
#undef PG8_SB
#undef PG8_STAGE
#undef PG8_LDA
#undef PG8_LDB
#undef PG8_MMA
#undef PG8_WAIT_V
#undef PG8_WAIT_L
#undef PG8_BAR
#undef PG8_SCHED
}
}
#define DEV __device__ __forceinline__
#define LAS __attribute__((address_space(3)))
typedef unsigned short bf16;
typedef float f32x4 __attribute__((ext_vector_type(4)));
typedef float f32x2 __attribute__((ext_vector_type(2)));
typedef float f32x16 __attribute__((ext_vector_type(16)));
typedef unsigned u32x4 __attribute__((ext_vector_type(4)));
typedef unsigned u32x2 __attribute__((ext_vector_type(2)));
typedef short bf16x8 __attribute__((ext_vector_type(8)));
typedef short s16x4 __attribute__((ext_vector_type(4)));
typedef __bf16 bf16x2_t __attribute__((ext_vector_type(2)));

constexpr int DM = 1024, DFF = 2816, MTOK = 81920, MP = 65536, SP = 4096, SS = 8192;
constexpr int PROJW = 2048;
constexpr float LOG2E = 1.4426950408889634f;
constexpr float QSCALE = 0.125f * LOG2E;
constexpr float ALPHA = 1.4142135623730951f;
constexpr size_t MiB = 1u << 20;
constexpr size_t WS_PAR = 0;
constexpr size_t WS_NRM = 256 * 1024;
constexpr int NRM_KN = 2 * 320 * 8;
constexpr size_t WS_BAR = 512 * 1024;
constexpr size_t WS_WGU = 1 * MiB;
constexpr size_t WS_WD = 45 * MiB;
constexpr size_t WS_WIN = 67 * MiB;
constexpr size_t WS_WF = 75 * MiB;
constexpr size_t WS_WOUT = 77 * MiB;
constexpr size_t WS_WG = 81 * MiB;
constexpr size_t WS_DFT = 82 * MiB;
constexpr size_t WS_AGG = 210 * MiB;
constexpr size_t WS_STATS = 215 * MiB;
constexpr size_t WS_ONES = WS_STATS + 768 * 1024;
constexpr size_t WS_PROJ = 216 * MiB;
constexpr size_t WS_BTF = 536 * MiB;
constexpr size_t WS_XC = 632 * MiB;
constexpr size_t WS_YMIX = 672 * MiB;
constexpr size_t WS_AU = 832 * MiB;
constexpr size_t WS_XB = WS_AU;
constexpr size_t WS_H = WS_PROJ;
constexpr size_t WS_PART = 992 * MiB;
constexpr size_t WS_END = 1008 * MiB;
static_assert(WS_H + (size_t)MTOK * DFF * 2 <= WS_YMIX, "H overlay");
constexpr int LDS_BYTES = 147456;

DEV unsigned pk2(float lo, float hi) { f32x2 v = {lo, hi}; bf16x2_t b = __builtin_convertvector(v, bf16x2_t); return __builtin_bit_cast(unsigned, b); }
DEV float bf2f(unsigned short b) { return __uint_as_float((unsigned)b << 16); }
DEV float bflo(unsigned w) { return __uint_as_float(w << 16); }
DEV float bfhi(unsigned w) { return __uint_as_float(w & 0xffff0000u); }
DEV float lane_xor(float v, int lane, int o) { return __int_as_float(__builtin_amdgcn_ds_bpermute((lane ^ o) << 2, __float_as_int(v))); }
DEV float wave_sum(float v, int lane) {
#pragma unroll
    for (int o = 1; o < 64; o <<= 1) v += lane_xor(v, lane, o);
    return v;
}
DEV float sigmoidf_(float x) { return __builtin_amdgcn_rcpf(1.f + __builtin_amdgcn_exp2f(-LOG2E * x)); }

namespace epi {
using pg8::Unit; using pg8::HALF; using pg8::BM;
struct SwiGLU {
    static constexpr bool PERM = true, AFTER_DRAIN = false;
    bf16* H;
    DEV void operator()(const f32x4 (&acc)[2][2][4][2], const Unit& u, int wr, int wc, int fr_, int fq_) const {
        int t__ = threadIdx.x; asm volatile("" : "+v"(t__)); const int fr = t__ & 15, fq = (t__ >> 4) & 3; (void)fr_; (void)fq_;
        const int col0 = u.pn * 128 + wc * 32 + 8 * fq;
#pragma unroll
        for (int ai = 0; ai < 2; ++ai)
#pragma unroll
            for (int m = 0; m < 4; ++m) {
                const int row = u.pm * BM + ai * HALF + wr * 64 + m * 16 + fr;
                float o[8];
#pragma unroll
                for (int n = 0; n < 2; ++n)
#pragma unroll
                    for (int e = 0; e < 4; ++e) { const float g = acc[ai][0][m][n][e], up = acc[ai][1][m][n][e]; o[4 * n + e] = g * sigmoidf_(g) * up; }
                u32x4 w; w.x = pk2(o[0], o[1]); w.y = pk2(o[2], o[3]); w.z = pk2(o[4], o[5]); w.w = pk2(o[6], o[7]);
                *(u32x4*)(H + (size_t)row * DFF + col0) = w; asm volatile("" ::: "memory");
            }
    }
};
struct Resid {
    static constexpr bool PERM = true, AFTER_DRAIN = false;
    float* X; float s; const float* stats; const float* g; const float* b; const float* r0; const float* r1; float al = ALPHA;
    DEV void operator()(const f32x4 (&acc)[2][2][4][2], const Unit& u, int wr, int wc, int fr_, int fq_) const {
        int t__ = threadIdx.x; asm volatile("" : "+v"(t__)); const int fr = t__ & 15, fq = (t__ >> 4) & 3; (void)fr_; (void)fq_;
        const int colb = u.pn * BM + wc * 32 + 8 * fq;
        const float* rsrc = (u.pm * BM < MP) ? r0 : r1 - (size_t)MP * DM;
        f32x4 gv[2][2], bv[2][2];
#pragma unroll
        for (int bj = 0; bj < 2; ++bj)
#pragma unroll
            for (int n = 0; n < 2; ++n) { gv[bj][n] = *(const f32x4*)(g + colb + bj * HALF + n * 4); bv[bj][n] = *(const f32x4*)(b + colb + bj * HALF + n * 4); }
#pragma unroll
        for (int ai = 0; ai < 2; ++ai)
#pragma unroll
            for (int m = 0; m < 4; ++m) {
                const size_t row = (size_t)(u.pm * BM + ai * HALF + wr * 64 + m * 16 + fr);
                const f32x2 st = *(const f32x2*)(stats + row * 2);
                float* rp = X + row * DM + colb; const float* rq = rsrc + row * DM + colb;
#pragma unroll
                for (int bj = 0; bj < 2; ++bj)
#pragma unroll
                    for (int n = 0; n < 2; ++n) { f32x4* p = (f32x4*)(rp + bj * HALF + n * 4); const f32x4 yv = *(const f32x4*)(rq + bj * HALF + n * 4); const f32x4 x = ((yv - st[0]) * st[1]) * gv[bj][n] + bv[bj][n]; *p = x * al + acc[ai][bj][m][n] * s; }
                asm volatile("" ::: "memory");
            }
    }
};
struct Proj {
    static constexpr bool PERM = true, AFTER_DRAIN = false;
    bf16* P;
    DEV void operator()(const f32x4 (&acc)[2][2][4][2], const Unit& u, int wr, int wc, int fr_, int fq_) const {
        int t__ = threadIdx.x; asm volatile("" : "+v"(t__)); const int fr = t__ & 15, fq = (t__ >> 4) & 3; (void)fr_; (void)fq_;
        const float sc = (u.pn == 2 || u.pn == 3) ? QSCALE : 1.f;
        const int col0 = u.pn * BM + wc * 32 + 8 * fq;
#pragma unroll
        for (int ai = 0; ai < 2; ++ai)
#pragma unroll
            for (int m = 0; m < 4; ++m) {
                bf16* rp = P + (size_t)(u.pm * BM + ai * HALF + wr * 64 + m * 16 + fr) * PROJW + col0;
#pragma unroll
                for (int bj = 0; bj < 2; ++bj) { const f32x4 v0 = acc[ai][bj][m][0] * sc, v1 = acc[ai][bj][m][1] * sc;
                    u32x4 w; w.x = pk2(v0[0], v0[1]); w.y = pk2(v0[2], v0[3]); w.z = pk2(v1[0], v1[1]); w.w = pk2(v1[2], v1[3]);
                    *(u32x4*)(rp + bj * HALF) = w; }
                asm volatile("" ::: "memory");
            }
    }
};
struct FT {
    static constexpr bool PERM = true, AFTER_DRAIN = false;
    bf16* BP;
    DEV void operator()(const f32x4 (&acc)[2][2][4][2], const Unit& u, int wr, int wc, int fr_, int fq_) const {
        int t__ = threadIdx.x; asm volatile("" : "+v"(t__)); const int fr = t__ & 15, fq = (t__ >> 4) & 3; (void)fr_; (void)fq_;
        const int which = u.pm;
#pragma unroll
        for (int ai = 0; ai < 2; ++ai)
#pragma unroll
            for (int m = 0; m < 4; ++m) {
                const int n = ai * HALF + wr * 64 + m * 16 + fr;
#pragma unroll
                for (int bj = 0; bj < 2; ++bj) {
                    const int t0 = u.pn * BM + bj * HALF + wc * 32 + 8 * fq;
                    const f32x4 v0 = acc[ai][bj][m][0], v1 = acc[ai][bj][m][1];
                    if (t0 < MP) {
                        const int seq = t0 >> 12, s = t0 & 4095;
                        u32x4 w; w.x = pk2(v0[0], v0[1]); w.y = pk2(v0[2], v0[3]); w.z = pk2(v1[0], v1[1]); w.w = pk2(v1[2], v1[3]);
                        *(u32x4*)(BP + ((size_t)seq * 256 + n) * 8192 + which * 4096 + s) = w;
                    } else {
                        const int tt = t0 - MP, seq2 = tt >> 13, s = tt & 8191;
                        u32x2 ev, od; ev.x = pk2(v0[0], v0[2]); ev.y = pk2(v1[0], v1[2]); od.x = pk2(v0[1], v0[3]); od.y = pk2(v1[1], v1[3]);
                        bf16* be = BP + ((size_t)(16 + seq2 * 2) * 256 + n) * 8192 + which * 4096 + (s >> 1);
                        *(u32x2*)be = ev; *(u32x2*)(be + (size_t)256 * 8192) = od;
                    }
                }
                asm volatile("" ::: "memory");
            }
    }
};
struct DFT {
    static constexpr bool PERM = true, AFTER_DRAIN = false;
    bf16* Y; float* PART; float scale;
    DEV void operator()(const f32x4 (&acc)[2][2][4][2], const Unit& u, int wr, int wc, int fr_, int fq_) const {
        int t__ = threadIdx.x; asm volatile("" : "+v"(t__)); const int fr = t__ & 15, fq = (t__ >> 4) & 3; (void)fr_; (void)fq_;
        const int col0 = wc * 32 + 8 * fq;
        if (u.z < 16) {
#pragma unroll
            for (int ai = 0; ai < 2; ++ai)
#pragma unroll
                for (int m = 0; m < 4; ++m) {
                    bf16* rp = Y + (size_t)(u.z * SP + u.pm * BM + ai * HALF + wr * 64 + m * 16 + fr) * DM + 768 + col0;
#pragma unroll
                    for (int bj = 0; bj < 2; ++bj) { const f32x4 v0 = acc[ai][bj][m][0] * scale, v1 = acc[ai][bj][m][1] * scale;
                        u32x4 w; w.x = pk2(v0[0], v0[1]); w.y = pk2(v0[2], v0[3]); w.z = pk2(v1[0], v1[1]); w.w = pk2(v1[2], v1[3]);
                        *(u32x4*)(rp + bj * HALF) = w; }
                    asm volatile("" ::: "memory");
                }
        } else {
#pragma unroll
            for (int ai = 0; ai < 2; ++ai)
#pragma unroll
                for (int m = 0; m < 4; ++m) {
                    float* rp = PART + ((size_t)(u.z - 16) * 4096 + (u.pm & 15) * BM + ai * HALF + wr * 64 + m * 16 + fr) * 256 + col0;
#pragma unroll
                    for (int bj = 0; bj < 2; ++bj) { *(f32x4*)(rp + bj * HALF) = acc[ai][bj][m][0]; *(f32x4*)(rp + bj * HALF + 4) = acc[ai][bj][m][1]; }
                    asm volatile("" ::: "memory");
                }
        }
    }
};
struct DftOrder {
    int G, c;
    DEV bool next(int i, Unit& u) const { const int L = i * G + c; if (L >= 320) return false; u.pn = 0;
        if (L < 288) { const int pmA = L / 18, zi = L - pmA * 18; u.pm = pmA; u.z = zi < 16 ? zi : 16 + 2 * (zi - 16); }
        else { const int L2 = L - 288; u.pm = 16 + (L2 >> 1); u.z = 17 + 2 * (L2 & 1); }
        return true; }
    DEV void a_ready(const Unit&) const {}
    DEV void done(const Unit&) const {}
};
struct Raw {
    static constexpr bool PERM = true, AFTER_DRAIN = false;
    bf16* P;
    DEV void operator()(const f32x4 (&acc)[2][2][4][2], const Unit& u, int wr, int wc, int fr_, int fq_) const {
        int t__ = threadIdx.x; asm volatile("" : "+v"(t__)); const int fr = t__ & 15, fq = (t__ >> 4) & 3; (void)fr_; (void)fq_;
        const int col0 = u.pn * BM + wc * 32 + 8 * fq;
#pragma unroll
        for (int ai = 0; ai < 2; ++ai)
#pragma unroll
            for (int m = 0; m < 4; ++m) {
                bf16* rp = P + (size_t)(u.pm * BM + ai * HALF + wr * 64 + m * 16 + fr) * 1024 + col0;
#pragma unroll
                for (int bj = 0; bj < 2; ++bj) { const f32x4 v0 = acc[ai][bj][m][0], v1 = acc[ai][bj][m][1];
                    u32x4 w; w.x = pk2(v0[0], v0[1]); w.y = pk2(v0[2], v0[3]); w.z = pk2(v1[0], v1[1]); w.w = pk2(v1[2], v1[3]);
                    *(u32x4*)(rp + bj * HALF) = w; }
                asm volatile("" ::: "memory");
            }
    }
};
struct BatchOrder {
    int lz, nM, G, c;
    DEV bool next(int i, Unit& u) const { const int L = i * G + c; if (L >= (nM << lz)) return false; u.pm = L >> lz; u.z = L & ((1 << lz) - 1); u.pn = 0; return true; }
    DEV void a_ready(const Unit&) const {}
    DEV void done(const Unit&) const {}
};
}
struct Ctx {
    const float* const* in; float* out; unsigned char* ws;
    int tid, lane, wave, G, bid;
};
#ifndef RPA
#define RPA 1
#endif
#ifndef RPB
#define RPB 1
#endif
#ifndef RPE
#define RPE 1
#endif
#ifndef RPF
#define RPF 1
#endif
DEV void transpose_item(const float* W, int ldw, int srccol0, bf16* WT, int ldo, int dstrow0, int k0, LAS float* scr, int lane) {
#pragma unroll 8
    for (int i = 0; i < 32; ++i) { const int kk = 2 * i + (lane >> 5); scr[kk * 33 + (lane & 31)] = W[(size_t)(k0 + kk) * ldw + srccol0 + (lane & 31)]; }
    asm volatile("s_waitcnt lgkmcnt(0)" ::: "memory");
    const int c = lane & 7;
#pragma unroll
    for (int j = 0; j < 4; ++j) { const int n = (lane >> 3) + 8 * j; const LAS float* s = scr + (8 * c) * 33 + n;
        u32x4 o; o.x = pk2(s[0 * 33], s[1 * 33]); o.y = pk2(s[2 * 33], s[3 * 33]); o.z = pk2(s[4 * 33], s[5 * 33]); o.w = pk2(s[6 * 33], s[7 * 33]);
        *(u32x4*)(WT + (size_t)(dstrow0 + n) * ldo + k0 + 8 * c) = o; }
    asm volatile("s_waitcnt lgkmcnt(0)" ::: "memory");
}
DEV void phase_prologue(const Ctx& C, LAS unsigned char* lds) {
    const int gw = C.bid * 8 + C.wave, NGW = C.G * 8;
    const long gt = (long)C.bid * 512 + C.tid, NGT = (long)C.G * 512;
    unsigned char* ws = C.ws;
for (int rp_ = 0; rp_ < RPA; ++rp_) {
    {
        LAS float* scr = (LAS float*)(lds + C.wave * 16384);
        for (int it = gw; it < 2 * 9984; it += NGW) {
            const int l = it / 9984, r = it % 9984; int j, q;
            if (r < 8448) { j = r / 1408; q = r % 1408; } else if (r < 9472) { j = 6; q = r - 8448; } else { j = 7; q = r - 9472; }
            const float* src; int ldw, K, N; bf16* dst; int inter = 0, ioff = 0;
            if (j == 0 || j == 1 || j == 3 || j == 4) { const int f = j >= 3; const int up = (j == 1 || j == 4);
                src = C.in[(f ? 7 : 4) + up] + (size_t)l * DM * DFF; ldw = DFF; K = DM; N = DFF; dst = (bf16*)(ws + WS_WGU) + (size_t)(l * 2 + f) * 5632 * 1024; inter = 1; ioff = up ? 128 : 0; }
            else if (j == 2 || j == 5) { const int f = j == 5; src = C.in[f ? 9 : 6] + (size_t)l * DFF * DM; ldw = DM; K = DFF; N = DM; dst = (bf16*)(ws + WS_WD) + (size_t)(l * 2 + f) * 1024 * 2816; }
            else if (j == 6) { src = C.in[10] + (size_t)l * DM * 2304; ldw = 2304; K = DM; N = 2048; dst = (bf16*)(ws + WS_WIN) + (size_t)l * 2048 * 1024; }
            else { src = C.in[20] + (size_t)l * DM * DM; ldw = DM; K = DM; N = DM; dst = (bf16*)(ws + WS_WOUT) + (size_t)l * 1024 * 1024; }
            const int nblk = N / 32, kb = q / nblk, nb = q % nblk, n0 = 32 * nb;
            const int drow = inter ? (256 * (n0 >> 7) + (n0 & 127) + ioff) : n0;
            transpose_item(src, ldw, n0, dst, K, drow, 64 * kb, scr, C.lane);
        }
    }
}
    for (int rp_ = 0; rp_ < RPB; ++rp_) {
    {
        LAS float* tw = (LAS float*)(lds + 8 * 16384);
        if (C.tid < 64) { float sn, cs; sincospif((float)C.tid * (1.0f / 32.0f), &sn, &cs); tw[C.tid] = cs; tw[64 + C.tid] = sn; }
        __syncthreads();
        for (long it = gt; it < 2L * 512 * 128; it += NGT) {
            const int l = (int)(it / (512 * 128)), r = (int)(it % (512 * 128)), nrow = r >> 7, k0 = (r & 127) * 8;
            const int which = nrow >> 8, g = (nrow >> 6) & 3, cp = nrow & 63;
            const float* wsrc = C.in[10] + (size_t)l * DM * 2304 + 2048 + 64 * g;
            float o[8];
#pragma unroll
            for (int kk = 0; kk < 8; ++kk) {
                const float* wr_ = wsrc + (size_t)(k0 + kk) * 2304; float a = 0.f;
                for (int c = 0; c < 64; c += 4) { const f32x4 w4 = *(const f32x4*)(wr_ + c);
                    a += w4[0] * tw[which * 64 + (((c + 0) * cp) & 63)] + w4[1] * tw[which * 64 + (((c + 1) * cp) & 63)] + w4[2] * tw[which * 64 + (((c + 2) * cp) & 63)] + w4[3] * tw[which * 64 + (((c + 3) * cp) & 63)]; }
                o[kk] = a;
            }
            u32x4 w; w.x = pk2(o[0], o[1]); w.y = pk2(o[2], o[3]); w.z = pk2(o[4], o[5]); w.w = pk2(o[6], o[7]);
            *(u32x4*)((bf16*)(ws + WS_WF) + ((size_t)l * 512 + nrow) * 1024 + k0) = w;
        }
    }
}
    for (long it = gt; it < 2L * 1024 * 32; it += NGT) {
        const int l = (int)(it / (1024 * 32)), r = (int)(it % (1024 * 32)), n = r >> 5, k0 = (r & 31) * 8;
        const int tn = n >> 8, dir = tn >> 1, chh = tn & 1, within = n & 255, gate = within >> 7, ch = chh * 128 + (within & 127), hb = ch >> 6, jj = ch & 63;
        u32x4 w = {0u, 0u, 0u, 0u};
        if ((k0 >> 6) == hb) {
            const float* src = C.in[gate ? 15 : 13] + ((size_t)((l * 2 + dir) * 4 + hb) * 64) * 64 + jj;
            float o[8];
#pragma unroll
            for (int kk = 0; kk < 8; ++kk) o[kk] = src[(size_t)((k0 & 63) + kk) * 64];
            w.x = pk2(o[0], o[1]); w.y = pk2(o[2], o[3]); w.z = pk2(o[4], o[5]); w.w = pk2(o[6], o[7]);
        }
        *(u32x4*)((bf16*)(ws + WS_WG) + ((size_t)l * 1024 + n) * 256 + k0) = w;
    }
    if (gt < 1024) { const float lam = C.in[17][gt]; ((float*)(ws + WS_PAR))[gt] = 8.f * log1pf(expf(-lam)); }
    if (gt >= 1024 && gt < 1026) { const int l = (int)gt - 1024; const float* lq = C.in[18] + l * 256; float s1 = 0.f, s2 = 0.f;
        for (int i = 0; i < 64; ++i) { s1 += lq[i] * lq[64 + i]; s2 += lq[128 + i] * lq[192 + i]; }
        const float li = 0.8f - 0.6f * expf(-0.3f * (float)l);
        ((float*)(ws + WS_PAR))[1024 + l] = expf(s1) - expf(s2) + li; ((float*)(ws + WS_PAR))[1026 + l] = li; }
    if (gt < NRM_KN + 2 * 18 * 8) ((unsigned*)(ws + WS_NRM))[gt] = 0u;
    if (gt < MTOK) *(f32x2*)((float*)(ws + WS_STATS) + gt * 2) = (f32x2){0.f, 1.f};
    if (gt < 2048) ((float*)(ws + WS_ONES))[gt] = gt < 1024 ? 1.f : 0.f;
for (int rp_ = 0; rp_ < RPE; ++rp_) {
for (int rp_ = 0; rp_ < RPE; ++rp_) {
    for (long it = gt; it < 8192L * 1024; it += NGT) {
        const int row = (int)(it >> 10), k0 = (int)(it & 1023) * 8, odd = row >> 12, sp = row & 4095, neg = k0 >> 12, nb = k0 & 4095;
        float o[8];
#pragma unroll
        for (int e = 0; e < 8; ++e) { const int n = nb + e; float sn, cs;
            if (!odd) { const int idx = (n * sp) & 4095; sincospif((float)idx * (1.0f / 2048.0f), &sn, &cs); }
            else { const int idx = ((2 * n + 1) * sp) & 8191; sincospif((float)idx * (1.0f / 4096.0f), &sn, &cs); }
            o[e] = neg ? -sn : cs; }
        u32x4 w; w.x = pk2(o[0], o[1]); w.y = pk2(o[2], o[3]); w.z = pk2(o[4], o[5]); w.w = pk2(o[6], o[7]);
        *(u32x4*)((bf16*)(ws + WS_DFT) + (size_t)row * 8192 + k0) = w;
    }
}
    {
        const f32x4* xp = (const f32x4*)C.in[0]; const f32x4* xs = (const f32x4*)C.in[1]; u32x2* xb = (u32x2*)(ws + WS_XB);
        const long NP = (long)MP * 256, NT = (long)MTOK * 256;
        for (long it = gt; it < NT; it += NGT) { const f32x4 v = it < NP ? xp[it] : xs[it - NP]; u32x2 w; w.x = pk2(v[0], v[1]); w.y = pk2(v[2], v[3]); xb[it] = w; }
    }
}
}
DEV void ln_row(const f32x4 (&cur)[4], const f32x4 (&gv)[4], const f32x4 (&bv)[4], int m, int lane, float* out, unsigned char* ws, bool final_) {
    float s = 0.f, q = 0.f;
#pragma unroll
    for (int j = 0; j < 4; ++j) { s += (cur[j][0] + cur[j][1]) + (cur[j][2] + cur[j][3]); q += (cur[j][0] * cur[j][0] + cur[j][1] * cur[j][1]) + (cur[j][2] * cur[j][2] + cur[j][3] * cur[j][3]); }
#pragma unroll
    for (int o = 1; o < 64; o <<= 1) { const float s2 = lane_xor(s, lane, o), q2 = lane_xor(q, lane, o); s += s2; q += q2; }
    const float mean = s * (1.f / DM), var = __builtin_fmaxf(q * (1.f / DM) - mean * mean, 0.f), rstd = 1.f / sqrtf(var + 1e-5f);
    if (final_) {
        f32x4* xr = (f32x4*)(out + (size_t)m * DM) + lane;
#pragma unroll
        for (int j = 0; j < 4; ++j) xr[64 * j] = (cur[j] - mean) * rstd * gv[j] + bv[j];
    } else {
        u32x2* o8 = (u32x2*)((bf16*)(ws + WS_XB) + (size_t)m * DM) + lane;
#pragma unroll
        for (int j = 0; j < 4; ++j) { const f32x4 y = (cur[j] - mean) * rstd * gv[j] + bv[j]; u32x2 w; w.x = pk2(y[0], y[1]); w.y = pk2(y[2], y[3]); o8[64 * j] = w; }
        if (lane == 0) *(f32x2*)((float*)(ws + WS_STATS) + (size_t)m * 2) = (f32x2){mean, rstd};
    }
}
DEV void phase_ln(const Ctx& C, const float* g, const float* b, bool final_) {
    const int gw = C.bid * 8 + C.wave, NGW = C.G * 8, lane = C.lane;
    f32x4 gv[4], bv[4];
#pragma unroll
    for (int j = 0; j < 4; ++j) { gv[j] = ((const f32x4*)g)[lane + 64 * j]; bv[j] = ((const f32x4*)b)[lane + 64 * j]; }
    f32x4 c0[4], c1[4], n0[4], n1[4];
    auto ld = [&](f32x4 (&d)[4], int m) { const int mm = m < MTOK ? m : gw;
#pragma unroll
        for (int j = 0; j < 4; ++j) d[j] = ((const f32x4*)(C.out + (size_t)mm * DM))[lane + 64 * j]; };
    ld(c0, gw); ld(c1, gw + NGW);
    for (int m = gw; m < MTOK; m += 2 * NGW) {
        ld(n0, m + 2 * NGW); ld(n1, m + 3 * NGW);
        ln_row(c0, gv, bv, m, lane, C.out, C.ws, final_);
        if (m + NGW < MTOK) ln_row(c1, gv, bv, m + NGW, lane, C.out, C.ws, final_);
#pragma unroll
        for (int j = 0; j < 4; ++j) { c0[j] = n0[j]; c1[j] = n1[j]; }
    }
}
DEV void phase_dft_combine(const Ctx& C) {
    const long gt = (long)C.bid * 512 + C.tid, NGT = (long)C.G * 512;
    const float* PART = (const float*)(C.ws + WS_PART); bf16* Y = (bf16*)(C.ws + WS_YMIX); const float sc = 0.001381067932004976f;
    for (long it = gt; it < 2L * 4096 * 64; it += NGT) {
        const int seq2 = (int)(it >> 18), r = (int)(it & 262143), sp = r >> 6, c = (r & 63) * 4;
        const f32x4 p1 = *(const f32x4*)(PART + ((size_t)(seq2 * 2) * 4096 + sp) * 256 + c), p2 = *(const f32x4*)(PART + ((size_t)(seq2 * 2 + 1) * 4096 + sp) * 256 + c);
        const f32x4 lo = (p1 + p2) * sc, hi = (p1 - p2) * sc;
        u32x2 wl, wh; wl.x = pk2(lo[0], lo[1]); wl.y = pk2(lo[2], lo[3]); wh.x = pk2(hi[0], hi[1]); wh.y = pk2(hi[2], hi[3]);
        bf16* yl = Y + (size_t)(MP + seq2 * SS + sp) * DM + 768 + c;
        *(u32x2*)yl = wl; *(u32x2*)(yl + (size_t)4096 * DM) = wh;
    }
}
DEV void phase_conv(const Ctx& C, int l) {
    const long gt = (long)C.bid * 512 + C.tid, NGT = (long)C.G * 512;
    const bf16* P = (const bf16*)(C.ws + WS_PROJ); bf16* XC = (bf16*)(C.ws + WS_XC);
    const float* cw = C.in[11] + l * 4 * 256; const float* cb = C.in[12] + l * 256;
    for (long it = gt; it < (long)MTOK * 32; it += NGT) {
        const int tok = (int)(it >> 5), c0 = (int)(it & 31) * 8;
        const int pos = tok < MP ? (tok & 4095) : ((tok - MP) & 8191), S = tok < MP ? SP : SS;
        float a[8];
        { const f32x4 b0 = *(const f32x4*)(cb + c0), b1 = *(const f32x4*)(cb + c0 + 4); a[0] = b0[0]; a[1] = b0[1]; a[2] = b0[2]; a[3] = b0[3]; a[4] = b1[0]; a[5] = b1[1]; a[6] = b1[2]; a[7] = b1[3]; }
#pragma unroll
        for (int j = 0; j < 4; ++j) { const int tt = pos - 2 + j;
            if (tt >= 0 && tt < S) { const u32x4 xw = *(const u32x4*)(P + (size_t)(tok - 2 + j) * PROJW + c0);
                const f32x4 w0 = *(const f32x4*)(cw + j * 256 + c0), w1 = *(const f32x4*)(cw + j * 256 + c0 + 4);
                a[0] += w0[0] * bflo(xw.x); a[1] += w0[1] * bfhi(xw.x); a[2] += w0[2] * bflo(xw.y); a[3] += w0[3] * bfhi(xw.y);
                a[4] += w1[0] * bflo(xw.z); a[5] += w1[1] * bfhi(xw.z); a[6] += w1[2] * bflo(xw.w); a[7] += w1[3] * bfhi(xw.w); } }
        u32x4 w; w.x = pk2(a[0], a[1]); w.y = pk2(a[2], a[3]); w.z = pk2(a[4], a[5]); w.w = pk2(a[6], a[7]);
        *(u32x4*)(XC + (size_t)tok * 256 + c0) = w;
    }
    unsigned* QN = (unsigned*)(C.ws + WS_NRM) + l * 320 * 8; unsigned* KN = (unsigned*)(C.ws + WS_NRM) + NRM_KN + l * 18 * 8;
    for (long it = gt; it < (long)MTOK * 8; it += NGT) {
        const int tok = (int)(it >> 3), hm = (int)(it & 7);
        const bf16* qp = P + (size_t)tok * PROJW + 512 + hm * 64; float sq = 0.f, sk = 0.f;
#pragma unroll
        for (int j = 0; j < 8; ++j) { const u32x4 a = *(const u32x4*)(qp + 8 * j), k4 = *(const u32x4*)(qp + 512 + 8 * j);
            sq += bflo(a.x) * bflo(a.x) + bfhi(a.x) * bfhi(a.x) + bflo(a.y) * bflo(a.y) + bfhi(a.y) * bfhi(a.y) + bflo(a.z) * bflo(a.z) + bfhi(a.z) * bfhi(a.z) + bflo(a.w) * bflo(a.w) + bfhi(a.w) * bfhi(a.w);
            sk += bflo(k4.x) * bflo(k4.x) + bfhi(k4.x) * bfhi(k4.x) + bflo(k4.y) * bflo(k4.y) + bfhi(k4.y) * bfhi(k4.y) + bflo(k4.z) * bflo(k4.z) + bfhi(k4.z) * bfhi(k4.z) + bflo(k4.w) * bflo(k4.w) + bfhi(k4.w) * bfhi(k4.w); }
#pragma unroll
        for (int o = 8; o < 64; o <<= 1) { sq = fmaxf(sq, lane_xor(sq, C.lane, o)); sk = fmaxf(sk, lane_xor(sk, C.lane, o)); }
        if (C.lane < 8) { const int seq = tok < MP ? (tok >> 12) : 16 + ((tok - MP) >> 13);
            atomicMax(QN + (tok >> 8) * 8 + hm, __float_as_uint(sq)); atomicMax(KN + seq * 8 + hm, __float_as_uint(sk)); }
    }
}
DEV float fsig(float x) { return __builtin_amdgcn_rcpf(1.f + __builtin_amdgcn_exp2f(-LOG2E * x)); }
DEV void gate_eval(float rp, float ip, float xc, float ba, float bx, float sp8, float& la2, float& u) {
    const float r = fsig(rp + ba), ig = fsig(ip + bx);
    la2 = -sp8 * r * LOG2E;
    const float em = __builtin_fmaxf(1.f - __builtin_amdgcn_exp2f(2.f * la2), 0.f);
    u = __builtin_amdgcn_sqrtf(em) * ig * xc;
}
DEV float gelu_tanh(float x) { const float z = 0.7978845608028654f * (x + 0.044715f * x * x * x); const float e = __builtin_amdgcn_exp2f(2.f * LOG2E * z); return 0.5f * x * (2.f - 2.f * __builtin_amdgcn_rcpf(e + 1.f)); }
constexpr int SROW = 68;
typedef _Float16 h16x2 __attribute__((ext_vector_type(2)));
DEV unsigned pkh(float a, float b) { return __builtin_bit_cast(unsigned, __builtin_amdgcn_cvt_pkrtz(a, b)); }
template <int DIRV> DEV void gate_stage(const bf16* gbase, const bf16* xcb, int chb, int tl, int cg, LAS unsigned* sl, const float* pba, const float* pbx, const float* par) {
    const int col = (DIRV * 2 + (chb >> 7)) * 256 + (chb & 127);
    float ba[8], bx[8], sp[8];
#pragma unroll
    for (int q = 0; q < 2; ++q) { const f32x4 a = *(const f32x4*)(pba + DIRV * 256 + chb + 4 * q), b = *(const f32x4*)(pbx + DIRV * 256 + chb + 4 * q), s = *(const f32x4*)(par + DIRV * 256 + chb + 4 * q);
#pragma unroll
        for (int e = 0; e < 4; ++e) { ba[4 * q + e] = a[e]; bx[4 * q + e] = b[e]; sp[4 * q + e] = s[e]; } }
#pragma unroll
    for (int j = 0; j < 8; ++j) {
        const int t = 8 * j + tl;
        const u32x4 rw = *(const u32x4*)(gbase + (size_t)t * 1024 + col), iw = *(const u32x4*)(gbase + (size_t)t * 1024 + col + 128), xw = *(const u32x4*)(xcb + (size_t)t * 256);
        const float rp[8] = {bflo(rw.x), bfhi(rw.x), bflo(rw.y), bfhi(rw.y), bflo(rw.z), bfhi(rw.z), bflo(rw.w), bfhi(rw.w)};
        const float ip[8] = {bflo(iw.x), bfhi(iw.x), bflo(iw.y), bfhi(iw.y), bflo(iw.z), bfhi(iw.z), bflo(iw.w), bfhi(iw.w)};
        const float xc[8] = {bflo(xw.x), bfhi(xw.x), bflo(xw.y), bfhi(xw.y), bflo(xw.z), bfhi(xw.z), bflo(xw.w), bfhi(xw.w)};
        unsigned w[8];
#pragma unroll
        for (int e = 0; e < 8; ++e) { float la, u; gate_eval(rp[e], ip[e], xc[e], ba[e], bx[e], sp[e], la, u); w[e] = pkh(la, u); }
        LAS u32x4* dst = (LAS u32x4*)(sl + t * SROW + cg * 8);
        dst[0] = (u32x4){w[0], w[1], w[2], w[3]}; dst[1] = (u32x4){w[4], w[5], w[6], w[7]};
    }
    asm volatile("s_waitcnt lgkmcnt(0)" ::: "memory");
}
template <bool FINAL> DEV void phase_scan(const Ctx& C, int l, LAS unsigned char* lds) {
    const int gw = C.bid * 8 + C.wave, NGW = C.G * 8, lane = C.lane, tl = lane >> 3, cg = lane & 7;
    const bf16* GP = (const bf16*)(C.ws + WS_AU); float* AGG = (float*)(C.ws + WS_AGG); const bf16* XC = (const bf16*)(C.ws + WS_XC);
    const bf16* P = (const bf16*)(C.ws + WS_PROJ); bf16* Y = (bf16*)(C.ws + WS_YMIX);
    const float* par = (const float*)(C.ws + WS_PAR) + l * 512; const float* pba = C.in[14] + l * 512; const float* pbx = C.in[16] + l * 512;
    LAS unsigned* sl = (LAS unsigned*)(lds + C.wave * (64 * SROW * 4));
    for (int it = gw; it < 1280 * 4; it += NGW) {
        const int cidx = it >> 2, g4 = it & 3, ch = g4 * 64 + lane, chb = g4 * 64 + cg * 8;
        const bf16* gbase = GP + (size_t)cidx * 64 * 1024; const bf16* xcb = XC + (size_t)cidx * 64 * 256 + chb;
        if (!FINAL) {
            gate_stage<0>(gbase, xcb, chb, tl, cg, sl, pba, pbx, par);
            { float Ps = 0.f, h = 0.f;
#pragma unroll 16
              for (int t = 0; t < 64; ++t) { const h16x2 w = __builtin_bit_cast(h16x2, sl[t * SROW + lane]); const float la = (float)w[0]; h = __builtin_amdgcn_exp2f(la) * h + (float)w[1]; Ps += la; }
              *(f32x2*)(AGG + ((size_t)(cidx * 2 + 0) * 256 + ch) * 2) = (f32x2){Ps, h}; }
            asm volatile("s_waitcnt lgkmcnt(0)" ::: "memory");
            gate_stage<1>(gbase, xcb, chb, tl, cg, sl, pba, pbx, par);
            { float Ps = 0.f, h = 0.f;
#pragma unroll 16
              for (int t = 63; t >= 0; --t) { const h16x2 w = __builtin_bit_cast(h16x2, sl[t * SROW + lane]); const float la = (float)w[0]; h = __builtin_amdgcn_exp2f(la) * h + (float)w[1]; Ps += la; }
              *(f32x2*)(AGG + ((size_t)(cidx * 2 + 1) * 256 + ch) * 2) = (f32x2){Ps, h}; }
            asm volatile("s_waitcnt lgkmcnt(0)" ::: "memory");
        } else {
            int c0, c1; if (cidx < 1024) { c0 = cidx & ~63; c1 = c0 + 64; } else { c0 = 1024 + ((cidx - 1024) & ~127); c1 = c0 + 128; }
            float hin = 0.f, hbin = 0.f;
#pragma unroll 16
            for (int c = c0; c < cidx; ++c) { const f32x2 a = *(const f32x2*)(AGG + ((size_t)(c * 2 + 0) * 256 + ch) * 2); hin = __builtin_amdgcn_exp2f(a[0]) * hin + a[1]; }
#pragma unroll 16
            for (int c = c1 - 1; c > cidx; --c) { const f32x2 a = *(const f32x2*)(AGG + ((size_t)(c * 2 + 1) * 256 + ch) * 2); hbin = __builtin_amdgcn_exp2f(a[0]) * hbin + a[1]; }
            gate_stage<0>(gbase, xcb, chb, tl, cg, sl, pba, pbx, par);
            float hf[64]; float h = hin;
#pragma unroll
            for (int t = 0; t < 64; ++t) { const h16x2 w = __builtin_bit_cast(h16x2, sl[t * SROW + lane]); h = __builtin_amdgcn_exp2f((float)w[0]) * h + (float)w[1]; hf[t] = h; }
            asm volatile("s_waitcnt lgkmcnt(0)" ::: "memory");
            gate_stage<1>(gbase, xcb, chb, tl, cg, sl, pba, pbx, par);
            h = hbin;
#pragma unroll
            for (int t = 63; t >= 0; --t) { const h16x2 w = __builtin_bit_cast(h16x2, sl[t * SROW + lane]); h = __builtin_amdgcn_exp2f((float)w[0]) * h + (float)w[1]; sl[t * SROW + lane] = __float_as_uint(hf[t] + h); }
            asm volatile("s_waitcnt lgkmcnt(0)" ::: "memory");
#pragma unroll
            for (int j = 0; j < 8; ++j) {
                const int t = 8 * j + tl; const size_t tok = (size_t)cidx * 64 + t;
                const LAS u32x4* src = (const LAS u32x4*)(sl + t * SROW + cg * 8); const u32x4 s0 = src[0], s1 = src[1];
                const u32x4 gw_ = *(const u32x4*)(P + tok * PROJW + 256 + chb);
                u32x4 o;
                o.x = pk2(gelu_tanh(bflo(gw_.x)) * __uint_as_float(s0.x), gelu_tanh(bfhi(gw_.x)) * __uint_as_float(s0.y));
                o.y = pk2(gelu_tanh(bflo(gw_.y)) * __uint_as_float(s0.z), gelu_tanh(bfhi(gw_.y)) * __uint_as_float(s0.w));
                o.z = pk2(gelu_tanh(bflo(gw_.z)) * __uint_as_float(s1.x), gelu_tanh(bfhi(gw_.z)) * __uint_as_float(s1.y));
                o.w = pk2(gelu_tanh(bflo(gw_.w)) * __uint_as_float(s1.z), gelu_tanh(bfhi(gw_.w)) * __uint_as_float(s1.w));
                *(u32x4*)(Y + tok * DM + chb) = o;
            }
            asm volatile("s_waitcnt lgkmcnt(0)" ::: "memory");
        }
    }
}
namespace att {
constexpr int KROW = 272, VROW = 320, KBUF = 32 * KROW, VBUF = 32 * VROW, LDS_K = 0, LDS_V = 2 * KBUF, LDS_Q = 2 * KBUF + 2 * VBUF;
static_assert(LDS_Q + 256 * KROW + 16 <= LDS_BYTES, "attention LDS");
typedef short v4i16_t __attribute__((ext_vector_type(4)));
DEV s16x4 vtr(const LAS unsigned char* p) { return __builtin_bit_cast(s16x4, __builtin_amdgcn_ds_read_tr16_b64_v4i16((LAS v4i16_t*)p)); }


DEV void attn_unit(const bf16* PROJ, bf16* YMIX, int tok0, int S, int head, int qb, float lam, float oscale, const float* subg, float Bnd, LAS unsigned char* lds) {
    int tid_ = threadIdx.x; asm volatile("" : "+v"(tid_));
    const int tid = tid_, lane = tid & 63, r32 = lane & 31, hi = lane >> 5, wid = __builtin_amdgcn_readfirstlane(tid >> 6);
    const int qpos = qb * 256 + wid * 32 + r32;
    LAS unsigned char* qlds = lds + LDS_Q + wid * 32 * KROW;
    { const bf16* qg = PROJ + (size_t)(tok0 + qb * 256 + wid * 32) * PROJW + 512 + head * 128;
#pragma unroll
      for (int i = 0; i < 8; ++i) { const int ch = lane + 64 * i, row = ch >> 4, c16 = ch & 15; const u32x4 v = *(const u32x4*)(qg + (size_t)row * PROJW + c16 * 8); *(LAS u32x4*)(qlds + row * KROW + c16 * 16) = v; } }
    const LAS unsigned char* qfb = qlds + r32 * KROW + hi * 16;
    bf16x8 qf0[4];
    { const bf16* qrow = PROJ + (size_t)(tok0 + qpos) * PROJW + 512 + head * 128 + hi * 8;
#pragma unroll
      for (int ds = 0; ds < 4; ++ds) qf0[ds] = *(const bf16x8*)(qrow + ds * 16); }
    const float sl2 = __builtin_amdgcn_exp2f(-2.f * (float)(head + 1)) * LOG2E;
    const int srow = tid >> 4, sc16 = tid & 15;
    const bf16* kg = PROJ + (size_t)(tok0 + srow) * PROJW + 1024 + head * 128 + sc16 * 8;
    const bf16* vg = kg + 512;
    LAS unsigned char* kst = lds + LDS_K + srow * KROW + sc16 * 16;
    LAS unsigned char* vst = lds + LDS_V + srow * VROW + sc16 * 16;
    const LAS unsigned char* kfb = lds + LDS_K + r32 * KROW + hi * 16;
    const int i16 = lane & 15, gq = i16 >> 2, gp = i16 & 3, g1 = (lane >> 4) & 1;
    const LAS unsigned char* vfb = lds + LDS_V + (4 * hi + gq) * VROW + (16 * g1 + 4 * gp) * 2;
    u32x4 kr0, vr0;
    { const size_t go0 = (size_t)(qb * 8) * 32 * PROJW; kr0 = *(const u32x4*)(kg + go0); vr0 = *(const u32x4*)(vg + go0); }
    *(LAS u32x4*)kst = kr0; *(LAS u32x4*)vst = vr0;
    __syncthreads();
    f32x16 O[2][4];
#pragma unroll
    for (int c = 0; c < 2; ++c)
#pragma unroll
        for (int d = 0; d < 4; ++d)
#pragma unroll
            for (int r = 0; r < 16; ++r) O[c][d][r] = 0.f;
    float mrun[2] = {-1e30f, -1e30f}, lrun[2] = {0.f, 0.f};
    const int ts = qb * 8, qw0 = qb * 256 + wid * 32;
    int t_lo = 0, t_hi = (S >> 5) - 1;
    { const float Df = (2.f * Bnd + 160.f) / sl2; if (Df < (float)S) { const int D = (int)Df + 1; const int a_ = (qb * 256 - D) >> 5, b_ = (qb * 256 + 255 + D) >> 5; t_lo = a_ > 0 ? a_ : 0; t_hi = b_ < t_hi ? b_ : t_hi; } }
    const int NT = t_hi - t_lo + 1;
    f32x16 bcv; float csign = 1.f;
#pragma unroll
    for (int r = 0; r < 16; ++r) { float cr_ = (float)((r & 3) + 8 * (r >> 2)); asm volatile("" : "+v"(cr_)); bcv[r] = sl2 * cr_; }
    for (int i = 0; i < NT; ++i) {
        int t = ts + i; if (t > t_hi) t -= NT;
        int tn = t + 1; if (tn > t_hi) tn -= NT;
        const int cur = i & 1, k0 = t * 32;
        const LAS unsigned char* kb = kfb + cur * KBUF; const LAS unsigned char* vb = vfb + cur * VBUF;
        const float dqf = (float)(qpos - k0 - 4 * hi);
        const bool diag = (k0 == qw0);
        if (!diag) { const float want = (k0 < qw0) ? 1.f : -1.f;
            if (want != csign) { csign = want;
#pragma unroll
                for (int r = 0; r < 16; ++r) bcv[r] = -bcv[r]; } }
        const float lt = diag ? 0.f : -csign * sl2 * dqf;
        if (i + 1 < NT) { const size_t go = (size_t)tn * 32 * PROJW; kr0 = *(const u32x4*)(kg + go); vr0 = *(const u32x4*)(vg + go); }
        bf16x8 pf[2][2];
        f32x16 pp[2]; pp[0] = bcv; pp[1] = bcv;
#pragma unroll
        for (int ds = 0; ds < 4; ++ds) {
            const bf16x8 ka = *(const LAS bf16x8*)(kb + (ds * 16) * 2), kc = *(const LAS bf16x8*)(kb + (64 + ds * 16) * 2);
            const bf16x8 qb1 = *(const LAS bf16x8*)(qfb + (64 + ds * 16) * 2);
            pp[0] = __builtin_amdgcn_mfma_f32_32x32x16_bf16(ka, qf0[ds], pp[0], 0, 0, 0);
            pp[1] = __builtin_amdgcn_mfma_f32_32x32x16_bf16(kc, qb1, pp[1], 0, 0, 0);
        }
        if (diag) {
#pragma unroll
            for (int r = 0; r < 16; ++r) { float cr = (float)((r & 3) + 8 * (r >> 2)); asm volatile("" : "+v"(cr)); const float fx = bcv[r] + sl2 * __builtin_fabsf(dqf - cr); pp[0][r] -= fx; pp[1][r] -= fx; }
        }
        float rm[2];
#pragma unroll
        for (int c = 0; c < 2; ++c) {
            float m_ = pp[c][0];
#pragma unroll
            for (int r = 1; r < 16; ++r) m_ = __builtin_fmaxf(m_, pp[c][r]);
            m_ += lt;
            auto rr = __builtin_amdgcn_permlane32_swap(__float_as_uint(m_), __float_as_uint(m_), false, false); rm[c] = __builtin_fmaxf(__uint_as_float(rr[0]), __uint_as_float(rr[1]));
        }
        if (__any(rm[0] > mrun[0] + 8.f || rm[1] > mrun[1] + 8.f)) {
#pragma unroll
            for (int c = 0; c < 2; ++c) {
                const float mnew = rm[c] > mrun[c] + 8.f ? rm[c] : mrun[c], alpha = __builtin_amdgcn_exp2f(mrun[c] - mnew);
                mrun[c] = mnew; lrun[c] *= alpha;
#pragma unroll
                for (int d = 0; d < 4; ++d)
#pragma unroll
                    for (int r = 0; r < 16; ++r) O[c][d][r] *= alpha;
            }
        }
#pragma unroll
        for (int c = 0; c < 2; ++c) {
            const float mm = mrun[c] - lt;
            float rs = 0.f;
#pragma unroll
            for (int r = 0; r < 16; ++r) { pp[c][r] = __builtin_amdgcn_exp2f(pp[c][r] - mm); rs += pp[c][r]; }
            lrun[c] += rs;
#pragma unroll
            for (int s = 0; s < 2; ++s) {
                u32x4 a;
                a.x = pk2(pp[c][8 * s + 0], pp[c][8 * s + 1]); a.y = pk2(pp[c][8 * s + 2], pp[c][8 * s + 3]); a.z = pk2(pp[c][8 * s + 4], pp[c][8 * s + 5]); a.w = pk2(pp[c][8 * s + 6], pp[c][8 * s + 7]);
                pf[c][s] = __builtin_bit_cast(bf16x8, a);
            }
        }
#pragma unroll
        for (int d = 0; d < 4; ++d)
#pragma unroll
            for (int xs = 0; xs < 2; ++xs) {
                const s16x4 lo = vtr(vb + (16 * xs) * VROW + d * 64), hh = vtr(vb + (16 * xs + 8) * VROW + d * 64);
                const bf16x8 vf = {lo[0], lo[1], lo[2], lo[3], hh[0], hh[1], hh[2], hh[3]};
                O[0][d] = __builtin_amdgcn_mfma_f32_32x32x16_bf16(vf, pf[0][xs], O[0][d], 0, 0, 0);
                O[1][d] = __builtin_amdgcn_mfma_f32_32x32x16_bf16(vf, pf[1][xs], O[1][d], 0, 0, 0);
            }
        if (i + 1 < NT) { const int nb = cur ^ 1; *(LAS u32x4*)(kst + nb * KBUF) = kr0; *(LAS u32x4*)(vst + nb * VBUF) = vr0; }
        __syncthreads();
    }
    const float l0 = lrun[0] + lane_xor(lrun[0], lane, 32), l1 = lrun[1] + lane_xor(lrun[1], lane, 32);
    const float i0 = 1.f / l0, i1 = lam / l1;
    float ss = 0.f;
#pragma unroll
    for (int d = 0; d < 4; ++d)
#pragma unroll
        for (int r = 0; r < 16; ++r) { const float o = O[0][d][r] * i0 - O[1][d][r] * i1; O[0][d][r] = o; ss += o * o; }
    ss += lane_xor(ss, lane, 32);
    const float rn = oscale / sqrtf(ss * (1.f / 128.f) + 1e-5f);
    bf16* yrow = YMIX + (size_t)(tok0 + qpos) * DM + 256 + head * 128;
#pragma unroll
    for (int d = 0; d < 4; ++d)
#pragma unroll
        for (int rg = 0; rg < 4; ++rg) { const int d0 = 32 * d + 8 * rg + 4 * hi; const f32x4 g4 = *(const f32x4*)(subg + d0);
            u32x2 w; w.x = pk2(O[0][d][4 * rg + 0] * rn * g4[0], O[0][d][4 * rg + 1] * rn * g4[1]); w.y = pk2(O[0][d][4 * rg + 2] * rn * g4[2], O[0][d][4 * rg + 3] * rn * g4[3]);
            *(u32x2*)(yrow + d0) = w; }
}
DEV void attn_phase(const Ctx& C, int l, LAS unsigned char* lds, int rep = 0) {
    const bf16* P = (const bf16*)(C.ws + WS_PROJ); bf16* Y = (bf16*)(C.ws + WS_YMIX);
    const float lam = ((const float*)(C.ws + WS_PAR))[1024 + l], li = ((const float*)(C.ws + WS_PAR))[1026 + l];
    const float* subg = C.in[19] + l * 128;
    const float* QN = (const float*)(C.ws + WS_NRM) + l * 320 * 8; const float* KN = (const float*)(C.ws + WS_NRM) + NRM_KN + l * 18 * 8;
    unsigned* qcnt = (unsigned*)(C.ws + WS_BAR) + 16 + 16 * l + 4 * rep;
    volatile LAS int* ubox = (volatile LAS int*)(lds + LDS_Q + 256 * KROW);
    for (;;) {
        if (C.tid == 0) ubox[0] = (int)__hip_atomic_fetch_add(qcnt, 1u, __ATOMIC_RELAXED, __HIP_MEMORY_SCOPE_AGENT);
        __syncthreads();
        const int u = ubox[0];
        if (u >= 1280) break;
        const int head = 3 - u / 320, r = u % 320;
        int tok0, S, qb, seq;
        if (r < 64) { seq = 16 + (r >> 5); qb = r & 31; tok0 = MP + (r >> 5) * SS; S = SS; }
        else { const int v = r - 64; seq = v >> 4; qb = v & 15; tok0 = seq * SP; S = SP; }
        const int blk = (tok0 >> 8) + qb;
        const float b0 = sqrtf(QN[blk * 8 + head * 2] * KN[seq * 8 + head * 2]), b1 = sqrtf(QN[blk * 8 + head * 2 + 1] * KN[seq * 8 + head * 2 + 1]);
        const float Bnd = 1.02f * fmaxf(b0, b1) + 0.5f;
        attn_unit(P, Y, tok0, S, head, qb, lam, 1.f - li, subg, Bnd, lds);
    }
}
}
DEV void grid_barrier(unsigned* bar, unsigned epoch, unsigned G) {
    asm volatile("s_waitcnt vmcnt(0)" ::: "memory");
    __syncthreads();
    if (threadIdx.x == 0) {
        __builtin_amdgcn_fence(__ATOMIC_RELEASE, "agent");
        asm volatile("s_waitcnt vmcnt(0)" ::: "memory");
        __hip_atomic_fetch_add(bar, 1u, __ATOMIC_RELAXED, __HIP_MEMORY_SCOPE_AGENT);
        const unsigned target = epoch * G;
        while (__hip_atomic_load(bar, __ATOMIC_RELAXED, __HIP_MEMORY_SCOPE_AGENT) < target) __builtin_amdgcn_s_sleep(2);
        __builtin_amdgcn_fence(__ATOMIC_ACQUIRE, "agent");
        asm volatile("s_waitcnt vmcnt(0)" ::: "memory");
    }
    __syncthreads();
}
#ifndef REP_ATT
#define REP_ATT 1
#endif
#ifndef REP_FFNUP
#define REP_FFNUP 1
#endif
#ifndef REP_DFT
#define REP_DFT 1
#endif
#ifndef REP_BAR
#define REP_BAR 1
#endif
#ifndef REP_FFNDN
#define REP_FFNDN 1
#endif
#ifndef REP_GATE
#define REP_GATE 1
#endif
#ifndef REP_OUT
#define REP_OUT 1
#endif
#ifndef REP_LN
#define REP_LN 1
#endif
#ifndef REP_PROJ
#define REP_PROJ 1
#endif
#ifndef REP_SCANA
#define REP_SCANA 1
#endif
#ifndef REP_SCANC
#define REP_SCANC 1
#endif
#ifndef REP_CONV
#define REP_CONV 1
#endif
#ifndef REP_BAR
#define REP_BAR 1
#endif
#ifndef REP_FFNDN
#define REP_FFNDN 1
#endif
#ifndef REP_GATE
#define REP_GATE 1
#endif
#ifndef REP_OUT
#define REP_OUT 1
#endif
#ifndef REP_LN
#define REP_LN 1
#endif
#ifndef REP_PRO
#define REP_PRO 1
#endif
struct Args { const float* in[21]; float* out; unsigned char* ws; int ph_lo, ph_hi; };
constexpr int NPHASES = 27;
__global__ void __launch_bounds__(512, 2) mk_fwd(Args a) {
    extern __shared__ __attribute__((aligned(16))) unsigned char lds_raw[];
    LAS unsigned char* lds = (LAS unsigned char*)lds_raw;
    cg::grid_group grid = cg::this_grid();
    Ctx C;
C.in = a.in; C.out = a.out; C.ws = a.ws; C.tid = threadIdx.x; C.lane = C.tid & 63; C.wave = __builtin_amdgcn_readfirstlane(C.tid >> 6); C.G = gridDim.x; C.bid = blockIdx.x;
    unsigned char* ws = a.ws;
    const int lo = a.ph_lo, hi = a.ph_hi;
    int ph = 0; unsigned epoch = 0;
#define PH_BEGIN if (ph >= lo && ph < hi) { { int t_ = threadIdx.x; asm volatile("" : "+v"(t_)); C.tid = t_; C.lane = t_ & 63; C.wave = __builtin_amdgcn_readfirstlane(t_ >> 6); size_t z_ = 0; asm volatile("" : "+s"(z_)); ws = a.ws + z_; C.ws = ws; C.out = a.out + z_;     int g_ = gridDim.x, b_ = blockIdx.x; asm volatile("" : "+s"(g_), "+s"(b_)); C.G = g_; C.bid = b_; }
#define PH_END   if (ph + 1 < hi) { for (int rb_ = 0; rb_ < REP_BAR; ++rb_) grid_barrier((unsigned*)(a.ws + WS_BAR), ++epoch, gridDim.x); } } ++ph;
#define XB ((bf16*)(ws + WS_XB))
#define H ((bf16*)(ws + WS_H))
#define PROJ ((bf16*)(ws + WS_PROJ))
#define YMIX ((bf16*)(ws + WS_YMIX))
    if (ph >= lo && ph < hi) { { int t_ = threadIdx.x; asm volatile("" : "+v"(t_)); C.tid = t_; C.lane = t_ & 63; C.wave = __builtin_amdgcn_readfirstlane(t_ >> 6); }
#ifndef NO_PRO
 for (int rep_ = 0; rep_ < REP_PRO; ++rep_) { phase_prologue(C, lds); __syncthreads(); }
#endif
 __syncthreads(); if (ph + 1 < hi) grid.sync(); } ++ph;
    for (int l = 0; l < 2; ++l) {
        for (int f = 0; f < 2; ++f) {
            if (f == 1) {
                PH_BEGIN
                { pg8::Gemm g{XB, (const bf16*)(ws + WS_WIN) + (size_t)l * 2048 * 1024, 1024, 1024, 1024, 0, 0}; pg8::StaticOrder S; S.init(MTOK, 2048, C.G, C.bid);
                  epi::Proj E{PROJ};
#ifndef NO_PROJ
 for (int rep_ = 0; rep_ < REP_PROJ; ++rep_) pg8::gemm_phase<epi::Proj, pg8::StaticOrder, true, true, 1024, 1024, 1024>(lds, g, S, E);
#endif
 }
                { pg8::Gemm g{(const bf16*)(ws + WS_WF) + (size_t)l * 512 * 1024, XB, 1024, 1024, 1024, 0, 0}; pg8::StaticOrder S; S.init(512, MTOK, C.G, C.bid);
                  epi::FT E{(bf16*)(ws + WS_BTF)};
#ifndef NO_FT
 for (int rep_ = 0; rep_ < REP_PROJ; ++rep_) pg8::gemm_phase<epi::FT, pg8::StaticOrder, true, true, 1024, 1024, 1024>(lds, g, S, E);
#endif
 }
                PH_END
                PH_BEGIN for (int rep_ = 0; rep_ < REP_CONV; ++rep_) phase_conv(C, l); PH_END
                PH_BEGIN
                { pg8::Gemm g{(const bf16*)(ws + WS_XC), (const bf16*)(ws + WS_WG) + (size_t)l * 1024 * 256, 256, 256, 256, 0, 0}; pg8::StaticOrder S; S.init(MTOK, 1024, C.G, C.bid);
                  epi::Raw E{(bf16*)(ws + WS_AU)};
#ifndef NO_GATE
 for (int rep_ = 0; rep_ < REP_GATE; ++rep_) pg8::gemm_phase<epi::Raw, pg8::StaticOrder, true, true, 256, 256, 256>(lds, g, S, E);
#endif
 }
                PH_END
                PH_BEGIN
#ifndef NO_SCANA
 for (int rep_ = 0; rep_ < REP_SCANA; ++rep_) phase_scan<false>(C, l, lds);
 __syncthreads();
#endif
                { pg8::Gemm g{(const bf16*)(ws + WS_DFT), (const bf16*)(ws + WS_BTF), 8192, 8192, 8192, 0, (size_t)256 * 8192}; epi::DftOrder S{C.G, C.bid};
                  epi::DFT E{YMIX, (float*)(ws + WS_PART), 0.001953125f  };
#ifndef NO_DFT
 for (int rep_ = 0; rep_ < REP_DFT; ++rep_) pg8::gemm_phase<epi::DFT, epi::DftOrder, true, true, 8192, 8192, 8192>(lds, g, S, E);
#endif
 }
#ifndef NO_ATT
 for (int rep_ = 0; rep_ < REP_ATT; ++rep_) att::attn_phase(C, l, lds, rep_);
#endif
 PH_END
                PH_BEGIN
phase_dft_combine(C);
#ifndef NO_SCANC
 for (int rep_ = 0; rep_ < REP_SCANC; ++rep_) phase_scan<true>(C, l, lds);
#endif
 PH_END
                PH_BEGIN
                { pg8::Gemm g{YMIX, (const bf16*)(ws + WS_WOUT) + (size_t)l * 1024 * 1024, 1024, 1024, 1024, 0, 0}; pg8::StaticOrder S; S.init(MTOK, 1024, C.G, C.bid);
                  epi::Resid E{C.out, 1.0f, (const float*)(ws + WS_STATS), C.in[2] + (l * 3 + 0) * 1024, C.in[3] + (l * 3 + 0) * 1024, C.out, C.out + (size_t)MP * DM};
#ifndef NO_OUT
 for (int rep_ = 1; rep_ < REP_OUT; ++rep_) { epi::Resid E0{C.out, 0.f, (const float*)(ws + WS_STATS), (const float*)(ws + WS_ONES), (const float*)(ws + WS_ONES) + 1024, C.out, C.out + (size_t)MP * DM, 1.f}; pg8::gemm_phase<epi::Resid, pg8::StaticOrder, true, true, 1024, 1024, 1024>(lds, g, S, E0); }
 pg8::gemm_phase<epi::Resid, pg8::StaticOrder, true, true, 1024, 1024, 1024>(lds, g, S, E);
#endif
 }
                PH_END
                PH_BEGIN for (int rep_ = 0; rep_ < REP_LN; ++rep_) phase_ln(C, C.in[2] + (l * 3 + 1) * 1024, C.in[3] + (l * 3 + 1) * 1024, false); PH_END
            }
            PH_BEGIN
            { pg8::Gemm g{XB, (const bf16*)(ws + WS_WGU) + (size_t)(l * 2 + f) * 5632 * 1024, 1024, 1024, 1024, 0, 0}; pg8::StaticOrder S; S.init(MTOK, 5632, C.G, C.bid);
              epi::SwiGLU E{H};
#ifndef NO_FFNUP
 for (int rep_ = 0; rep_ < REP_FFNUP; ++rep_) pg8::gemm_phase<epi::SwiGLU, pg8::StaticOrder, true, true, 1024, 1024, 1024>(lds, g, S, E);
#endif
 }
            PH_END
            PH_BEGIN
            { pg8::Gemm g{H, (const bf16*)(ws + WS_WD) + (size_t)(l * 2 + f) * 1024 * 2816, 2816, 2816, 2816, 0, 0}; pg8::StaticOrder S; S.init(MTOK, 1024, C.G, C.bid);
              const bool ident_ = (l == 0 && f == 0); const int pidx_ = f == 1 ? l * 3 + 1 : (l - 1) * 3 + 2;
              epi::Resid E{C.out, 0.5f, (const float*)(ws + WS_STATS), ident_ ? (const float*)(ws + WS_ONES) : C.in[2] + pidx_ * 1024, ident_ ? (const float*)(ws + WS_ONES) + 1024 : C.in[3] + pidx_ * 1024, ident_ ? C.in[0] : C.out, ident_ ? C.in[1] : C.out + (size_t)MP * DM};
#ifndef NO_FFNDN
 for (int rep_ = 1; rep_ < REP_FFNDN; ++rep_) { epi::Resid E0{C.out, 0.f, (const float*)(ws + WS_STATS), (const float*)(ws + WS_ONES), (const float*)(ws + WS_ONES) + 1024, C.out, C.out + (size_t)MP * DM, 1.f}; pg8::gemm_phase<epi::Resid, pg8::StaticOrder, true, true, 2816, 2816, 2816>(lds, g, S, E0); }
 pg8::gemm_phase<epi::Resid, pg8::StaticOrder, true, true, 2816, 2816, 2816>(lds, g, S, E);
#endif
 }
            PH_END
            PH_BEGIN for (int rep_ = 0; rep_ < ((l == 1 && f == 1) ? 1 : REP_LN); ++rep_) phase_ln(C, C.in[2] + (l * 3 + 2 * f) * 1024, C.in[3] + (l * 3 + 2 * f) * 1024, l == 1 && f == 1); PH_END
        }
    }
}

#ifndef MK_COOP
#define MK_COOP 1
#endif
extern "C" void kernel_launch(void* const* d_in, const int* in_sizes, int n_in, void* d_out, int out_size, void* d_ws, size_t ws_size, hipStream_t stream) {
    static int grid = 0;
    if (grid == 0) {
        if (n_in != 21 || out_size != MTOK * DM || ws_size < WS_END) { fprintf(stderr, "kernel_launch: unexpected shapes (n_in %d out %d ws %zu)\n", n_in, out_size, ws_size); grid = -1; return; }
        int dev = 0, cus = 0, per_cu = 0;
        hipGetDevice(&dev); hipDeviceGetAttribute(&cus, hipDeviceAttributeMultiprocessorCount, dev);
        hipFuncSetAttribute((const void*)mk_fwd, hipFuncAttributeMaxDynamicSharedMemorySize, LDS_BYTES);
        hipOccupancyMaxActiveBlocksPerMultiprocessor(&per_cu, (const void*)mk_fwd, 512, LDS_BYTES);
        (void)hipGetLastError();
        if (per_cu < 1) per_cu = 1;
        grid = cus;
    }
    if (grid < 0) return;
    if (MK_COOP) (void)hipMemsetAsync((char*)d_ws + WS_BAR, 0, 256, stream);
    Args a{};
    for (int i = 0; i < 21; ++i) a.in[i] = (const float*)d_in[i];
    a.out = (float*)d_out; a.ws = (unsigned char*)d_ws;
#if MK_COOP
    a.ph_lo = 0; a.ph_hi = NPHASES;
    void* args[] = {&a};
    hipError_t e = hipLaunchCooperativeKernel((const void*)mk_fwd, dim3(grid), dim3(512), args, LDS_BYTES, stream);
    if (e != hipSuccess) fprintf(stderr, "cooperative launch failed: %s (grid %d)\n", hipGetErrorString(e), grid);
#else
    for (int p = 0; p < NPHASES; ++p) { a.ph_lo = p; a.ph_hi = p + 1; hipLaunchKernelGGL(mk_fwd, dim3(grid), dim3(512), LDS_BYTES, stream, a); }
#endif
}
```

```cpp
#include <hip/hip_runtime.h>
#include <hip/hip_cooperative_groups.h>
#include <hip/hip_bf16.h>
#include <cstdio>
#include <cstdint>
#include <cmath>
namespace cg = cooperative_groups;
namespace pg8 {
#define PG8_LAS __attribute__((address_space(3)))
typedef unsigned short bf16_t;
typedef short bf16x8 __attribute__((ext_vector_type(8)));
typedef float f32x4 __attribute__((ext_vector_type(4)));
typedef unsigned u32x4 __attribute__((ext_vector_type(4)));
constexpr int BM = 256, BK = 64, HALF = 128, HTB = HALF * BK * 2  , STAGE_BYTES = 8 * HTB, NXCD = 8, WGM = 8;

__host__ __device__ __forceinline__ int lds_byte(int r, int c) { const int st = (r >> 4) * 2 + (c >> 5), rr = r & 15, cc = c & 31, ob = rr * 64 + cc * 2; return st * 1024 + (ob ^ (((ob >> 9) & 1) << 5)); }
__host__ __device__ __forceinline__ void stage_rc(int b, int& R, int& C) { const int st = b / 1024, sb = b % 1024, swz = sb ^ (((sb >> 9) & 1) << 5); R = (st >> 1) * 16 + swz / 64; C = (st & 1) * 32 + (swz % 64) / 2; }
__host__ __device__ __forceinline__ int perm32(int rho) { const int n = rho >> 4, i = rho & 15; return 8 * (i >> 2) + 4 * n + (i & 3); }

struct Unit { int pm, pn, z; };
struct Gemm { const bf16_t* A; const bf16_t* Bt; int K, lda, ldb; size_t zA, zB; };

struct StaticOrder {
    int nM, nN, nwg, G, c;
    __host__ __device__ void init(int M, int N, int G_, int c_) { nM = M / BM; nN = N / BM; nwg = nM * nN; G = G_; c = c_; }
    __host__ __device__ bool next(int i, Unit& u) const {
        const long L = (long)i * G + c; if (L >= nwg) return false;
        int wgid = (int)L; { const int q = nwg / NXCD, r = nwg % NXCD, xcd = wgid % NXCD, off = wgid / NXCD; wgid = (xcd < r ? xcd * (q + 1) : r * (q + 1) + (xcd - r) * q) + off; }
        const int nig = WGM * nN, gid = wgid / nig, fm = gid * WGM, gsz = (nM - fm) < WGM ? (nM - fm) : WGM;
        u.pm = fm + ((wgid % nig) % gsz); u.pn = (wgid % nig) / gsz; u.z = 0; return true;
    }
    __device__ __forceinline__ void a_ready(const Unit&) const {}
    __device__ __forceinline__ void done(const Unit&) const {}
};

__device__ __forceinline__ unsigned cvt_pk_bf16(float lo, float hi) { unsigned r; asm volatile("v_cvt_pk_bf16_f32 %0, %1, %2" : "=v"(r) : "v"(lo), "v"(hi)); return r; }
typedef float f32x2 __attribute__((ext_vector_type(2)));
__device__ __forceinline__ f32x2 gelu_pk(f32x2 v) {
    const f32x2 av = __builtin_elementwise_abs(v), d = av * 0.2316418882f + 1.0f;
    f32x2 t; t.x = __builtin_amdgcn_rcpf(d.x); t.y = __builtin_amdgcn_rcpf(d.y);
    f32x2 q = t * 0.5307027145f + (-0.7265760135f); q = q * t + 0.7107068705f; q = q * t + (-0.142248368f); q = q * t + 0.127414796f; q = q * t;
    const f32x2 s = (v * v) * (-0.72134752044f);
    f32x2 e; e.x = __builtin_amdgcn_exp2f(s.x); e.y = __builtin_amdgcn_exp2f(s.y);
    const f32x2 m = v * (q * e), r = v - m;
    f32x2 o; o.x = v.x < 0.f ? m.x : r.x; o.y = v.y < 0.f ? m.y : r.y; return o;
}

template <int ACT  > struct EpiBf16 {
    static constexpr bool PERM = true, AFTER_DRAIN = false; static_assert(ACT == 0 || ACT == 1, "EpiBf16: ACT is 0 (none) or 1 (gelu_pk)");
    bf16_t* O; int ldc; const float* bias; int split_cols; size_t split_stride; float scale0;
    __device__ __forceinline__ void operator()(const f32x4 (&acc)[2][2][4][2], const Unit& u, int wr, int wc, int fr, int fq) const {
        const int row0 = u.pm * BM + wr * 64 + fr; int colt = u.pn * BM; bf16_t* base = O;
        float sc = 1.f; if (split_cols) { const int t = colt / split_cols; base += (size_t)t * split_stride; colt -= t * split_cols; if (t == 0) sc = scale0; }
        const int col0 = colt + wc * 32 + 8 * fq, bcol0 = u.pn * BM + wc * 32 + 8 * fq;
        f32x4 bv[2][2];
#pragma unroll
        for (int bj = 0; bj < 2; ++bj)
#pragma unroll
            for (int n = 0; n < 2; ++n) bv[bj][n] = bias ? *(const f32x4*)(bias + bcol0 + bj * HALF + 4 * n) : (f32x4){0.f, 0.f, 0.f, 0.f};
#pragma unroll
        for (int ai = 0; ai < 2; ++ai)
#pragma unroll
            for (int m = 0; m < 4; ++m) { bf16_t* rowp = base + (size_t)(row0 + ai * HALF + m * 16) * ldc + col0;
#pragma unroll
                for (int bj = 0; bj < 2; ++bj) { f32x4 v0 = acc[ai][bj][m][0] + bv[bj][0], v1 = acc[ai][bj][m][1] + bv[bj][1];
                    if (ACT == 1) { f32x2 a = gelu_pk((f32x2){v0[0], v0[1]}), b = gelu_pk((f32x2){v0[2], v0[3]}), c = gelu_pk((f32x2){v1[0], v1[1]}), d = gelu_pk((f32x2){v1[2], v1[3]});
                        v0 = (f32x4){a.x, a.y, b.x, b.y}; v1 = (f32x4){c.x, c.y, d.x, d.y}; }
                    v0 = v0 * sc; v1 = v1 * sc; u32x4 w; w.x = cvt_pk_bf16(v0[0], v0[1]); w.y = cvt_pk_bf16(v0[2], v0[3]); w.z = cvt_pk_bf16(v1[0], v1[1]); w.w = cvt_pk_bf16(v1[2], v1[3]);
                    *(u32x4*)(rowp + bj * HALF) = w; } }
    }
};

template <class Epi, class Sched, bool ALIGN_EPI, bool SP2, int KK, int LDA, int LDB>
__device__ __forceinline__ void gemm_phase(PG8_LAS unsigned char* lds, const Gemm g, const Sched& S, const Epi& E) {
    int tid_ = threadIdx.x; asm volatile("" : "+v"(tid_));
    const int tid = tid_, wid = __builtin_amdgcn_readfirstlane(tid >> 6), lane = tid & 63, wr = wid >> 2, wc = wid & 3, fr = lane & 15, fq = lane >> 4;
    constexpr int K = KK, nt = K / BK;
    unsigned voffA[2], voffB[2];
#pragma unroll
    for (int i = 0; i < 2; ++i) { int R, C; stage_rc(tid * 16 + i * 8192, R, C); const int Rb = Epi::PERM ? ((R & ~31) + perm32(R & 31)) : R;
        voffA[i] = (unsigned)(R * LDA + C) * 2u; voffB[i] = (unsigned)(Rb * LDB + C) * 2u; }
    constexpr size_t kstep = (size_t)(BK * 2);
    constexpr size_t hstepA = (size_t)HALF * LDA * 2, hstepB = (size_t)HALF * LDB * 2;
    constexpr size_t tstepA = 2 * hstepA, tstepB = 2 * hstepB;
    const unsigned ldsw = (unsigned)wid * 1024u;
    const int aoff = lds_byte(wr * 64 + fr, fq * 8), boff = lds_byte(wc * 32 + fr, fq * 8);
#define PG8_SA(b, h) (((b) * 2 + (h)) * HTB)
#define PG8_SB(b, h) ((4 + (b) * 2 + (h)) * HTB)
#define PG8_STAGE(bufoff, gbase, voff) do { _Pragma("unroll") for (int _i = 0; _i < 2; ++_i) \
        __builtin_amdgcn_global_load_lds((const unsigned*)((const char*)(gbase) + (voff)[_i]), (PG8_LAS unsigned*)(lds + (bufoff) + ldsw + _i * 8192), 16, 0, 0); } while (0)
#define PG8_LDA(dst, b, h) do { _Pragma("unroll") for (int m = 0; m < 4; ++m) _Pragma("unroll") for (int k = 0; k < 2; ++k) dst[m][k] = *(const PG8_LAS bf16x8*)(lds + PG8_SA(b, h) + aoff + m * 2048 + k * 1024); } while (0)
#define PG8_LDB(dst, b, h) do { _Pragma("unroll") for (int n = 0; n < 2; ++n) _Pragma("unroll") for (int k = 0; k < 2; ++k) dst[n][k] = *(const PG8_LAS bf16x8*)(lds + PG8_SB(b, h) + boff + n * 2048 + k * 1024); } while (0)
#define PG8_MMA(ai, bj, At, Bt) do { __builtin_amdgcn_s_setprio(1); _Pragma("unroll") for (int m = 0; m < 4; ++m) _Pragma("unroll") for (int n = 0; n < 2; ++n) _Pragma("unroll") for (int k = 0; k < 2; ++k) \
        acc[ai][bj][m][n] = __builtin_amdgcn_mfma_f32_16x16x32_bf16(Bt[n][k], At[m][k], acc[ai][bj][m][n], 0, 0, 0); __builtin_amdgcn_s_setprio(0); } while (0)
#define PG8_WAIT_V(n) asm volatile("s_waitcnt vmcnt(" #n ")" ::: "memory")
#define PG8_WAIT_L(n) asm volatile("s_waitcnt lgkmcnt(" #n ")" ::: "memory")
#define PG8_BAR __builtin_amdgcn_s_barrier()
#define PG8_SCHED __builtin_amdgcn_sched_barrier(0)
    Unit cur, nxt; int ui = 0;
    if (!S.next(0, cur)) return;
    f32x4 acc[2][2][4][2];
#pragma unroll
    for (int a = 0; a < 2; ++a)
#pragma unroll
        for (int b = 0; b < 2; ++b)
#pragma unroll
            for (int m = 0; m < 4; ++m)
#pragma unroll
                for (int n = 0; n < 2; ++n) acc[a][b][m][n] = (f32x4){0.f, 0.f, 0.f, 0.f};
    bf16x8 At[4][2], B0[2][2], B1[2][2];
    const char* cA = (const char*)g.A + (size_t)cur.z * g.zA * 2 + (size_t)cur.pm * tstepA; const char* cB = (const char*)g.Bt + (size_t)cur.z * g.zB * 2 + (size_t)cur.pn * tstepB;
    S.a_ready(cur);
    if constexpr (SP2) {
        PG8_STAGE(PG8_SB(0, 0), cB, voffB); PG8_STAGE(PG8_SB(0, 1), cB + hstepB, voffB); PG8_STAGE(PG8_SA(0, 0), cA, voffA); PG8_STAGE(PG8_SA(0, 1), cA + hstepA, voffA);
        if (wr == 1) PG8_BAR;
        PG8_WAIT_V(2); PG8_BAR;
        PG8_STAGE(PG8_SB(1, 0), cB + kstep, voffB); PG8_STAGE(PG8_SA(1, 0), cA + kstep, voffA); PG8_STAGE(PG8_SB(1, 1), cB + hstepB + kstep, voffB);
        PG8_WAIT_V(6); PG8_BAR;
    } else {
        PG8_STAGE(PG8_SB(0, 0), cB, voffB); PG8_STAGE(PG8_SA(0, 0), cA, voffA); PG8_STAGE(PG8_SB(0, 1), cB + hstepB, voffB); PG8_STAGE(PG8_SA(0, 1), cA + hstepA, voffA);
        if (wr == 1) PG8_BAR;
        PG8_WAIT_V(4); PG8_BAR;
        PG8_STAGE(PG8_SB(1, 0), cB + kstep, voffB); PG8_STAGE(PG8_SA(1, 0), cA + kstep, voffA); PG8_STAGE(PG8_SB(1, 1), cB + hstepB + kstep, voffB);
        PG8_WAIT_V(6); PG8_BAR;
    }
    for (;;) {
        const bool has_next = S.next(ui + 1, nxt);
        const char* nA = has_next ? (const char*)g.A + (size_t)nxt.z * g.zA * 2 + (size_t)nxt.pm * tstepA : cA; const char* nB = has_next ? (const char*)g.Bt + (size_t)nxt.z * g.zB * 2 + (size_t)nxt.pn * tstepB : cB;
        for (int t = 0; t < nt; t += 2) {
            const bool last = (t == nt - 2);
            const char* a1 = cA + (size_t)(t + 1) * kstep;
            const char* a2 = last ? nA : cA + (size_t)(t + 2) * kstep; const char* b2 = last ? nB : cB + (size_t)(t + 2) * kstep;
            const char* a3 = a2 + kstep; const char* b3 = b2 + kstep;
            if (last && has_next) S.a_ready(nxt);
            if constexpr (SP2) {
            PG8_LDB(B0, 0, 0); PG8_LDB(B1, 0, 1); PG8_SCHED; PG8_LDA(At, 0, 0); PG8_STAGE(PG8_SA(1, 1), a1 + hstepA, voffA);
            PG8_WAIT_V(8); PG8_WAIT_L(0); PG8_BAR; PG8_MMA(0, 0, At, B0); PG8_MMA(0, 1, At, B1); PG8_BAR; PG8_SCHED;
            PG8_LDA(At, 0, 1); PG8_STAGE(PG8_SB(0, 0), b2, voffB); PG8_STAGE(PG8_SB(0, 1), b2 + hstepB, voffB); PG8_STAGE(PG8_SA(0, 0), a2, voffA);
            PG8_WAIT_V(8); PG8_WAIT_L(0); PG8_BAR; PG8_MMA(1, 0, At, B0); PG8_MMA(1, 1, At, B1); PG8_BAR; PG8_SCHED;
            PG8_LDB(B0, 1, 0); PG8_LDB(B1, 1, 1); PG8_SCHED; PG8_LDA(At, 1, 0); PG8_STAGE(PG8_SA(0, 1), a2 + hstepA, voffA);
            PG8_WAIT_V(8); PG8_WAIT_L(0); PG8_BAR; PG8_MMA(0, 0, At, B0); PG8_MMA(0, 1, At, B1); PG8_BAR; PG8_SCHED;
            PG8_LDA(At, 1, 1); PG8_STAGE(PG8_SB(1, 0), b3, voffB); PG8_STAGE(PG8_SB(1, 1), b3 + hstepB, voffB); PG8_STAGE(PG8_SA(1, 0), a3, voffA);
            PG8_WAIT_V(8); PG8_WAIT_L(0); PG8_BAR; PG8_MMA(1, 0, At, B0); PG8_MMA(1, 1, At, B1); PG8_BAR; PG8_SCHED;
            } else {
            PG8_LDB(B0, 0, 0); PG8_SCHED; PG8_LDA(At, 0, 0); PG8_STAGE(PG8_SA(1, 1), a1 + hstepA, voffA);
            PG8_WAIT_L(8); PG8_BAR; PG8_WAIT_L(0); PG8_MMA(0, 0, At, B0); PG8_BAR; PG8_SCHED;
            PG8_LDB(B1, 0, 1); PG8_STAGE(PG8_SB(0, 0), b2, voffB);
            PG8_BAR; PG8_WAIT_L(0); PG8_MMA(0, 1, At, B1); PG8_BAR;
            PG8_LDA(At, 0, 1); PG8_STAGE(PG8_SA(0, 0), a2, voffA);
            PG8_BAR; PG8_WAIT_L(0); PG8_MMA(1, 0, At, B0); PG8_BAR; PG8_SCHED;
            PG8_STAGE(PG8_SB(0, 1), b2 + hstepB, voffB);
            PG8_WAIT_V(6); PG8_BAR; PG8_MMA(1, 1, At, B1); PG8_BAR;
            PG8_LDB(B0, 1, 0); PG8_SCHED; PG8_LDA(At, 1, 0); PG8_STAGE(PG8_SA(0, 1), a2 + hstepA, voffA);
            PG8_WAIT_L(8); PG8_BAR; PG8_WAIT_L(0); PG8_MMA(0, 0, At, B0); PG8_BAR; PG8_SCHED;
            PG8_LDB(B1, 1, 1); PG8_STAGE(PG8_SB(1, 0), b3, voffB);
            PG8_BAR; PG8_WAIT_L(0); PG8_MMA(0, 1, At, B1); PG8_BAR;
            PG8_LDA(At, 1, 1); PG8_STAGE(PG8_SA(1, 0), a3, voffA);
            PG8_BAR; PG8_WAIT_L(0); PG8_MMA(1, 0, At, B0); PG8_BAR; PG8_SCHED;
            PG8_STAGE(PG8_SB(1, 1), b3 + hstepB, voffB);
            PG8_WAIT_V(6); PG8_BAR; PG8_MMA(1, 1, At, B1); PG8_BAR;
            }
        }
        if constexpr (ALIGN_EPI) { if (wr == 0) PG8_BAR; }
        if constexpr (!Epi::AFTER_DRAIN) { E(acc, cur, wr, wc, fr, fq); S.done(cur); }
        if (!has_next) break;
#pragma unroll
        for (int a = 0; a < 2; ++a)
#pragma unroll
            for (int b = 0; b < 2; ++b)
#pragma unroll
                for (int m = 0; m < 4; ++m)
#pragma unroll
                    for (int n = 0; n < 2; ++n) acc[a][b][m][n] = (f32x4){0.f, 0.f, 0.f, 0.f};
        cur = nxt; cA = nA; cB = nB; ++ui;
        if constexpr (ALIGN_EPI) { if (wr == 1) PG8_BAR; }
    }
    PG8_WAIT_V(0);
    if constexpr (!ALIGN_EPI) { if (wr == 0) PG8_BAR; }
    PG8_BAR;
    if constexpr (Epi::AFTER_DRAIN) { E.fused(acc, cur, wr, wc, fr, fq, lds, wid, lane); S.done(cur); }
#undef PG8_SA
#undef PG8_SB
#undef PG8_STAGE
#undef PG8_LDA
#undef PG8_LDB
#undef PG8_MMA
#undef PG8_WAIT_V
#undef PG8_WAIT_L
#undef PG8_BAR
#undef PG8_SCHED
}
}
#define DEV __device__ __forceinline__
#define LAS __attribute__((address_space(3)))
typedef unsigned short bf16;
typedef float f32x4 __attribute__((ext_vector_type(4)));
typedef float f32x2 __attribute__((ext_vector_type(2)));
typedef float f32x16 __attribute__((ext_vector_type(16)));
typedef unsigned u32x4 __attribute__((ext_vector_type(4)));
typedef unsigned u32x2 __attribute__((ext_vector_type(2)));
typedef short bf16x8 __attribute__((ext_vector_type(8)));
typedef short s16x4 __attribute__((ext_vector_type(4)));
typedef __bf16 bf16x2_t __attribute__((ext_vector_type(2)));

constexpr int DM = 1024, DFF = 2816, MTOK = 81920, MP = 65536, SP = 4096, SS = 8192;
constexpr int PROJW = 2048;
constexpr float LOG2E = 1.4426950408889634f;
constexpr float QSCALE = 0.125f * LOG2E;
constexpr float ALPHA = 1.4142135623730951f;
constexpr size_t MiB = 1u << 20;
constexpr size_t WS_PAR = 0;
constexpr size_t WS_NRM = 256 * 1024;
constexpr int NRM_KN = 2 * 320 * 8;
constexpr size_t WS_BAR = 512 * 1024;
constexpr size_t WS_WGU = 1 * MiB;
constexpr size_t WS_WD = 45 * MiB;
constexpr size_t WS_WIN = 67 * MiB;
constexpr size_t WS_WF = 75 * MiB;
constexpr size_t WS_WOUT = 77 * MiB;
constexpr size_t WS_WG = 81 * MiB;
constexpr size_t WS_DFT = 82 * MiB;
constexpr size_t WS_AGG = 210 * MiB;
constexpr size_t WS_STATS = 215 * MiB;
constexpr size_t WS_ONES = WS_STATS + 768 * 1024;
constexpr size_t WS_PROJ = 216 * MiB;
constexpr size_t WS_BTF = 536 * MiB;
constexpr size_t WS_XC = 632 * MiB;
constexpr size_t WS_YMIX = 672 * MiB;
constexpr size_t WS_AU = 832 * MiB;
constexpr size_t WS_XB = WS_AU;
constexpr size_t WS_H = WS_PROJ;
constexpr size_t WS_PART = 992 * MiB;
constexpr size_t WS_END = 1008 * MiB;
static_assert(WS_H + (size_t)MTOK * DFF * 2 <= WS_YMIX, "H overlay");
constexpr int LDS_BYTES = 147456;

DEV unsigned pk2(float lo, float hi) { f32x2 v = {lo, hi}; bf16x2_t b = __builtin_convertvector(v, bf16x2_t); return __builtin_bit_cast(unsigned, b); }
DEV float bf2f(unsigned short b) { return __uint_as_float((unsigned)b << 16); }
DEV float bflo(unsigned w) { return __uint_as_float(w << 16); }
DEV float bfhi(unsigned w) { return __uint_as_float(w & 0xffff0000u); }
DEV float lane_xor(float v, int lane, int o) { return __int_as_float(__builtin_amdgcn_ds_bpermute((lane ^ o) << 2, __float_as_int(v))); }
DEV float wave_sum(float v, int lane) {
#pragma unroll
    for (int o = 1; o < 64; o <<= 1) v += lane_xor(v, lane, o);
    return v;
}
DEV float sigmoidf_(float x) { return __builtin_amdgcn_rcpf(1.f + __builtin_amdgcn_exp2f(-LOG2E * x)); }

namespace epi {
using pg8::Unit; using pg8::HALF; using pg8::BM;
struct SwiGLU {
    static constexpr bool PERM = true, AFTER_DRAIN = false;
    bf16* H;
    DEV void operator()(const f32x4 (&acc)[2][2][4][2], const Unit& u, int wr, int wc, int fr_, int fq_) const {
        int t__ = threadIdx.x; asm volatile("" : "+v"(t__)); const int fr = t__ & 15, fq = (t__ >> 4) & 3; (void)fr_; (void)fq_;
        const int col0 = u.pn * 128 + wc * 32 + 8 * fq;
#pragma unroll
        for (int ai = 0; ai < 2; ++ai)
#pragma unroll
            for (int m = 0; m < 4; ++m) {
                const int row = u.pm * BM + ai * HALF + wr * 64 + m * 16 + fr;
                float o[8];
#pragma unroll
                for (int n = 0; n < 2; ++n)
#pragma unroll
                    for (int e = 0; e < 4; ++e) { const float g = acc[ai][0][m][n][e], up = acc[ai][1][m][n][e]; o[4 * n + e] = g * sigmoidf_(g) * up; }
                u32x4 w; w.x = pk2(o[0], o[1]); w.y = pk2(o[2], o[3]); w.z = pk2(o[4], o[5]); w.w = pk2(o[6], o[7]);
                *(u32x4*)(H + (size_t)row * DFF + col0) = w; asm volatile("" ::: "memory");
            }
    }
};
struct Resid {
    static constexpr bool PERM = true, AFTER_DRAIN = false;
    float* X; float s; const float* stats; const float* g; const float* b; const float* r0; const float* r1; float al = ALPHA;
    DEV void operator()(const f32x4 (&acc)[2][2][4][2], const Unit& u, int wr, int wc, int fr_, int fq_) const {
        int t__ = threadIdx.x; asm volatile("" : "+v"(t__)); const int fr = t__ & 15, fq = (t__ >> 4) & 3; (void)fr_; (void)fq_;
        const int colb = u.pn * BM + wc * 32 + 8 * fq;
        const float* rsrc = (u.pm * BM < MP) ? r0 : r1 - (size_t)MP * DM;
        f32x4 gv[2][2], bv[2][2];
#pragma unroll
        for (int bj = 0; bj < 2; ++bj)
#pragma unroll
            for (int n = 0; n < 2; ++n) { gv[bj][n] = *(const f32x4*)(g + colb + bj * HALF + n * 4); bv[bj][n] = *(const f32x4*)(b + colb + bj * HALF + n * 4); }
#pragma unroll
        for (int ai = 0; ai < 2; ++ai)
#pragma unroll
            for (int m = 0; m < 4; ++m) {
                const size_t row = (size_t)(u.pm * BM + ai * HALF + wr * 64 + m * 16 + fr);
                const f32x2 st = *(const f32x2*)(stats + row * 2);
                float* rp = X + row * DM + colb; const float* rq = rsrc + row * DM + colb;
#pragma unroll
                for (int bj = 0; bj < 2; ++bj)
#pragma unroll
                    for (int n = 0; n < 2; ++n) { f32x4* p = (f32x4*)(rp + bj * HALF + n * 4); const f32x4 yv = *(const f32x4*)(rq + bj * HALF + n * 4); const f32x4 x = ((yv - st[0]) * st[1]) * gv[bj][n] + bv[bj][n]; *p = x * al + acc[ai][bj][m][n] * s; }
                asm volatile("" ::: "memory");
            }
    }
};
struct Proj {
    static constexpr bool PERM = true, AFTER_DRAIN = false;
    bf16* P;
    DEV void operator()(const f32x4 (&acc)[2][2][4][2], const Unit& u, int wr, int wc, int fr_, int fq_) const {
        int t__ = threadIdx.x; asm volatile("" : "+v"(t__)); const int fr = t__ & 15, fq = (t__ >> 4) & 3; (void)fr_; (void)fq_;
        const float sc = (u.pn == 2 || u.pn == 3) ? QSCALE : 1.f;
        const int col0 = u.pn * BM + wc * 32 + 8 * fq;
#pragma unroll
        for (int ai = 0; ai < 2; ++ai)
#pragma unroll
            for (int m = 0; m < 4; ++m) {
                bf16* rp = P + (size_t)(u.pm * BM + ai * HALF + wr * 64 + m * 16 + fr) * PROJW + col0;
#pragma unroll
                for (int bj = 0; bj < 2; ++bj) { const f32x4 v0 = acc[ai][bj][m][0] * sc, v1 = acc[ai][bj][m][1] * sc;
                    u32x4 w; w.x = pk2(v0[0], v0[1]); w.y = pk2(v0[2], v0[3]); w.z = pk2(v1[0], v1[1]); w.w = pk2(v1[2], v1[3]);
                    *(u32x4*)(rp + bj * HALF) = w; }
                asm volatile("" ::: "memory");
            }
    }
};
struct FT {
    static constexpr bool PERM = true, AFTER_DRAIN = false;
    bf16* BP;
    DEV void operator()(const f32x4 (&acc)[2][2][4][2], const Unit& u, int wr, int wc, int fr_, int fq_) const {
        int t__ = threadIdx.x; asm volatile("" : "+v"(t__)); const int fr = t__ & 15, fq = (t__ >> 4) & 3; (void)fr_; (void)fq_;
        const int which = u.pm;
#pragma unroll
        for (int ai = 0; ai < 2; ++ai)
#pragma unroll
            for (int m = 0; m < 4; ++m) {
                const int n = ai * HALF + wr * 64 + m * 16 + fr;
#pragma unroll
                for (int bj = 0; bj < 2; ++bj) {
                    const int t0 = u.pn * BM + bj * HALF + wc * 32 + 8 * fq;
                    const f32x4 v0 = acc[ai][bj][m][0], v1 = acc[ai][bj][m][1];
                    if (t0 < MP) {
                        const int seq = t0 >> 12, s = t0 & 4095;
                        u32x4 w; w.x = pk2(v0[0], v0[1]); w.y = pk2(v0[2], v0[3]); w.z = pk2(v1[0], v1[1]); w.w = pk2(v1[2], v1[3]);
                        *(u32x4*)(BP + ((size_t)seq * 256 + n) * 8192 + which * 4096 + s) = w;
                    } else {
                        const int tt = t0 - MP, seq2 = tt >> 13, s = tt & 8191;
                        u32x2 ev, od; ev.x = pk2(v0[0], v0[2]); ev.y = pk2(v1[0], v1[2]); od.x = pk2(v0[1], v0[3]); od.y = pk2(v1[1], v1[3]);
                        bf16* be = BP + ((size_t)(16 + seq2 * 2) * 256 + n) * 8192 + which * 4096 + (s >> 1);
                        *(u32x2*)be = ev; *(u32x2*)(be + (size_t)256 * 8192) = od;
                    }
                }
                asm volatile("" ::: "memory");
            }
    }
};
struct DFT {
    static constexpr bool PERM = true, AFTER_DRAIN = false;
    bf16* Y; float* PART; float scale;
    DEV void operator()(const f32x4 (&acc)[2][2][4][2], const Unit& u, int wr, int wc, int fr_, int fq_) const {
        int t__ = threadIdx.x; asm volatile("" : "+v"(t__)); const int fr = t__ & 15, fq = (t__ >> 4) & 3; (void)fr_; (void)fq_;
        const int col0 = wc * 32 + 8 * fq;
        if (u.z < 16) {
#pragma unroll
            for (int ai = 0; ai < 2; ++ai)
#pragma unroll
                for (int m = 0; m < 4; ++m) {
                    bf16* rp = Y + (size_t)(u.z * SP + u.pm * BM + ai * HALF + wr * 64 + m * 16 + fr) * DM + 768 + col0;
#pragma unroll
                    for (int bj = 0; bj < 2; ++bj) { const f32x4 v0 = acc[ai][bj][m][0] * scale, v1 = acc[ai][bj][m][1] * scale;
                        u32x4 w; w.x = pk2(v0[0], v0[1]); w.y = pk2(v0[2], v0[3]); w.z = pk2(v1[0], v1[1]); w.w = pk2(v1[2], v1[3]);
                        *(u32x4*)(rp + bj * HALF) = w; }
                    asm volatile("" ::: "memory");
                }
        } else {
#pragma unroll
            for (int ai = 0; ai < 2; ++ai)
#pragma unroll
                for (int m = 0; m < 4; ++m) {
                    float* rp = PART + ((size_t)(u.z - 16) * 4096 + (u.pm & 15) * BM + ai * HALF + wr * 64 + m * 16 + fr) * 256 + col0;
#pragma unroll
                    for (int bj = 0; bj < 2; ++bj) { *(f32x4*)(rp + bj * HALF) = acc[ai][bj][m][0]; *(f32x4*)(rp + bj * HALF + 4) = acc[ai][bj][m][1]; }
                    asm volatile("" ::: "memory");
                }
        }
    }
};
struct DftOrder {
    int G, c;
    DEV bool next(int i, Unit& u) const { const int L = i * G + c; if (L >= 320) return false; u.pn = 0;
        if (L < 288) { const int pmA = L / 18, zi = L - pmA * 18; u.pm = pmA; u.z = zi < 16 ? zi : 16 + 2 * (zi - 16); }
        else { const int L2 = L - 288; u.pm = 16 + (L2 >> 1); u.z = 17 + 2 * (L2 & 1); }
        return true; }
    DEV void a_ready(const Unit&) const {}
    DEV void done(const Unit&) const {}
};
struct Raw {
    static constexpr bool PERM = true, AFTER_DRAIN = false;
    bf16* P;
    DEV void operator()(const f32x4 (&acc)[2][2][4][2], const Unit& u, int wr, int wc, int fr_, int fq_) const {
        int t__ = threadIdx.x; asm volatile("" : "+v"(t__)); const int fr = t__ & 15, fq = (t__ >> 4) & 3; (void)fr_; (void)fq_;
        const int col0 = u.pn * BM + wc * 32 + 8 * fq;
#pragma unroll
        for (int ai = 0; ai < 2; ++ai)
#pragma unroll
            for (int m = 0; m < 4; ++m) {
                bf16* rp = P + (size_t)(u.pm * BM + ai * HALF + wr * 64 + m * 16 + fr) * 1024 + col0;
#pragma unroll
                for (int bj = 0; bj < 2; ++bj) { const f32x4 v0 = acc[ai][bj][m][0], v1 = acc[ai][bj][m][1];
                    u32x4 w; w.x = pk2(v0[0], v0[1]); w.y = pk2(v0[2], v0[3]); w.z = pk2(v1[0], v1[1]); w.w = pk2(v1[2], v1[3]);
                    *(u32x4*)(rp + bj * HALF) = w; }
                asm volatile("" ::: "memory");
            }
    }
};
struct BatchOrder {
    int lz, nM, G, c;
    DEV bool next(int i, Unit& u) const { const int L = i * G + c; if (L >= (nM << lz)) return false; u.pm = L >> lz; u.z = L & ((1 << lz) - 1); u.pn = 0; return true; }
    DEV void a_ready(const Unit&) const {}
    DEV void done(const Unit&) const {}
};
}
struct Ctx {
    const float* const* in; float* out; unsigned char* ws;
    int tid, lane, wave, G, bid;
};
#ifndef RPA
#define RPA 1
#endif
#ifndef RPB
#define RPB 1
#endif
#ifndef RPE
#define RPE 1
#endif
#ifndef RPF
#define RPF 1
#endif
DEV void transpose_item(const float* W, int ldw, int srccol0, bf16* WT, int ldo, int dstrow0, int k0, LAS float* scr, int lane) {
#pragma unroll 8
    for (int i = 0; i < 32; ++i) { const int kk = 2 * i + (lane >> 5); scr[kk * 33 + (lane & 31)] = W[(size_t)(k0 + kk) * ldw + srccol0 + (lane & 31)]; }
    asm volatile("s_waitcnt lgkmcnt(0)" ::: "memory");
    const int c = lane & 7;
#pragma unroll
    for (int j = 0; j < 4; ++j) { const int n = (lane >> 3) + 8 * j; const LAS float* s = scr + (8 * c) * 33 + n;
        u32x4 o; o.x = pk2(s[0 * 33], s[1 * 33]); o.y = pk2(s[2 * 33], s[3 * 33]); o.z = pk2(s[4 * 33], s[5 * 33]); o.w = pk2(s[6 * 33], s[7 * 33]);
        *(u32x4*)(WT + (size_t)(dstrow0 + n) * ldo + k0 + 8 * c) = o; }
    asm volatile("s_waitcnt lgkmcnt(0)" ::: "memory");
}
DEV void phase_prologue(const Ctx& C, LAS unsigned char* lds) {
    const int gw = C.bid * 8 + C.wave, NGW = C.G * 8;
    const long gt = (long)C.bid * 512 + C.tid, NGT = (long)C.G * 512;
    unsigned char* ws = C.ws;
for (int rp_ = 0; rp_ < RPA; ++rp_) {
    {
        LAS float* scr = (LAS float*)(lds + C.wave * 16384);
        for (int it = gw; it < 2 * 9984; it += NGW) {
            const int l = it / 9984, r = it % 9984; int j, q;
            if (r < 8448) { j = r / 1408; q = r % 1408; } else if (r < 9472) { j = 6; q = r - 8448; } else { j = 7; q = r - 9472; }
            const float* src; int ldw, K, N; bf16* dst; int inter = 0, ioff = 0;
            if (j == 0 || j == 1 || j == 3 || j == 4) { const int f = j >= 3; const int up = (j == 1 || j == 4);
                src = C.in[(f ? 7 : 4) + up] + (size_t)l * DM * DFF; ldw = DFF; K = DM; N = DFF; dst = (bf16*)(ws + WS_WGU) + (size_t)(l * 2 + f) * 5632 * 1024; inter = 1; ioff = up ? 128 : 0; }
            else if (j == 2 || j == 5) { const int f = j == 5; src = C.in[f ? 9 : 6] + (size_t)l * DFF * DM; ldw = DM; K = DFF; N = DM; dst = (bf16*)(ws + WS_WD) + (size_t)(l * 2 + f) * 1024 * 2816; }
            else if (j == 6) { src = C.in[10] + (size_t)l * DM * 2304; ldw = 2304; K = DM; N = 2048; dst = (bf16*)(ws + WS_WIN) + (size_t)l * 2048 * 1024; }
            else { src = C.in[20] + (size_t)l * DM * DM; ldw = DM; K = DM; N = DM; dst = (bf16*)(ws + WS_WOUT) + (size_t)l * 1024 * 1024; }
            const int nblk = N / 32, kb = q / nblk, nb = q % nblk, n0 = 32 * nb;
            const int drow = inter ? (256 * (n0 >> 7) + (n0 & 127) + ioff) : n0;
            transpose_item(src, ldw, n0, dst, K, drow, 64 * kb, scr, C.lane);
        }
    }
}
    for (int rp_ = 0; rp_ < RPB; ++rp_) {
    {
        LAS float* tw = (LAS float*)(lds + 8 * 16384);
        if (C.tid < 64) { float sn, cs; sincospif((float)C.tid * (1.0f / 32.0f), &sn, &cs); tw[C.tid] = cs; tw[64 + C.tid] = sn; }
        __syncthreads();
        for (long it = gt; it < 2L * 512 * 128; it += NGT) {
            const int l = (int)(it / (512 * 128)), r = (int)(it % (512 * 128)), nrow = r >> 7, k0 = (r & 127) * 8;
            const int which = nrow >> 8, g = (nrow >> 6) & 3, cp = nrow & 63;
            const float* wsrc = C.in[10] + (size_t)l * DM * 2304 + 2048 + 64 * g;
            float o[8];
#pragma unroll
            for (int kk = 0; kk < 8; ++kk) {
                const float* wr_ = wsrc + (size_t)(k0 + kk) * 2304; float a = 0.f;
                for (int c = 0; c < 64; c += 4) { const f32x4 w4 = *(const f32x4*)(wr_ + c);
                    a += w4[0] * tw[which * 64 + (((c + 0) * cp) & 63)] + w4[1] * tw[which * 64 + (((c + 1) * cp) & 63)] + w4[2] * tw[which * 64 + (((c + 2) * cp) & 63)] + w4[3] * tw[which * 64 + (((c + 3) * cp) & 63)]; }
                o[kk] = a;
            }
            u32x4 w; w.x = pk2(o[0], o[1]); w.y = pk2(o[2], o[3]); w.z = pk2(o[4], o[5]); w.w = pk2(o[6], o[7]);
            *(u32x4*)((bf16*)(ws + WS_WF) + ((size_t)l * 512 + nrow) * 1024 + k0) = w;
        }
    }
}
    for (long it = gt; it < 2L * 1024 * 32; it += NGT) {
        const int l = (int)(it / (1024 * 32)), r = (int)(it % (1024 * 32)), n = r >> 5, k0 = (r & 31) * 8;
        const int tn = n >> 8, dir = tn >> 1, chh = tn & 1, within = n & 255, gate = within >> 7, ch = chh * 128 + (within & 127), hb = ch >> 6, jj = ch & 63;
        u32x4 w = {0u, 0u, 0u, 0u};
        if ((k0 >> 6) == hb) {
            const float* src = C.in[gate ? 15 : 13] + ((size_t)((l * 2 + dir) * 4 + hb) * 64) * 64 + jj;
            float o[8];
#pragma unroll
            for (int kk = 0; kk < 8; ++kk) o[kk] = src[(size_t)((k0 & 63) + kk) * 64];
            w.x = pk2(o[0], o[1]); w.y = pk2(o[2], o[3]); w.z = pk2(o[4], o[5]); w.w = pk2(o[6], o[7]);
        }
        *(u32x4*)((bf16*)(ws + WS_WG) + ((size_t)l * 1024 + n) * 256 + k0) = w;
    }
    if (gt < 1024) { const float lam = C.in[17][gt]; ((float*)(ws + WS_PAR))[gt] = 8.f * log1pf(expf(-lam)); }
    if (gt >= 1024 && gt < 1026) { const int l = (int)gt - 1024; const float* lq = C.in[18] + l * 256; float s1 = 0.f, s2 = 0.f;
        for (int i = 0; i < 64; ++i) { s1 += lq[i] * lq[64 + i]; s2 += lq[128 + i] * lq[192 + i]; }
        const float li = 0.8f - 0.6f * expf(-0.3f * (float)l);
        ((float*)(ws + WS_PAR))[1024 + l] = expf(s1) - expf(s2) + li; ((float*)(ws + WS_PAR))[1026 + l] = li; }
    if (gt < NRM_KN + 2 * 18 * 8) ((unsigned*)(ws + WS_NRM))[gt] = 0u;
    if (gt < MTOK) *(f32x2*)((float*)(ws + WS_STATS) + gt * 2) = (f32x2){0.f, 1.f};
    if (gt < 2048) ((float*)(ws + WS_ONES))[gt] = gt < 1024 ? 1.f : 0.f;
for (int rp_ = 0; rp_ < RPE; ++rp_) {
for (int rp_ = 0; rp_ < RPE; ++rp_) {
    for (long it = gt; it < 8192L * 1024; it += NGT) {
        const int row = (int)(it >> 10), k0 = (int)(it & 1023) * 8, odd = row >> 12, sp = row & 4095, neg = k0 >> 12, nb = k0 & 4095;
        float o[8];
#pragma unroll
        for (int e = 0; e < 8; ++e) { const int n = nb + e; float sn, cs;
            if (!odd) { const int idx = (n * sp) & 4095; sincospif((float)idx * (1.0f / 2048.0f), &sn, &cs); }
            else { const int idx = ((2 * n + 1) * sp) & 8191; sincospif((float)idx * (1.0f / 4096.0f), &sn, &cs); }
            o[e] = neg ? -sn : cs; }
        u32x4 w; w.x = pk2(o[0], o[1]); w.y = pk2(o[2], o[3]); w.z = pk2(o[4], o[5]); w.w = pk2(o[6], o[7]);
        *(u32x4*)((bf16*)(ws + WS_DFT) + (size_t)row * 8192 + k0) = w;
    }
}
    {
        const f32x4* xp = (const f32x4*)C.in[0]; const f32x4* xs = (const f32x4*)C.in[1]; u32x2* xb = (u32x2*)(ws + WS_XB);
        const long NP = (long)MP * 256, NT = (long)MTOK * 256;
        for (long it = gt; it < NT; it += NGT) { const f32x4 v = it < NP ? xp[it] : xs[it - NP]; u32x2 w; w.x = pk2(v[0], v[1]); w.y = pk2(v[2], v[3]); xb[it] = w; }
    }
}
}
DEV void ln_row(const f32x4 (&cur)[4], const f32x4 (&gv)[4], const f32x4 (&bv)[4], int m, int lane, float* out, unsigned char* ws, bool final_) {
    float s = 0.f, q = 0.f;
#pragma unroll
    for (int j = 0; j < 4; ++j) { s += (cur[j][0] + cur[j][1]) + (cur[j][2] + cur[j][3]); q += (cur[j][0] * cur[j][0] + cur[j][1] * cur[j][1]) + (cur[j][2] * cur[j][2] + cur[j][3] * cur[j][3]); }
#pragma unroll
    for (int o = 1; o < 64; o <<= 1) { const float s2 = lane_xor(s, lane, o), q2 = lane_xor(q, lane, o); s += s2; q += q2; }
    const float mean = s * (1.f / DM), var = __builtin_fmaxf(q * (1.f / DM) - mean * mean, 0.f), rstd = 1.f / sqrtf(var + 1e-5f);
    if (final_) {
        f32x4* xr = (f32x4*)(out + (size_t)m * DM) + lane;
#pragma unroll
        for (int j = 0; j < 4; ++j) xr[64 * j] = (cur[j] - mean) * rstd * gv[j] + bv[j];
    } else {
        u32x2* o8 = (u32x2*)((bf16*)(ws + WS_XB) + (size_t)m * DM) + lane;
#pragma unroll
        for (int j = 0; j < 4; ++j) { const f32x4 y = (cur[j] - mean) * rstd * gv[j] + bv[j]; u32x2 w; w.x = pk2(y[0], y[1]); w.y = pk2(y[2], y[3]); o8[64 * j] = w; }
        if (lane == 0) *(f32x2*)((float*)(ws + WS_STATS) + (size_t)m * 2) = (f32x2){mean, rstd};
    }
}
DEV void phase_ln(const Ctx& C, const float* g, const float* b, bool final_) {
    const int gw = C.bid * 8 + C.wave, NGW = C.G * 8, lane = C.lane;
    f32x4 gv[4], bv[4];
#pragma unroll
    for (int j = 0; j < 4; ++j) { gv[j] = ((const f32x4*)g)[lane + 64 * j]; bv[j] = ((const f32x4*)b)[lane + 64 * j]; }
    f32x4 c0[4], c1[4], n0[4], n1[4];
    auto ld = [&](f32x4 (&d)[4], int m) { const int mm = m < MTOK ? m : gw;
#pragma unroll
        for (int j = 0; j < 4; ++j) d[j] = ((const f32x4*)(C.out + (size_t)mm * DM))[lane + 64 * j]; };
    ld(c0, gw); ld(c1, gw + NGW);
    for (int m = gw; m < MTOK; m += 2 * NGW) {
        ld(n0, m + 2 * NGW); ld(n1, m + 3 * NGW);
        ln_row(c0, gv, bv, m, lane, C.out, C.ws, final_);
        if (m + NGW < MTOK) ln_row(c1, gv, bv, m + NGW, lane, C.out, C.ws, final_);
#pragma unroll
        for (int j = 0; j < 4; ++j) { c0[j] = n0[j]; c1[j] = n1[j]; }
    }
}
DEV void phase_dft_combine(const Ctx& C) {
    const long gt = (long)C.bid * 512 + C.tid, NGT = (long)C.G * 512;
    const float* PART = (const float*)(C.ws + WS_PART); bf16* Y = (bf16*)(C.ws + WS_YMIX); const float sc = 0.001381067932004976f;
    for (long it = gt; it < 2L * 4096 * 64; it += NGT) {
        const int seq2 = (int)(it >> 18), r = (int)(it & 262143), sp = r >> 6, c = (r & 63) * 4;
        const f32x4 p1 = *(const f32x4*)(PART + ((size_t)(seq2 * 2) * 4096 + sp) * 256 + c), p2 = *(const f32x4*)(PART + ((size_t)(seq2 * 2 + 1) * 4096 + sp) * 256 + c);
        const f32x4 lo = (p1 + p2) * sc, hi = (p1 - p2) * sc;
        u32x2 wl, wh; wl.x = pk2(lo[0], lo[1]); wl.y = pk2(lo[2], lo[3]); wh.x = pk2(hi[0], hi[1]); wh.y = pk2(hi[2], hi[3]);
        bf16* yl = Y + (size_t)(MP + seq2 * SS + sp) * DM + 768 + c;
        *(u32x2*)yl = wl; *(u32x2*)(yl + (size_t)4096 * DM) = wh;
    }
}
DEV void phase_conv(const Ctx& C, int l) {
    const long gt = (long)C.bid * 512 + C.tid, NGT = (long)C.G * 512;
    const bf16* P = (const bf16*)(C.ws + WS_PROJ); bf16* XC = (bf16*)(C.ws + WS_XC);
    const float* cw = C.in[11] + l * 4 * 256; const float* cb = C.in[12] + l * 256;
    for (long it = gt; it < (long)MTOK * 32; it += NGT) {
        const int tok = (int)(it >> 5), c0 = (int)(it & 31) * 8;
        const int pos = tok < MP ? (tok & 4095) : ((tok - MP) & 8191), S = tok < MP ? SP : SS;
        float a[8];
        { const f32x4 b0 = *(const f32x4*)(cb + c0), b1 = *(const f32x4*)(cb + c0 + 4); a[0] = b0[0]; a[1] = b0[1]; a[2] = b0[2]; a[3] = b0[3]; a[4] = b1[0]; a[5] = b1[1]; a[6] = b1[2]; a[7] = b1[3]; }
#pragma unroll
        for (int j = 0; j < 4; ++j) { const int tt = pos - 2 + j;
            if (tt >= 0 && tt < S) { const u32x4 xw = *(const u32x4*)(P + (size_t)(tok - 2 + j) * PROJW + c0);
                const f32x4 w0 = *(const f32x4*)(cw + j * 256 + c0), w1 = *(const f32x4*)(cw + j * 256 + c0 + 4);
                a[0] += w0[0] * bflo(xw.x); a[1] += w0[1] * bfhi(xw.x); a[2] += w0[2] * bflo(xw.y); a[3] += w0[3] * bfhi(xw.y);
                a[4] += w1[0] * bflo(xw.z); a[5] += w1[1] * bfhi(xw.z); a[6] += w1[2] * bflo(xw.w); a[7] += w1[3] * bfhi(xw.w); } }
        u32x4 w; w.x = pk2(a[0], a[1]); w.y = pk2(a[2], a[3]); w.z = pk2(a[4], a[5]); w.w = pk2(a[6], a[7]);
        *(u32x4*)(XC + (size_t)tok * 256 + c0) = w;
    }
    unsigned* QN = (unsigned*)(C.ws + WS_NRM) + l * 320 * 8; unsigned* KN = (unsigned*)(C.ws + WS_NRM) + NRM_KN + l * 18 * 8;
    for (long it = gt; it < (long)MTOK * 8; it += NGT) {
        const int tok = (int)(it >> 3), hm = (int)(it & 7);
        const bf16* qp = P + (size_t)tok * PROJW + 512 + hm * 64; float sq = 0.f, sk = 0.f;
#pragma unroll
        for (int j = 0; j < 8; ++j) { const u32x4 a = *(const u32x4*)(qp + 8 * j), k4 = *(const u32x4*)(qp + 512 + 8 * j);
            sq += bflo(a.x) * bflo(a.x) + bfhi(a.x) * bfhi(a.x) + bflo(a.y) * bflo(a.y) + bfhi(a.y) * bfhi(a.y) + bflo(a.z) * bflo(a.z) + bfhi(a.z) * bfhi(a.z) + bflo(a.w) * bflo(a.w) + bfhi(a.w) * bfhi(a.w);
            sk += bflo(k4.x) * bflo(k4.x) + bfhi(k4.x) * bfhi(k4.x) + bflo(k4.y) * bflo(k4.y) + bfhi(k4.y) * bfhi(k4.y) + bflo(k4.z) * bflo(k4.z) + bfhi(k4.z) * bfhi(k4.z) + bflo(k4.w) * bflo(k4.w) + bfhi(k4.w) * bfhi(k4.w); }
#pragma unroll
        for (int o = 8; o < 64; o <<= 1) { sq = fmaxf(sq, lane_xor(sq, C.lane, o)); sk = fmaxf(sk, lane_xor(sk, C.lane, o)); }
        if (C.lane < 8) { const int seq = tok < MP ? (tok >> 12) : 16 + ((tok - MP) >> 13);
            atomicMax(QN + (tok >> 8) * 8 + hm, __float_as_uint(sq)); atomicMax(KN + seq * 8 + hm, __float_as_uint(sk)); }
    }
}
DEV float fsig(float x) { return __builtin_amdgcn_rcpf(1.f + __builtin_amdgcn_exp2f(-LOG2E * x)); }
DEV void gate_eval(float rp, float ip, float xc, float ba, float bx, float sp8, float& la2, float& u) {
    const float r = fsig(rp + ba), ig = fsig(ip + bx);
    la2 = -sp8 * r * LOG2E;
    const float em = __builtin_fmaxf(1.f - __builtin_amdgcn_exp2f(2.f * la2), 0.f);
    u = __builtin_amdgcn_sqrtf(em) * ig * xc;
}
DEV float gelu_tanh(float x) { const float z = 0.7978845608028654f * (x + 0.044715f * x * x * x); const float e = __builtin_amdgcn_exp2f(2.f * LOG2E * z); return 0.5f * x * (2.f - 2.f * __builtin_amdgcn_rcpf(e + 1.f)); }
constexpr int SROW = 68;
typedef _Float16 h16x2 __attribute__((ext_vector_type(2)));
DEV unsigned pkh(float a, float b) { return __builtin_bit_cast(unsigned, __builtin_amdgcn_cvt_pkrtz(a, b)); }
template <int DIRV> DEV void gate_stage(const bf16* gbase, const bf16* xcb, int chb, int tl, int cg, LAS unsigned* sl, const float* pba, const float* pbx, const float* par) {
    const int col = (DIRV * 2 + (chb >> 7)) * 256 + (chb & 127);
    float ba[8], bx[8], sp[8];
#pragma unroll
    for (int q = 0; q < 2; ++q) { const f32x4 a = *(const f32x4*)(pba + DIRV * 256 + chb + 4 * q), b = *(const f32x4*)(pbx + DIRV * 256 + chb + 4 * q), s = *(const f32x4*)(par + DIRV * 256 + chb + 4 * q);
#pragma unroll
        for (int e = 0; e < 4; ++e) { ba[4 * q + e] = a[e]; bx[4 * q + e] = b[e]; sp[4 * q + e] = s[e]; } }
#pragma unroll
    for (int j = 0; j < 8; ++j) {
        const int t = 8 * j + tl;
        const u32x4 rw = *(const u32x4*)(gbase + (size_t)t * 1024 + col), iw = *(const u32x4*)(gbase + (size_t)t * 1024 + col + 128), xw = *(const u32x4*)(xcb + (size_t)t * 256);
        const float rp[8] = {bflo(rw.x), bfhi(rw.x), bflo(rw.y), bfhi(rw.y), bflo(rw.z), bfhi(rw.z), bflo(rw.w), bfhi(rw.w)};
        const float ip[8] = {bflo(iw.x), bfhi(iw.x), bflo(iw.y), bfhi(iw.y), bflo(iw.z), bfhi(iw.z), bflo(iw.w), bfhi(iw.w)};
        const float xc[8] = {bflo(xw.x), bfhi(xw.x), bflo(xw.y), bfhi(xw.y), bflo(xw.z), bfhi(xw.z), bflo(xw.w), bfhi(xw.w)};
        unsigned w[8];
#pragma unroll
        for (int e = 0; e < 8; ++e) { float la, u; gate_eval(rp[e], ip[e], xc[e], ba[e], bx[e], sp[e], la, u); w[e] = pkh(la, u); }
        LAS u32x4* dst = (LAS u32x4*)(sl + t * SROW + cg * 8);
        dst[0] = (u32x4){w[0], w[1], w[2], w[3]}; dst[1] = (u32x4){w[4], w[5], w[6], w[7]};
    }
    asm volatile("s_waitcnt lgkmcnt(0)" ::: "memory");
}
template <bool FINAL> DEV void phase_scan(const Ctx& C, int l, LAS unsigned char* lds) {
    const int gw = C.bid * 8 + C.wave, NGW = C.G * 8, lane = C.lane, tl = lane >> 3, cg = lane & 7;
    const bf16* GP = (const bf16*)(C.ws + WS_AU); float* AGG = (float*)(C.ws + WS_AGG); const bf16* XC = (const bf16*)(C.ws + WS_XC);
    const bf16* P = (const bf16*)(C.ws + WS_PROJ); bf16* Y = (bf16*)(C.ws + WS_YMIX);
    const float* par = (const float*)(C.ws + WS_PAR) + l * 512; const float* pba = C.in[14] + l * 512; const float* pbx = C.in[16] + l * 512;
    LAS unsigned* sl = (LAS unsigned*)(lds + C.wave * (64 * SROW * 4));
    for (int it = gw; it < 1280 * 4; it += NGW) {
        const int cidx = it >> 2, g4 = it & 3, ch = g4 * 64 + lane, chb = g4 * 64 + cg * 8;
        const bf16* gbase = GP + (size_t)cidx * 64 * 1024; const bf16* xcb = XC + (size_t)cidx * 64 * 256 + chb;
        if (!FINAL) {
            gate_stage<0>(gbase, xcb, chb, tl, cg, sl, pba, pbx, par);
            { float Ps = 0.f, h = 0.f;
#pragma unroll 16
              for (int t = 0; t < 64; ++t) { const h16x2 w = __builtin_bit_cast(h16x2, sl[t * SROW + lane]); const float la = (float)w[0]; h = __builtin_amdgcn_exp2f(la) * h + (float)w[1]; Ps += la; }
              *(f32x2*)(AGG + ((size_t)(cidx * 2 + 0) * 256 + ch) * 2) = (f32x2){Ps, h}; }
            asm volatile("s_waitcnt lgkmcnt(0)" ::: "memory");
            gate_stage<1>(gbase, xcb, chb, tl, cg, sl, pba, pbx, par);
            { float Ps = 0.f, h = 0.f;
#pragma unroll 16
              for (int t = 63; t >= 0; --t) { const h16x2 w = __builtin_bit_cast(h16x2, sl[t * SROW + lane]); const float la = (float)w[0]; h = __builtin_amdgcn_exp2f(la) * h + (float)w[1]; Ps += la; }
              *(f32x2*)(AGG + ((size_t)(cidx * 2 + 1) * 256 + ch) * 2) = (f32x2){Ps, h}; }
            asm volatile("s_waitcnt lgkmcnt(0)" ::: "memory");
        } else {
            int c0, c1; if (cidx < 1024) { c0 = cidx & ~63; c1 = c0 + 64; } else { c0 = 1024 + ((cidx - 1024) & ~127); c1 = c0 + 128; }
            float hin = 0.f, hbin = 0.f;
#pragma unroll 16
            for (int c = c0; c < cidx; ++c) { const f32x2 a = *(const f32x2*)(AGG + ((size_t)(c * 2 + 0) * 256 + ch) * 2); hin = __builtin_amdgcn_exp2f(a[0]) * hin + a[1]; }
#pragma unroll 16
            for (int c = c1 - 1; c > cidx; --c) { const f32x2 a = *(const f32x2*)(AGG + ((size_t)(c * 2 + 1) * 256 + ch) * 2); hbin = __builtin_amdgcn_exp2f(a[0]) * hbin + a[1]; }
            gate_stage<0>(gbase, xcb, chb, tl, cg, sl, pba, pbx, par);
            float hf[64]; float h = hin;
#pragma unroll
            for (int t = 0; t < 64; ++t) { const h16x2 w = __builtin_bit_cast(h16x2, sl[t * SROW + lane]); h = __builtin_amdgcn_exp2f((float)w[0]) * h + (float)w[1]; hf[t] = h; }
            asm volatile("s_waitcnt lgkmcnt(0)" ::: "memory");
            gate_stage<1>(gbase, xcb, chb, tl, cg, sl, pba, pbx, par);
            h = hbin;
#pragma unroll
            for (int t = 63; t >= 0; --t) { const h16x2 w = __builtin_bit_cast(h16x2, sl[t * SROW + lane]); h = __builtin_amdgcn_exp2f((float)w[0]) * h + (float)w[1]; sl[t * SROW + lane] = __float_as_uint(hf[t] + h); }
            asm volatile("s_waitcnt lgkmcnt(0)" ::: "memory");
#pragma unroll
            for (int j = 0; j < 8; ++j) {
                const int t = 8 * j + tl; const size_t tok = (size_t)cidx * 64 + t;
                const LAS u32x4* src = (const LAS u32x4*)(sl + t * SROW + cg * 8); const u32x4 s0 = src[0], s1 = src[1];
                const u32x4 gw_ = *(const u32x4*)(P + tok * PROJW + 256 + chb);
                u32x4 o;
                o.x = pk2(gelu_tanh(bflo(gw_.x)) * __uint_as_float(s0.x), gelu_tanh(bfhi(gw_.x)) * __uint_as_float(s0.y));
                o.y = pk2(gelu_tanh(bflo(gw_.y)) * __uint_as_float(s0.z), gelu_tanh(bfhi(gw_.y)) * __uint_as_float(s0.w));
                o.z = pk2(gelu_tanh(bflo(gw_.z)) * __uint_as_float(s1.x), gelu_tanh(bfhi(gw_.z)) * __uint_as_float(s1.y));
                o.w = pk2(gelu_tanh(bflo(gw_.w)) * __uint_as_float(s1.z), gelu_tanh(bfhi(gw_.w)) * __uint_as_float(s1.w));
                *(u32x4*)(Y + tok * DM + chb) = o;
            }
            asm volatile("s_waitcnt lgkmcnt(0)" ::: "memory");
        }
    }
}
namespace att {
constexpr int KROW = 272, VROW = 320, KBUF = 32 * KROW, VBUF = 32 * VROW, LDS_K = 0, LDS_V = 2 * KBUF, LDS_Q = 2 * KBUF + 2 * VBUF;
static_assert(LDS_Q + 256 * KROW + 16 <= LDS_BYTES, "attention LDS");
typedef short v4i16_t __attribute__((ext_vector_type(4)));
DEV s16x4 vtr(const LAS unsigned char* p) { return __builtin_bit_cast(s16x4, __builtin_amdgcn_ds_read_tr16_b64_v4i16((LAS v4i16_t*)p)); }


DEV void attn_unit(const bf16* PROJ, bf16* YMIX, int tok0, int S, int head, int qb, float lam, float oscale, const float* subg, float Bnd, LAS unsigned char* lds) {
    int tid_ = threadIdx.x; asm volatile("" : "+v"(tid_));
    const int tid = tid_, lane = tid & 63, r32 = lane & 31, hi = lane >> 5, wid = __builtin_amdgcn_readfirstlane(tid >> 6);
    const int qpos = qb * 256 + wid * 32 + r32;
    LAS unsigned char* qlds = lds + LDS_Q + wid * 32 * KROW;
    { const bf16* qg = PROJ + (size_t)(tok0 + qb * 256 + wid * 32) * PROJW + 512 + head * 128;
#pragma unroll
      for (int i = 0; i < 8; ++i) { const int ch = lane + 64 * i, row = ch >> 4, c16 = ch & 15; const u32x4 v = *(const u32x4*)(qg + (size_t)row * PROJW + c16 * 8); *(LAS u32x4*)(qlds + row * KROW + c16 * 16) = v; } }
    const LAS unsigned char* qfb = qlds + r32 * KROW + hi * 16;
    const float sl2 = __builtin_amdgcn_exp2f(-2.f * (float)(head + 1)) * LOG2E;
    const int srow = tid >> 4, sc16 = tid & 15;
    const bf16* kg = PROJ + (size_t)(tok0 + srow) * PROJW + 1024 + head * 128 + sc16 * 8;
    const bf16* vg = kg + 512;
    LAS unsigned char* kst = lds + LDS_K + srow * KROW + sc16 * 16;
    LAS unsigned char* vst = lds + LDS_V + srow * VROW + sc16 * 16;
    const LAS unsigned char* kfb = lds + LDS_K + r32 * KROW + hi * 16;
    const int i16 = lane & 15, gq = i16 >> 2, gp = i16 & 3, g1 = (lane >> 4) & 1;
    const LAS unsigned char* vfb = lds + LDS_V + (4 * hi + gq) * VROW + (16 * g1 + 4 * gp) * 2;
    u32x4 kr0, vr0;
    { const size_t go0 = (size_t)(qb * 8) * 32 * PROJW; kr0 = *(const u32x4*)(kg + go0); vr0 = *(const u32x4*)(vg + go0); }
    *(LAS u32x4*)kst = kr0; *(LAS u32x4*)vst = vr0;
    __syncthreads();
    f32x16 O[2][4];
#pragma unroll
    for (int c = 0; c < 2; ++c)
#pragma unroll
        for (int d = 0; d < 4; ++d)
#pragma unroll
            for (int r = 0; r < 16; ++r) O[c][d][r] = 0.f;
    float mrun[2] = {-1e30f, -1e30f}, lrun[2] = {0.f, 0.f};
    const int ts = qb * 8, qw0 = qb * 256 + wid * 32;
    int t_lo = 0, t_hi = (S >> 5) - 1;
    { const float Df = (2.f * Bnd + 160.f) / sl2; if (Df < (float)S) { const int D = (int)Df + 1; const int a_ = (qb * 256 - D) >> 5, b_ = (qb * 256 + 255 + D) >> 5; t_lo = a_ > 0 ? a_ : 0; t_hi = b_ < t_hi ? b_ : t_hi; } }
    const int NT = t_hi - t_lo + 1;
    f32x16 bcv; float csign = 1.f;
#pragma unroll
    for (int r = 0; r < 16; ++r) { float cr_ = (float)((r & 3) + 8 * (r >> 2)); asm volatile("" : "+v"(cr_)); bcv[r] = sl2 * cr_; }
    for (int i = 0; i < NT; ++i) {
        int t = ts + i; if (t > t_hi) t -= NT;
        int tn = t + 1; if (tn > t_hi) tn -= NT;
        const int cur = i & 1, k0 = t * 32;
        const LAS unsigned char* kb = kfb + cur * KBUF; const LAS unsigned char* vb = vfb + cur * VBUF;
        const float dqf = (float)(qpos - k0 - 4 * hi);
        const bool diag = (k0 == qw0);
        if (!diag) { const float want = (k0 < qw0) ? 1.f : -1.f;
            if (want != csign) { csign = want;
#pragma unroll
                for (int r = 0; r < 16; ++r) bcv[r] = -bcv[r]; } }
        const float lt = diag ? 0.f : -csign * sl2 * dqf;
        if (i + 1 < NT) { const size_t go = (size_t)tn * 32 * PROJW; kr0 = *(const u32x4*)(kg + go); vr0 = *(const u32x4*)(vg + go); }
        bf16x8 pf[2][2];
        f32x16 pp[2]; pp[0] = bcv; pp[1] = bcv;
#pragma unroll
        for (int c = 0; c < 2; ++c) {
            bf16x8 kf[4], qf[4];
#pragma unroll
            for (int ds = 0; ds < 4; ++ds) { kf[ds] = *(const LAS bf16x8*)(kb + (c * 64 + ds * 16) * 2); qf[ds] = *(const LAS bf16x8*)(qfb + (c * 64 + ds * 16) * 2); }
            __builtin_amdgcn_sched_barrier(0);
#pragma unroll
            for (int ds = 0; ds < 4; ++ds) pp[c] = __builtin_amdgcn_mfma_f32_32x32x16_bf16(kf[ds], qf[ds], pp[c], 0, 0, 0);
        }
        if (diag) {
#pragma unroll
            for (int r = 0; r < 16; ++r) { float cr = (float)((r & 3) + 8 * (r >> 2)); asm volatile("" : "+v"(cr)); const float fx = bcv[r] + sl2 * __builtin_fabsf(dqf - cr); pp[0][r] -= fx; pp[1][r] -= fx; }
        }
        float rm[2];
#pragma unroll
        for (int c = 0; c < 2; ++c) {
            float m_ = pp[c][0];
#pragma unroll
            for (int r = 1; r < 16; ++r) m_ = __builtin_fmaxf(m_, pp[c][r]);
            m_ += lt;
            auto rr = __builtin_amdgcn_permlane32_swap(__float_as_uint(m_), __float_as_uint(m_), false, false); rm[c] = __builtin_fmaxf(__uint_as_float(rr[0]), __uint_as_float(rr[1]));
        }
        if (__any(rm[0] > mrun[0] + 8.f || rm[1] > mrun[1] + 8.f)) {
#pragma unroll
            for (int c = 0; c < 2; ++c) {
                const float mnew = rm[c] > mrun[c] + 8.f ? rm[c] : mrun[c], alpha = __builtin_amdgcn_exp2f(mrun[c] - mnew);
                mrun[c] = mnew; lrun[c] *= alpha;
#pragma unroll
                for (int d = 0; d < 4; ++d)
#pragma unroll
                    for (int r = 0; r < 16; ++r) O[c][d][r] *= alpha;
            }
        }
#pragma unroll
        for (int c = 0; c < 2; ++c) {
            const float mm = mrun[c] - lt;
            float rs = 0.f;
#pragma unroll
            for (int r = 0; r < 16; ++r) { pp[c][r] = __builtin_amdgcn_exp2f(pp[c][r] - mm); rs += pp[c][r]; }
            lrun[c] += rs;
#pragma unroll
            for (int s = 0; s < 2; ++s) {
                u32x4 a;
                a.x = pk2(pp[c][8 * s + 0], pp[c][8 * s + 1]); a.y = pk2(pp[c][8 * s + 2], pp[c][8 * s + 3]); a.z = pk2(pp[c][8 * s + 4], pp[c][8 * s + 5]); a.w = pk2(pp[c][8 * s + 6], pp[c][8 * s + 7]);
                pf[c][s] = __builtin_bit_cast(bf16x8, a);
            }
        }
#pragma unroll
        for (int xs = 0; xs < 2; ++xs) { __builtin_amdgcn_sched_barrier(0);
            s16x4 vlo[4], vhi[4];
#pragma unroll
            for (int d = 0; d < 4; ++d) { vlo[d] = vtr(vb + (16 * xs) * VROW + d * 64); vhi[d] = vtr(vb + (16 * xs + 8) * VROW + d * 64); }
            __builtin_amdgcn_sched_barrier(0);
#pragma unroll
            for (int d = 0; d < 4; ++d) {
                const bf16x8 vf = {vlo[d][0], vlo[d][1], vlo[d][2], vlo[d][3], vhi[d][0], vhi[d][1], vhi[d][2], vhi[d][3]};
                O[0][d] = __builtin_amdgcn_mfma_f32_32x32x16_bf16(vf, pf[0][xs], O[0][d], 0, 0, 0);
                O[1][d] = __builtin_amdgcn_mfma_f32_32x32x16_bf16(vf, pf[1][xs], O[1][d], 0, 0, 0);
            }
        }
        if (i + 1 < NT) { const int nb = cur ^ 1; *(LAS u32x4*)(kst + nb * KBUF) = kr0; *(LAS u32x4*)(vst + nb * VBUF) = vr0; }
        __syncthreads();
    }
    const float l0 = lrun[0] + lane_xor(lrun[0], lane, 32), l1 = lrun[1] + lane_xor(lrun[1], lane, 32);
    const float i0 = 1.f / l0, i1 = lam / l1;
    float ss = 0.f;
#pragma unroll
    for (int d = 0; d < 4; ++d)
#pragma unroll
        for (int r = 0; r < 16; ++r) { const float o = O[0][d][r] * i0 - O[1][d][r] * i1; O[0][d][r] = o; ss += o * o; }
    ss += lane_xor(ss, lane, 32);
    const float rn = oscale / sqrtf(ss * (1.f / 128.f) + 1e-5f);
    bf16* yrow = YMIX + (size_t)(tok0 + qpos) * DM + 256 + head * 128;
#pragma unroll
    for (int d = 0; d < 4; ++d)
#pragma unroll
        for (int rg = 0; rg < 4; ++rg) { const int d0 = 32 * d + 8 * rg + 4 * hi; const f32x4 g4 = *(const f32x4*)(subg + d0);
            u32x2 w; w.x = pk2(O[0][d][4 * rg + 0] * rn * g4[0], O[0][d][4 * rg + 1] * rn * g4[1]); w.y = pk2(O[0][d][4 * rg + 2] * rn * g4[2], O[0][d][4 * rg + 3] * rn * g4[3]);
            *(u32x2*)(yrow + d0) = w; }
}
DEV void attn_phase(const Ctx& C, int l, LAS unsigned char* lds, int rep = 0) {
    const bf16* P = (const bf16*)(C.ws + WS_PROJ); bf16* Y = (bf16*)(C.ws + WS_YMIX);
    const float lam = ((const float*)(C.ws + WS_PAR))[1024 + l], li = ((const float*)(C.ws + WS_PAR))[1026 + l];
    const float* subg = C.in[19] + l * 128;
    const float* QN = (const float*)(C.ws + WS_NRM) + l * 320 * 8; const float* KN = (const float*)(C.ws + WS_NRM) + NRM_KN + l * 18 * 8;
    unsigned* qcnt = (unsigned*)(C.ws + WS_BAR) + 16 + 16 * l + 4 * rep;
    volatile LAS int* ubox = (volatile LAS int*)(lds + LDS_Q + 256 * KROW);
    for (;;) {
        if (C.tid == 0) ubox[0] = (int)__hip_atomic_fetch_add(qcnt, 1u, __ATOMIC_RELAXED, __HIP_MEMORY_SCOPE_AGENT);
        __syncthreads();
        const int u = ubox[0];
        if (u >= 1280) break;
        const int head = 3 - u / 320, r = u % 320;
        int tok0, S, qb, seq;
        if (r < 64) { seq = 16 + (r >> 5); qb = r & 31; tok0 = MP + (r >> 5) * SS; S = SS; }
        else { const int v = r - 64; seq = v >> 4; qb = v & 15; tok0 = seq * SP; S = SP; }
        const int blk = (tok0 >> 8) + qb;
        const float b0 = sqrtf(QN[blk * 8 + head * 2] * KN[seq * 8 + head * 2]), b1 = sqrtf(QN[blk * 8 + head * 2 + 1] * KN[seq * 8 + head * 2 + 1]);
        const float Bnd = 1.02f * fmaxf(b0, b1) + 0.5f;
        attn_unit(P, Y, tok0, S, head, qb, lam, 1.f - li, subg, Bnd, lds);
    }
}
}
DEV void grid_barrier(unsigned* bar, unsigned epoch, unsigned G) {
    asm volatile("s_waitcnt vmcnt(0)" ::: "memory");
    __syncthreads();
    if (threadIdx.x == 0) {
        __builtin_amdgcn_fence(__ATOMIC_RELEASE, "agent");
        asm volatile("s_waitcnt vmcnt(0)" ::: "memory");
        __hip_atomic_fetch_add(bar, 1u, __ATOMIC_RELAXED, __HIP_MEMORY_SCOPE_AGENT);
        const unsigned target = epoch * G;
        while (__hip_atomic_load(bar, __ATOMIC_RELAXED, __HIP_MEMORY_SCOPE_AGENT) < target) __builtin_amdgcn_s_sleep(2);
        __builtin_amdgcn_fence(__ATOMIC_ACQUIRE, "agent");
        asm volatile("s_waitcnt vmcnt(0)" ::: "memory");
    }
    __syncthreads();
}
#ifndef REP_ATT
#define REP_ATT 1
#endif
#ifndef REP_FFNUP
#define REP_FFNUP 1
#endif
#ifndef REP_DFT
#define REP_DFT 1
#endif
#ifndef REP_BAR
#define REP_BAR 1
#endif
#ifndef REP_FFNDN
#define REP_FFNDN 1
#endif
#ifndef REP_GATE
#define REP_GATE 1
#endif
#ifndef REP_OUT
#define REP_OUT 1
#endif
#ifndef REP_LN
#define REP_LN 1
#endif
#ifndef REP_PROJ
#define REP_PROJ 1
#endif
#ifndef REP_SCANA
#define REP_SCANA 1
#endif
#ifndef REP_SCANC
#define REP_SCANC 1
#endif
#ifndef REP_CONV
#define REP_CONV 1
#endif
#ifndef REP_BAR
#define REP_BAR 1
#endif
#ifndef REP_FFNDN
#define REP_FFNDN 1
#endif
#ifndef REP_GATE
#define REP_GATE 1
#endif
#ifndef REP_OUT
#define REP_OUT 1
#endif
#ifndef REP_LN
#define REP_LN 1
#endif
#ifndef REP_PRO
#define REP_PRO 1
#endif
struct Args { const float* in[21]; float* out; unsigned char* ws; int ph_lo, ph_hi; };
constexpr int NPHASES = 27;
__global__ void __launch_bounds__(512, 2) mk_fwd(Args a) {
    extern __shared__ __attribute__((aligned(16))) unsigned char lds_raw[];
    LAS unsigned char* lds = (LAS unsigned char*)lds_raw;
    cg::grid_group grid = cg::this_grid();
    Ctx C;
C.in = a.in; C.out = a.out; C.ws = a.ws; C.tid = threadIdx.x; C.lane = C.tid & 63; C.wave = __builtin_amdgcn_readfirstlane(C.tid >> 6); C.G = gridDim.x; C.bid = blockIdx.x;
    unsigned char* ws = a.ws;
    const int lo = a.ph_lo, hi = a.ph_hi;
    int ph = 0; unsigned epoch = 0;
#define PH_BEGIN if (ph >= lo && ph < hi) { { int t_ = threadIdx.x; asm volatile("" : "+v"(t_)); C.tid = t_; C.lane = t_ & 63; C.wave = __builtin_amdgcn_readfirstlane(t_ >> 6); size_t z_ = 0; asm volatile("" : "+s"(z_)); ws = a.ws + z_; C.ws = ws; C.out = a.out + z_;     int g_ = gridDim.x, b_ = blockIdx.x; asm volatile("" : "+s"(g_), "+s"(b_)); C.G = g_; C.bid = b_; }
#define PH_END   if (ph + 1 < hi) { for (int rb_ = 0; rb_ < REP_BAR; ++rb_) grid_barrier((unsigned*)(a.ws + WS_BAR), ++epoch, gridDim.x); } } ++ph;
#define XB ((bf16*)(ws + WS_XB))
#define H ((bf16*)(ws + WS_H))
#define PROJ ((bf16*)(ws + WS_PROJ))
#define YMIX ((bf16*)(ws + WS_YMIX))
    if (ph >= lo && ph < hi) { { int t_ = threadIdx.x; asm volatile("" : "+v"(t_)); C.tid = t_; C.lane = t_ & 63; C.wave = __builtin_amdgcn_readfirstlane(t_ >> 6); }
#ifndef NO_PRO
 for (int rep_ = 0; rep_ < REP_PRO; ++rep_) { phase_prologue(C, lds); __syncthreads(); }
#endif
 __syncthreads(); if (ph + 1 < hi) grid.sync(); } ++ph;
    for (int l = 0; l < 2; ++l) {
        for (int f = 0; f < 2; ++f) {
            if (f == 1) {
                PH_BEGIN
                { pg8::Gemm g{XB, (const bf16*)(ws + WS_WIN) + (size_t)l * 2048 * 1024, 1024, 1024, 1024, 0, 0}; pg8::StaticOrder S; S.init(MTOK, 2048, C.G, C.bid);
                  epi::Proj E{PROJ};
#ifndef NO_PROJ
 for (int rep_ = 0; rep_ < REP_PROJ; ++rep_) pg8::gemm_phase<epi::Proj, pg8::StaticOrder, true, true, 1024, 1024, 1024>(lds, g, S, E);
#endif
 }
                { pg8::Gemm g{(const bf16*)(ws + WS_WF) + (size_t)l * 512 * 1024, XB, 1024, 1024, 1024, 0, 0}; pg8::StaticOrder S; S.init(512, MTOK, C.G, C.bid);
                  epi::FT E{(bf16*)(ws + WS_BTF)};
#ifndef NO_FT
 for (int rep_ = 0; rep_ < REP_PROJ; ++rep_) pg8::gemm_phase<epi::FT, pg8::StaticOrder, true, true, 1024, 1024, 1024>(lds, g, S, E);
#endif
 }
                PH_END
                PH_BEGIN for (int rep_ = 0; rep_ < REP_CONV; ++rep_) phase_conv(C, l); PH_END
                PH_BEGIN
                { pg8::Gemm g{(const bf16*)(ws + WS_XC), (const bf16*)(ws + WS_WG) + (size_t)l * 1024 * 256, 256, 256, 256, 0, 0}; pg8::StaticOrder S; S.init(MTOK, 1024, C.G, C.bid);
                  epi::Raw E{(bf16*)(ws + WS_AU)};
#ifndef NO_GATE
 for (int rep_ = 0; rep_ < REP_GATE; ++rep_) pg8::gemm_phase<epi::Raw, pg8::StaticOrder, true, true, 256, 256, 256>(lds, g, S, E);
#endif
 }
                PH_END
                PH_BEGIN
#ifndef NO_SCANA
 for (int rep_ = 0; rep_ < REP_SCANA; ++rep_) phase_scan<false>(C, l, lds);
 __syncthreads();
#endif
                { pg8::Gemm g{(const bf16*)(ws + WS_DFT), (const bf16*)(ws + WS_BTF), 8192, 8192, 8192, 0, (size_t)256 * 8192}; epi::DftOrder S{C.G, C.bid};
                  epi::DFT E{YMIX, (float*)(ws + WS_PART), 0.001953125f  };
#ifndef NO_DFT
 for (int rep_ = 0; rep_ < REP_DFT; ++rep_) pg8::gemm_phase<epi::DFT, epi::DftOrder, true, true, 8192, 8192, 8192>(lds, g, S, E);
#endif
 }
#ifndef NO_ATT
 for (int rep_ = 0; rep_ < REP_ATT; ++rep_) att::attn_phase(C, l, lds, rep_);
#endif
 PH_END
                PH_BEGIN
phase_dft_combine(C);
#ifndef NO_SCANC
 for (int rep_ = 0; rep_ < REP_SCANC; ++rep_) phase_scan<true>(C, l, lds);
#endif
 PH_END
                PH_BEGIN
                { pg8::Gemm g{YMIX, (const bf16*)(ws + WS_WOUT) + (size_t)l * 1024 * 1024, 1024, 1024, 1024, 0, 0}; pg8::StaticOrder S; S.init(MTOK, 1024, C.G, C.bid);
                  epi::Resid E{C.out, 1.0f, (const float*)(ws + WS_STATS), C.in[2] + (l * 3 + 0) * 1024, C.in[3] + (l * 3 + 0) * 1024, C.out, C.out + (size_t)MP * DM};
#ifndef NO_OUT
 for (int rep_ = 1; rep_ < REP_OUT; ++rep_) { epi::Resid E0{C.out, 0.f, (const float*)(ws + WS_STATS), (const float*)(ws + WS_ONES), (const float*)(ws + WS_ONES) + 1024, C.out, C.out + (size_t)MP * DM, 1.f}; pg8::gemm_phase<epi::Resid, pg8::StaticOrder, true, true, 1024, 1024, 1024>(lds, g, S, E0); }
 pg8::gemm_phase<epi::Resid, pg8::StaticOrder, true, true, 1024, 1024, 1024>(lds, g, S, E);
#endif
 }
                PH_END
                PH_BEGIN for (int rep_ = 0; rep_ < REP_LN; ++rep_) phase_ln(C, C.in[2] + (l * 3 + 1) * 1024, C.in[3] + (l * 3 + 1) * 1024, false); PH_END
            }
            PH_BEGIN
            { pg8::Gemm g{XB, (const bf16*)(ws + WS_WGU) + (size_t)(l * 2 + f) * 5632 * 1024, 1024, 1024, 1024, 0, 0}; pg8::StaticOrder S; S.init(MTOK, 5632, C.G, C.bid);
              epi::SwiGLU E{H};
#ifndef NO_FFNUP
 for (int rep_ = 0; rep_ < REP_FFNUP; ++rep_) pg8::gemm_phase<epi::SwiGLU, pg8::StaticOrder, true, true, 1024, 1024, 1024>(lds, g, S, E);
#endif
 }
            PH_END
            PH_BEGIN
            { pg8::Gemm g{H, (const bf16*)(ws + WS_WD) + (size_t)(l * 2 + f) * 1024 * 2816, 2816, 2816, 2816, 0, 0}; pg8::StaticOrder S; S.init(MTOK, 1024, C.G, C.bid);
              const bool ident_ = (l == 0 && f == 0); const int pidx_ = f == 1 ? l * 3 + 1 : (l - 1) * 3 + 2;
              epi::Resid E{C.out, 0.5f, (const float*)(ws + WS_STATS), ident_ ? (const float*)(ws + WS_ONES) : C.in[2] + pidx_ * 1024, ident_ ? (const float*)(ws + WS_ONES) + 1024 : C.in[3] + pidx_ * 1024, ident_ ? C.in[0] : C.out, ident_ ? C.in[1] : C.out + (size_t)MP * DM};
#ifndef NO_FFNDN
 for (int rep_ = 1; rep_ < REP_FFNDN; ++rep_) { epi::Resid E0{C.out, 0.f, (const float*)(ws + WS_STATS), (const float*)(ws + WS_ONES), (const float*)(ws + WS_ONES) + 1024, C.out, C.out + (size_t)MP * DM, 1.f}; pg8::gemm_phase<epi::Resid, pg8::StaticOrder, true, true, 2816, 2816, 2816>(lds, g, S, E0); }
 pg8::gemm_phase<epi::Resid, pg8::StaticOrder, true, true, 2816, 2816, 2816>(lds, g, S, E);
#endif
 }
            PH_END
            PH_BEGIN for (int rep_ = 0; rep_ < ((l == 1 && f == 1) ? 1 : REP_LN); ++rep_) phase_ln(C, C.in[2] + (l * 3 + 2 * f) * 1024, C.in[3] + (l * 3 + 2 * f) * 1024, l == 1 && f == 1); PH_END
        }
    }
}

#ifndef MK_COOP
#define MK_COOP 1
#endif
extern "C" void kernel_launch(void* const* d_in, const int* in_sizes, int n_in, void* d_out, int out_size, void* d_ws, size_t ws_size, hipStream_t stream) {
    static int grid = 0;
    if (grid == 0) {
        if (n_in != 21 || out_size != MTOK * DM || ws_size < WS_END) { fprintf(stderr, "kernel_launch: unexpected shapes (n_in %d out %d ws %zu)\n", n_in, out_size, ws_size); grid = -1; return; }
        int dev = 0, cus = 0, per_cu = 0;
        hipGetDevice(&dev); hipDeviceGetAttribute(&cus, hipDeviceAttributeMultiprocessorCount, dev);
        hipFuncSetAttribute((const void*)mk_fwd, hipFuncAttributeMaxDynamicSharedMemorySize, LDS_BYTES);
        hipOccupancyMaxActiveBlocksPerMultiprocessor(&per_cu, (const void*)mk_fwd, 512, LDS_BYTES);
        (void)hipGetLastError();
        if (per_cu < 1) per_cu = 1;
        grid = cus;
    }
    if (grid < 0) return;
    if (MK_COOP) (void)hipMemsetAsync((char*)d_ws + WS_BAR, 0, 256, stream);
    Args a{};
    for (int i = 0; i < 21; ++i) a.in[i] = (const float*)d_in[i];
    a.out = (float*)d_out; a.ws = (unsigned char*)d_ws;
#if MK_COOP
    a.ph_lo = 0; a.ph_hi = NPHASES;
    void* args[] = {&a};
    hipError_t e = hipLaunchCooperativeKernel((const void*)mk_fwd, dim3(grid), dim3(512), args, LDS_BYTES, stream);
    if (e != hipSuccess) fprintf(stderr, "cooperative launch failed: %s (grid %d)\n", hipGetErrorString(e), grid);
#else
    for (int p = 0; p < NPHASES; ++p) { a.ph_lo = p; a.ph_hi = p + 1; hipLaunchKernelGGL(mk_fwd, dim3(grid), dim3(512), LDS_BYTES, stream, a); }
#endif
}
```

```cpp
#include <hip/hip_runtime.h>
#include <hip/hip_cooperative_groups.h>
#include <hip/hip_bf16.h>
#include <cstdio>
#include <cstdint>
#include <cmath>
namespace cg = cooperative_groups;
namespace pg8 {
#define PG8_LAS __attribute__((address_space(3)))
typedef unsigned short bf16_t;
typedef short bf16x8 __attribute__((ext_vector_type(8)));
typedef float f32x4 __attribute__((ext_vector_type(4)));
typedef unsigned u32x4 __attribute__((ext_vector_type(4)));
constexpr int BM = 256, BK = 64, HALF = 128, HTB = HALF * BK * 2  , STAGE_BYTES = 8 * HTB, NXCD = 8, WGM = 8;

__host__ __device__ __forceinline__ int lds_byte(int r, int c) { const int st = (r >> 4) * 2 + (c >> 5), rr = r & 15, cc = c & 31, ob = rr * 64 + cc * 2; return st * 1024 + (ob ^ (((ob >> 9) & 1) << 5)); }
__host__ __device__ __forceinline__ void stage_rc(int b, int& R, int& C) { const int st = b / 1024, sb = b % 1024, swz = sb ^ (((sb >> 9) & 1) << 5); R = (st >> 1) * 16 + swz / 64; C = (st & 1) * 32 + (swz % 64) / 2; }
__host__ __device__ __forceinline__ int perm32(int rho) { const int n = rho >> 4, i = rho & 15; return 8 * (i >> 2) + 4 * n + (i & 3); }

struct Unit { int pm, pn, z; };
struct Gemm { const bf16_t* A; const bf16_t* Bt; int K, lda, ldb; size_t zA, zB; };

struct StaticOrder {
    int nM, nN, nwg, G, c; int rev = 0;
    __host__ __device__ void init(int M, int N, int G_, int c_) { nM = M / BM; nN = N / BM; nwg = nM * nN; G = G_; c = c_; }
    __host__ __device__ bool next(int i, Unit& u) const {
        const long L = (long)i * G + c; if (L >= nwg) return false;
        int wgid = rev ? nwg - 1 - (int)L : (int)L; { const int q = nwg / NXCD, r = nwg % NXCD, xcd = wgid % NXCD, off = wgid / NXCD; wgid = (xcd < r ? xcd * (q + 1) : r * (q + 1) + (xcd - r) * q) + off; }
        const int nig = WGM * nN, gid = wgid / nig, fm = gid * WGM, gsz = (nM - fm) < WGM ? (nM - fm) : WGM;
        u.pm = fm + ((wgid % nig) % gsz); u.pn = (wgid % nig) / gsz; u.z = 0; return true;
    }
    __device__ __forceinline__ void a_ready(const Unit&) const {}
    __device__ __forceinline__ void done(const Unit&) const {}
};

__device__ __forceinline__ unsigned cvt_pk_bf16(float lo, float hi) { unsigned r; asm volatile("v_cvt_pk_bf16_f32 %0, %1, %2" : "=v"(r) : "v"(lo), "v"(hi)); return r; }
typedef float f32x2 __attribute__((ext_vector_type(2)));
__device__ __forceinline__ f32x2 gelu_pk(f32x2 v) {
    const f32x2 av = __builtin_elementwise_abs(v), d = av * 0.2316418882f + 1.0f;
    f32x2 t; t.x = __builtin_amdgcn_rcpf(d.x); t.y = __builtin_amdgcn_rcpf(d.y);
    f32x2 q = t * 0.5307027145f + (-0.7265760135f); q = q * t + 0.7107068705f; q = q * t + (-0.142248368f); q = q * t + 0.127414796f; q = q * t;
    const f32x2 s = (v * v) * (-0.72134752044f);
    f32x2 e; e.x = __builtin_amdgcn_exp2f(s.x); e.y = __builtin_amdgcn_exp2f(s.y);
    const f32x2 m = v * (q * e), r = v - m;
    f32x2 o; o.x = v.x < 0.f ? m.x : r.x; o.y = v.y < 0.f ? m.y : r.y; return o;
}

template <int ACT  > struct EpiBf16 {
    static constexpr bool PERM = true, AFTER_DRAIN = false; static_assert(ACT == 0 || ACT == 1, "EpiBf16: ACT is 0 (none) or 1 (gelu_pk)");
    bf16_t* O; int ldc; const float* bias; int split_cols; size_t split_stride; float scale0;
    __device__ __forceinline__ void operator()(const f32x4 (&acc)[2][2][4][2], const Unit& u, int wr, int wc, int fr, int fq) const {
        const int row0 = u.pm * BM + wr * 64 + fr; int colt = u.pn * BM; bf16_t* base = O;
        float sc = 1.f; if (split_cols) { const int t = colt / split_cols; base += (size_t)t * split_stride; colt -= t * split_cols; if (t == 0) sc = scale0; }
        const int col0 = colt + wc * 32 + 8 * fq, bcol0 = u.pn * BM + wc * 32 + 8 * fq;
        f32x4 bv[2][2];
#pragma unroll
        for (int bj = 0; bj < 2; ++bj)
#pragma unroll
            for (int n = 0; n < 2; ++n) bv[bj][n] = bias ? *(const f32x4*)(bias + bcol0 + bj * HALF + 4 * n) : (f32x4){0.f, 0.f, 0.f, 0.f};
#pragma unroll
        for (int ai = 0; ai < 2; ++ai)
#pragma unroll
            for (int m = 0; m < 4; ++m) { bf16_t* rowp = base + (size_t)(row0 + ai * HALF + m * 16) * ldc + col0;
#pragma unroll
                for (int bj = 0; bj < 2; ++bj) { f32x4 v0 = acc[ai][bj][m][0] + bv[bj][0], v1 = acc[ai][bj][m][1] + bv[bj][1];
                    if (ACT == 1) { f32x2 a = gelu_pk((f32x2){v0[0], v0[1]}), b = gelu_pk((f32x2){v0[2], v0[3]}), c = gelu_pk((f32x2){v1[0], v1[1]}), d = gelu_pk((f32x2){v1[2], v1[3]});
                        v0 = (f32x4){a.x, a.y, b.x, b.y}; v1 = (f32x4){c.x, c.y, d.x, d.y}; }
                    v0 = v0 * sc; v1 = v1 * sc; u32x4 w; w.x = cvt_pk_bf16(v0[0], v0[1]); w.y = cvt_pk_bf16(v0[2], v0[3]); w.z = cvt_pk_bf16(v1[0], v1[1]); w.w = cvt_pk_bf16(v1[2], v1[3]);
                    *(u32x4*)(rowp + bj * HALF) = w; } }
    }
};

template <class Epi, class Sched, bool ALIGN_EPI, bool SP2, int KK, int LDA, int LDB>
__device__ __forceinline__ void gemm_phase(PG8_LAS unsigned char* lds, const Gemm g, const Sched& S, const Epi& E) {
    int tid_ = threadIdx.x; asm volatile("" : "+v"(tid_));
    const int tid = tid_, wid = __builtin_amdgcn_readfirstlane(tid >> 6), lane = tid & 63, wr = wid >> 2, wc = wid & 3, fr = lane & 15, fq = lane >> 4;
    constexpr int K = KK, nt = K / BK;
    unsigned voffA[2], voffB[2];
#pragma unroll
    for (int i = 0; i < 2; ++i) { int R, C; stage_rc(tid * 16 + i * 8192, R, C); const int Rb = Epi::PERM ? ((R & ~31) + perm32(R & 31)) : R;
        voffA[i] = (unsigned)(R * LDA + C) * 2u; voffB[i] = (unsigned)(Rb * LDB + C) * 2u; }
    constexpr size_t kstep = (size_t)(BK * 2);
    constexpr size_t hstepA = (size_t)HALF * LDA * 2, hstepB = (size_t)HALF * LDB * 2;
    constexpr size_t tstepA = 2 * hstepA, tstepB = 2 * hstepB;
    const unsigned ldsw = (unsigned)wid * 1024u;
    const int aoff = lds_byte(wr * 64 + fr, fq * 8), boff = lds_byte(wc * 32 + fr, fq * 8);
#define PG8_SA(b, h) (((b) * 2 + (h)) * HTB)
#define PG8_SB(b, h) ((4 + (b) * 2 + (h)) * HTB)
#define PG8_STAGE(bufoff, gbase, voff) do { _Pragma("unroll") for (int _i = 0; _i < 2; ++_i) \
        __builtin_amdgcn_global_load_lds((const unsigned*)((const char*)(gbase) + (voff)[_i]), (PG8_LAS unsigned*)(lds + (bufoff) + ldsw + _i * 8192), 16, 0, 0); } while (0)
#define PG8_LDA(dst, b, h) do { _Pragma("unroll") for (int m = 0; m < 4; ++m) _Pragma("unroll") for (int k = 0; k < 2; ++k) dst[m][k] = *(const PG8_LAS bf16x8*)(lds + PG8_SA(b, h) + aoff + m * 2048 + k * 1024); } while (0)
#define PG8_LDB(dst, b, h) do { _Pragma("unroll") for (int n = 0; n < 2; ++n) _Pragma("unroll") for (int k = 0; k < 2; ++k) dst[n][k] = *(const PG8_LAS bf16x8*)(lds + PG8_SB(b, h) + boff + n * 2048 + k * 1024); } while (0)
#define PG8_MMA(ai, bj, At, Bt) do { __builtin_amdgcn_s_setprio(1); _Pragma("unroll") for (int m = 0; m < 4; ++m) _Pragma("unroll") for (int n = 0; n < 2; ++n) _Pragma("unroll") for (int k = 0; k < 2; ++k) \
        acc[ai][bj][m][n] = __builtin_amdgcn_mfma_f32_16x16x32_bf16(Bt[n][k], At[m][k], acc[ai][bj][m][n], 0, 0, 0); __builtin_amdgcn_s_setprio(0); } while (0)
#define PG8_WAIT_V(n) asm volatile("s_waitcnt vmcnt(" #n ")" ::: "memory")
#define PG8_WAIT_L(n) asm volatile("s_waitcnt lgkmcnt(" #n ")" ::: "memory")
#define PG8_BAR __builtin_amdgcn_s_barrier()
#define PG8_SCHED __builtin_amdgcn_sched_barrier(0)
    Unit cur, nxt; int ui = 0;
    if (!S.next(0, cur)) return;
    f32x4 acc[2][2][4][2];
#pragma unroll
    for (int a = 0; a < 2; ++a)
#pragma unroll
        for (int b = 0; b < 2; ++b)
#pragma unroll
            for (int m = 0; m < 4; ++m)
#pragma unroll
                for (int n = 0; n < 2; ++n) acc[a][b][m][n] = (f32x4){0.f, 0.f, 0.f, 0.f};
    bf16x8 At[4][2], B0[2][2], B1[2][2];
    const char* cA = (const char*)g.A + (size_t)cur.z * g.zA * 2 + (size_t)cur.pm * tstepA; const char* cB = (const char*)g.Bt + (size_t)cur.z * g.zB * 2 + (size_t)cur.pn * tstepB;
    S.a_ready(cur);
    if constexpr (SP2) {
        PG8_STAGE(PG8_SB(0, 0), cB, voffB); PG8_STAGE(PG8_SB(0, 1), cB + hstepB, voffB); PG8_STAGE(PG8_SA(0, 0), cA, voffA); PG8_STAGE(PG8_SA(0, 1), cA + hstepA, voffA);
        if (wr == 1) PG8_BAR;
        PG8_WAIT_V(2); PG8_BAR;
        PG8_STAGE(PG8_SB(1, 0), cB + kstep, voffB); PG8_STAGE(PG8_SA(1, 0), cA + kstep, voffA); PG8_STAGE(PG8_SB(1, 1), cB + hstepB + kstep, voffB);
        PG8_WAIT_V(6); PG8_BAR;
    } else {
        PG8_STAGE(PG8_SB(0, 0), cB, voffB); PG8_STAGE(PG8_SA(0, 0), cA, voffA); PG8_STAGE(PG8_SB(0, 1), cB + hstepB, voffB); PG8_STAGE(PG8_SA(0, 1), cA + hstepA, voffA);
        if (wr == 1) PG8_BAR;
        PG8_WAIT_V(4); PG8_BAR;
        PG8_STAGE(PG8_SB(1, 0), cB + kstep, voffB); PG8_STAGE(PG8_SA(1, 0), cA + kstep, voffA); PG8_STAGE(PG8_SB(1, 1), cB + hstepB + kstep, voffB);
        PG8_WAIT_V(6); PG8_BAR;
    }
    for (;;) {
        const bool has_next = S.next(ui + 1, nxt);
        const char* nA = has_next ? (const char*)g.A + (size_t)nxt.z * g.zA * 2 + (size_t)nxt.pm * tstepA : cA; const char* nB = has_next ? (const char*)g.Bt + (size_t)nxt.z * g.zB * 2 + (size_t)nxt.pn * tstepB : cB;
        for (int t = 0; t < nt; t += 2) {
            const bool last = (t == nt - 2);
            const char* a1 = cA + (size_t)(t + 1) * kstep;
            const char* a2 = last ? nA : cA + (size_t)(t + 2) * kstep; const char* b2 = last ? nB : cB + (size_t)(t + 2) * kstep;
            const char* a3 = a2 + kstep; const char* b3 = b2 + kstep;
            if (last && has_next) S.a_ready(nxt);
            if constexpr (SP2) {
            PG8_LDB(B0, 0, 0); PG8_LDB(B1, 0, 1); PG8_SCHED; PG8_LDA(At, 0, 0); PG8_STAGE(PG8_SA(1, 1), a1 + hstepA, voffA);
            PG8_WAIT_V(8); PG8_WAIT_L(0); PG8_BAR; PG8_MMA(0, 0, At, B0); PG8_MMA(0, 1, At, B1); PG8_BAR; PG8_SCHED;
            PG8_LDA(At, 0, 1); PG8_STAGE(PG8_SB(0, 0), b2, voffB); PG8_STAGE(PG8_SB(0, 1), b2 + hstepB, voffB); PG8_STAGE(PG8_SA(0, 0), a2, voffA);
            PG8_WAIT_V(8); PG8_WAIT_L(0); PG8_BAR; PG8_MMA(1, 0, At, B0); PG8_MMA(1, 1, At, B1); PG8_BAR; PG8_SCHED;
            PG8_LDB(B0, 1, 0); PG8_LDB(B1, 1, 1); PG8_SCHED; PG8_LDA(At, 1, 0); PG8_STAGE(PG8_SA(0, 1), a2 + hstepA, voffA);
            PG8_WAIT_V(8); PG8_WAIT_L(0); PG8_BAR; PG8_MMA(0, 0, At, B0); PG8_MMA(0, 1, At, B1); PG8_BAR; PG8_SCHED;
            PG8_LDA(At, 1, 1); PG8_STAGE(PG8_SB(1, 0), b3, voffB); PG8_STAGE(PG8_SB(1, 1), b3 + hstepB, voffB); PG8_STAGE(PG8_SA(1, 0), a3, voffA);
            PG8_WAIT_V(8); PG8_WAIT_L(0); PG8_BAR; PG8_MMA(1, 0, At, B0); PG8_MMA(1, 1, At, B1); PG8_BAR; PG8_SCHED;
            } else {
            PG8_LDB(B0, 0, 0); PG8_SCHED; PG8_LDA(At, 0, 0); PG8_STAGE(PG8_SA(1, 1), a1 + hstepA, voffA);
            PG8_WAIT_L(8); PG8_BAR; PG8_WAIT_L(0); PG8_MMA(0, 0, At, B0); PG8_BAR; PG8_SCHED;
            PG8_LDB(B1, 0, 1); PG8_STAGE(PG8_SB(0, 0), b2, voffB);
            PG8_BAR; PG8_WAIT_L(0); PG8_MMA(0, 1, At, B1); PG8_BAR;
            PG8_LDA(At, 0, 1); PG8_STAGE(PG8_SA(0, 0), a2, voffA);
            PG8_BAR; PG8_WAIT_L(0); PG8_MMA(1, 0, At, B0); PG8_BAR; PG8_SCHED;
            PG8_STAGE(PG8_SB(0, 1), b2 + hstepB, voffB);
            PG8_WAIT_V(6); PG8_BAR; PG8_MMA(1, 1, At, B1); PG8_BAR;
            PG8_LDB(B0, 1, 0); PG8_SCHED; PG8_LDA(At, 1, 0); PG8_STAGE(PG8_SA(0, 1), a2 + hstepA, voffA);
            PG8_WAIT_L(8); PG8_BAR; PG8_WAIT_L(0); PG8_MMA(0, 0, At, B0); PG8_BAR; PG8_SCHED;
            PG8_LDB(B1, 1, 1); PG8_STAGE(PG8_SB(1, 0), b3, voffB);
            PG8_BAR; PG8_WAIT_L(0); PG8_MMA(0, 1, At, B1); PG8_BAR;
            PG8_LDA(At, 1, 1); PG8_STAGE(PG8_SA(1, 0), a3, voffA);
            PG8_BAR; PG8_WAIT_L(0); PG8_MMA(1, 0, At, B0); PG8_BAR; PG8_SCHED;
            PG8_STAGE(PG8_SB(1, 1), b3 + hstepB, voffB);
            PG8_WAIT_V(6); PG8_BAR; PG8_MMA(1, 1, At, B1); PG8_BAR;
            }
        }
        if constexpr (ALIGN_EPI) { if (wr == 0) PG8_BAR; }
        if constexpr (!Epi::AFTER_DRAIN) { E(acc, cur, wr, wc, fr, fq); S.done(cur); }
        if (!has_next) break;
#pragma unroll
        for (int a = 0; a < 2; ++a)
#pragma unroll
            for (int b = 0; b < 2; ++b)
#pragma unroll
                for (int m = 0; m < 4; ++m)
#pragma unroll
                    for (int n = 0; n < 2; ++n) acc[a][b][m][n] = (f32x4){0.f, 0.f, 0.f, 0.f};
        cur = nxt; cA = nA; cB = nB; ++ui;
        if constexpr (ALIGN_EPI) { if (wr == 1) PG8_BAR; }
    }
    PG8_WAIT_V(0);
    if constexpr (!ALIGN_EPI) { if (wr == 0) PG8_BAR; }
    PG8_BAR;
    if constexpr (Epi::AFTER_DRAIN) { E.fused(acc, cur, wr, wc, fr, fq, lds, wid, lane); S.done(cur); }
#undef PG8_SA
#undef PG8_SB
#undef PG8_STAGE
#undef PG8_LDA
#undef PG8_LDB
#undef PG8_MMA
#undef PG8_WAIT_V
#undef PG8_WAIT_L
#undef PG8_BAR
#undef PG8_SCHED
}
}
#define DEV __device__ __forceinline__
#define LAS __attribute__((address_space(3)))
typedef unsigned short bf16;
typedef float f32x4 __attribute__((ext_vector_type(4)));
typedef float f32x2 __attribute__((ext_vector_type(2)));
typedef float f32x16 __attribute__((ext_vector_type(16)));
typedef unsigned u32x4 __attribute__((ext_vector_type(4)));
typedef unsigned u32x2 __attribute__((ext_vector_type(2)));
typedef short bf16x8 __attribute__((ext_vector_type(8)));
typedef short s16x4 __attribute__((ext_vector_type(4)));
typedef __bf16 bf16x2_t __attribute__((ext_vector_type(2)));

constexpr int DM = 1024, DFF = 2816, MTOK = 81920, MP = 65536, SP = 4096, SS = 8192;
constexpr int PROJW = 2048;
constexpr float LOG2E = 1.4426950408889634f;
constexpr float QSCALE = 0.125f * LOG2E;
constexpr float ALPHA = 1.4142135623730951f;
constexpr size_t MiB = 1u << 20;
constexpr size_t WS_PAR = 0;
constexpr size_t WS_NRM = 256 * 1024;
constexpr int NRM_KN = 2 * 320 * 8;
constexpr size_t WS_BAR = 512 * 1024;
constexpr size_t WS_WGU = 1 * MiB;
constexpr size_t WS_WD = 45 * MiB;
constexpr size_t WS_WIN = 67 * MiB;
constexpr size_t WS_WF = 75 * MiB;
constexpr size_t WS_WOUT = 77 * MiB;
constexpr size_t WS_WG = 81 * MiB;
constexpr size_t WS_DFT = 82 * MiB;
constexpr size_t WS_AGG = 210 * MiB;
constexpr size_t WS_STATS = 215 * MiB;
constexpr size_t WS_ONES = WS_STATS + 768 * 1024;
constexpr size_t WS_PROJ = 216 * MiB;
constexpr size_t WS_BTF = 536 * MiB;
constexpr size_t WS_XC = 632 * MiB;
constexpr size_t WS_YMIX = 672 * MiB;
constexpr size_t WS_AU = 832 * MiB;
constexpr size_t WS_XB = WS_AU;
constexpr size_t WS_H = WS_PROJ;
constexpr size_t WS_PART = 992 * MiB;
constexpr size_t WS_END = 1008 * MiB;
static_assert(WS_H + (size_t)MTOK * DFF * 2 <= WS_YMIX, "H overlay");
constexpr int LDS_BYTES = 147456;

DEV unsigned pk2(float lo, float hi) { f32x2 v = {lo, hi}; bf16x2_t b = __builtin_convertvector(v, bf16x2_t); return __builtin_bit_cast(unsigned, b); }
DEV float bf2f(unsigned short b) { return __uint_as_float((unsigned)b << 16); }
DEV float bflo(unsigned w) { return __uint_as_float(w << 16); }
DEV float bfhi(unsigned w) { return __uint_as_float(w & 0xffff0000u); }
DEV float lane_xor(float v, int lane, int o) { return __int_as_float(__builtin_amdgcn_ds_bpermute((lane ^ o) << 2, __float_as_int(v))); }
DEV float wave_sum(float v, int lane) {
#pragma unroll
    for (int o = 1; o < 64; o <<= 1) v += lane_xor(v, lane, o);
    return v;
}
DEV float sigmoidf_(float x) { return __builtin_amdgcn_rcpf(1.f + __builtin_amdgcn_exp2f(-LOG2E * x)); }

namespace epi {
using pg8::Unit; using pg8::HALF; using pg8::BM;
struct SwiGLU {
    static constexpr bool PERM = true, AFTER_DRAIN = false;
    bf16* H;
    DEV void operator()(const f32x4 (&acc)[2][2][4][2], const Unit& u, int wr, int wc, int fr_, int fq_) const {
        int t__ = threadIdx.x; asm volatile("" : "+v"(t__)); const int fr = t__ & 15, fq = (t__ >> 4) & 3; (void)fr_; (void)fq_;
        const int col0 = u.pn * 128 + wc * 32 + 8 * fq;
#pragma unroll
        for (int ai = 0; ai < 2; ++ai)
#pragma unroll
            for (int m = 0; m < 4; ++m) {
                const int row = u.pm * BM + ai * HALF + wr * 64 + m * 16 + fr;
                float o[8];
#pragma unroll
                for (int n = 0; n < 2; ++n)
#pragma unroll
                    for (int e = 0; e < 4; ++e) { const float g = acc[ai][0][m][n][e], up = acc[ai][1][m][n][e]; o[4 * n + e] = g * sigmoidf_(g) * up; }
                u32x4 w; w.x = pk2(o[0], o[1]); w.y = pk2(o[2], o[3]); w.z = pk2(o[4], o[5]); w.w = pk2(o[6], o[7]);
                *(u32x4*)(H + (size_t)row * DFF + col0) = w; asm volatile("" ::: "memory");
            }
    }
};
struct Resid {
    static constexpr bool PERM = true, AFTER_DRAIN = false;
    float* X; float s; const float* stats; const float* g; const float* b; const float* r0; const float* r1; float al = ALPHA;
    DEV void operator()(const f32x4 (&acc)[2][2][4][2], const Unit& u, int wr, int wc, int fr_, int fq_) const {
        int t__ = threadIdx.x; asm volatile("" : "+v"(t__)); const int fr = t__ & 15, fq = (t__ >> 4) & 3; (void)fr_; (void)fq_;
        const int colb = u.pn * BM + wc * 32 + 8 * fq;
        const float* rsrc = (u.pm * BM < MP) ? r0 : r1 - (size_t)MP * DM;
        f32x4 gv[2][2], bv[2][2];
#pragma unroll
        for (int bj = 0; bj < 2; ++bj)
#pragma unroll
            for (int n = 0; n < 2; ++n) { gv[bj][n] = *(const f32x4*)(g + colb + bj * HALF + n * 4); bv[bj][n] = *(const f32x4*)(b + colb + bj * HALF + n * 4); }
#pragma unroll
        for (int ai = 0; ai < 2; ++ai)
#pragma unroll
            for (int m = 0; m < 4; ++m) {
                const size_t row = (size_t)(u.pm * BM + ai * HALF + wr * 64 + m * 16 + fr);
                const f32x2 st = *(const f32x2*)(stats + row * 2);
                float* rp = X + row * DM + colb; const float* rq = rsrc + row * DM + colb;
#pragma unroll
                for (int bj = 0; bj < 2; ++bj)
#pragma unroll
                    for (int n = 0; n < 2; ++n) { f32x4* p = (f32x4*)(rp + bj * HALF + n * 4); const f32x4 yv = *(const f32x4*)(rq + bj * HALF + n * 4); const f32x4 x = ((yv - st[0]) * st[1]) * gv[bj][n] + bv[bj][n]; *p = x * al + acc[ai][bj][m][n] * s; }
                asm volatile("" ::: "memory");
            }
    }
};
struct Proj {
    static constexpr bool PERM = true, AFTER_DRAIN = false;
    bf16* P;
    DEV void operator()(const f32x4 (&acc)[2][2][4][2], const Unit& u, int wr, int wc, int fr_, int fq_) const {
        int t__ = threadIdx.x; asm volatile("" : "+v"(t__)); const int fr = t__ & 15, fq = (t__ >> 4) & 3; (void)fr_; (void)fq_;
        const float sc = (u.pn == 2 || u.pn == 3) ? QSCALE : 1.f;
        const int col0 = u.pn * BM + wc * 32 + 8 * fq;
#pragma unroll
        for (int ai = 0; ai < 2; ++ai)
#pragma unroll
            for (int m = 0; m < 4; ++m) {
                bf16* rp = P + (size_t)(u.pm * BM + ai * HALF + wr * 64 + m * 16 + fr) * PROJW + col0;
#pragma unroll
                for (int bj = 0; bj < 2; ++bj) { const f32x4 v0 = acc[ai][bj][m][0] * sc, v1 = acc[ai][bj][m][1] * sc;
                    u32x4 w; w.x = pk2(v0[0], v0[1]); w.y = pk2(v0[2], v0[3]); w.z = pk2(v1[0], v1[1]); w.w = pk2(v1[2], v1[3]);
                    *(u32x4*)(rp + bj * HALF) = w; }
                asm volatile("" ::: "memory");
            }
    }
};
struct FT {
    static constexpr bool PERM = true, AFTER_DRAIN = false;
    bf16* BP;
    DEV void operator()(const f32x4 (&acc)[2][2][4][2], const Unit& u, int wr, int wc, int fr_, int fq_) const {
        int t__ = threadIdx.x; asm volatile("" : "+v"(t__)); const int fr = t__ & 15, fq = (t__ >> 4) & 3; (void)fr_; (void)fq_;
        const int which = u.pm;
#pragma unroll
        for (int ai = 0; ai < 2; ++ai)
#pragma unroll
            for (int m = 0; m < 4; ++m) {
                const int n = ai * HALF + wr * 64 + m * 16 + fr;
#pragma unroll
                for (int bj = 0; bj < 2; ++bj) {
                    const int t0 = u.pn * BM + bj * HALF + wc * 32 + 8 * fq;
                    const f32x4 v0 = acc[ai][bj][m][0], v1 = acc[ai][bj][m][1];
                    if (t0 < MP) {
                        const int seq = t0 >> 12, s = t0 & 4095;
                        u32x4 w; w.x = pk2(v0[0], v0[1]); w.y = pk2(v0[2], v0[3]); w.z = pk2(v1[0], v1[1]); w.w = pk2(v1[2], v1[3]);
                        *(u32x4*)(BP + ((size_t)seq * 256 + n) * 8192 + which * 4096 + s) = w;
                    } else {
                        const int tt = t0 - MP, seq2 = tt >> 13, s = tt & 8191;
                        u32x2 ev, od; ev.x = pk2(v0[0], v0[2]); ev.y = pk2(v1[0], v1[2]); od.x = pk2(v0[1], v0[3]); od.y = pk2(v1[1], v1[3]);
                        bf16* be = BP + ((size_t)(16 + seq2 * 2) * 256 + n) * 8192 + which * 4096 + (s >> 1);
                        *(u32x2*)be = ev; *(u32x2*)(be + (size_t)256 * 8192) = od;
                    }
                }
                asm volatile("" ::: "memory");
            }
    }
};
struct DFT {
    static constexpr bool PERM = true, AFTER_DRAIN = false;
    bf16* Y; float* PART; float scale;
    DEV void operator()(const f32x4 (&acc)[2][2][4][2], const Unit& u, int wr, int wc, int fr_, int fq_) const {
        int t__ = threadIdx.x; asm volatile("" : "+v"(t__)); const int fr = t__ & 15, fq = (t__ >> 4) & 3; (void)fr_; (void)fq_;
        const int col0 = wc * 32 + 8 * fq;
        if (u.z < 16) {
#pragma unroll
            for (int ai = 0; ai < 2; ++ai)
#pragma unroll
                for (int m = 0; m < 4; ++m) {
                    bf16* rp = Y + (size_t)(u.z * SP + u.pm * BM + ai * HALF + wr * 64 + m * 16 + fr) * DM + 768 + col0;
#pragma unroll
                    for (int bj = 0; bj < 2; ++bj) { const f32x4 v0 = acc[ai][bj][m][0] * scale, v1 = acc[ai][bj][m][1] * scale;
                        u32x4 w; w.x = pk2(v0[0], v0[1]); w.y = pk2(v0[2], v0[3]); w.z = pk2(v1[0], v1[1]); w.w = pk2(v1[2], v1[3]);
                        *(u32x4*)(rp + bj * HALF) = w; }
                    asm volatile("" ::: "memory");
                }
        } else {
#pragma unroll
            for (int ai = 0; ai < 2; ++ai)
#pragma unroll
                for (int m = 0; m < 4; ++m) {
                    float* rp = PART + ((size_t)(u.z - 16) * 4096 + (u.pm & 15) * BM + ai * HALF + wr * 64 + m * 16 + fr) * 256 + col0;
#pragma unroll
                    for (int bj = 0; bj < 2; ++bj) { *(f32x4*)(rp + bj * HALF) = acc[ai][bj][m][0]; *(f32x4*)(rp + bj * HALF + 4) = acc[ai][bj][m][1]; }
                    asm volatile("" ::: "memory");
                }
        }
    }
};
struct DftOrder {
    int G, c;
    DEV bool next(int i, Unit& u) const { const int L = i * G + c; if (L >= 320) return false; u.pn = 0;
        if (L < 288) { const int pmA = L / 18, zi = L - pmA * 18; u.pm = pmA; u.z = zi < 16 ? zi : 16 + 2 * (zi - 16); }
        else { const int L2 = L - 288; u.pm = 16 + (L2 >> 1); u.z = 17 + 2 * (L2 & 1); }
        return true; }
    DEV void a_ready(const Unit&) const {}
    DEV void done(const Unit&) const {}
};
struct Raw {
    static constexpr bool PERM = true, AFTER_DRAIN = false;
    bf16* P;
    DEV void operator()(const f32x4 (&acc)[2][2][4][2], const Unit& u, int wr, int wc, int fr_, int fq_) const {
        int t__ = threadIdx.x; asm volatile("" : "+v"(t__)); const int fr = t__ & 15, fq = (t__ >> 4) & 3; (void)fr_; (void)fq_;
        const int col0 = u.pn * BM + wc * 32 + 8 * fq;
#pragma unroll
        for (int ai = 0; ai < 2; ++ai)
#pragma unroll
            for (int m = 0; m < 4; ++m) {
                bf16* rp = P + (size_t)(u.pm * BM + ai * HALF + wr * 64 + m * 16 + fr) * 1024 + col0;
#pragma unroll
                for (int bj = 0; bj < 2; ++bj) { const f32x4 v0 = acc[ai][bj][m][0], v1 = acc[ai][bj][m][1];
                    u32x4 w; w.x = pk2(v0[0], v0[1]); w.y = pk2(v0[2], v0[3]); w.z = pk2(v1[0], v1[1]); w.w = pk2(v1[2], v1[3]);
                    *(u32x4*)(rp + bj * HALF) = w; }
                asm volatile("" ::: "memory");
            }
    }
};
struct BatchOrder {
    int lz, nM, G, c;
    DEV bool next(int i, Unit& u) const { const int L = i * G + c; if (L >= (nM << lz)) return false; u.pm = L >> lz; u.z = L & ((1 << lz) - 1); u.pn = 0; return true; }
    DEV void a_ready(const Unit&) const {}
    DEV void done(const Unit&) const {}
};
}
struct Ctx {
    const float* const* in; float* out; unsigned char* ws;
    int tid, lane, wave, G, bid;
};
#ifndef RPA
#define RPA 1
#endif
#ifndef RPB
#define RPB 1
#endif
#ifndef RPE
#define RPE 1
#endif
#ifndef RPF
#define RPF 1
#endif
DEV void transpose_item(const float* W, int ldw, int srccol0, bf16* WT, int ldo, int dstrow0, int k0, LAS float* scr, int lane) {
#pragma unroll 8
    for (int i = 0; i < 32; ++i) { const int kk = 2 * i + (lane >> 5); scr[kk * 33 + (lane & 31)] = W[(size_t)(k0 + kk) * ldw + srccol0 + (lane & 31)]; }
    asm volatile("s_waitcnt lgkmcnt(0)" ::: "memory");
    const int c = lane & 7;
#pragma unroll
    for (int j = 0; j < 4; ++j) { const int n = (lane >> 3) + 8 * j; const LAS float* s = scr + (8 * c) * 33 + n;
        u32x4 o; o.x = pk2(s[0 * 33], s[1 * 33]); o.y = pk2(s[2 * 33], s[3 * 33]); o.z = pk2(s[4 * 33], s[5 * 33]); o.w = pk2(s[6 * 33], s[7 * 33]);
        *(u32x4*)(WT + (size_t)(dstrow0 + n) * ldo + k0 + 8 * c) = o; }
    asm volatile("s_waitcnt lgkmcnt(0)" ::: "memory");
}
DEV void phase_prologue(const Ctx& C, LAS unsigned char* lds) {
    const int gw = C.bid * 8 + C.wave, NGW = C.G * 8;
    const long gt = (long)C.bid * 512 + C.tid, NGT = (long)C.G * 512;
    unsigned char* ws = C.ws;
for (int rp_ = 0; rp_ < RPA; ++rp_) {
    {
        LAS float* scr = (LAS float*)(lds + C.wave * 16384);
        for (int it = gw; it < 2 * 9984; it += NGW) {
            const int l = it / 9984, r = it % 9984; int j, q;
            if (r < 8448) { j = r / 1408; q = r % 1408; } else if (r < 9472) { j = 6; q = r - 8448; } else { j = 7; q = r - 9472; }
            const float* src; int ldw, K, N; bf16* dst; int inter = 0, ioff = 0;
            if (j == 0 || j == 1 || j == 3 || j == 4) { const int f = j >= 3; const int up = (j == 1 || j == 4);
                src = C.in[(f ? 7 : 4) + up] + (size_t)l * DM * DFF; ldw = DFF; K = DM; N = DFF; dst = (bf16*)(ws + WS_WGU) + (size_t)(l * 2 + f) * 5632 * 1024; inter = 1; ioff = up ? 128 : 0; }
            else if (j == 2 || j == 5) { const int f = j == 5; src = C.in[f ? 9 : 6] + (size_t)l * DFF * DM; ldw = DM; K = DFF; N = DM; dst = (bf16*)(ws + WS_WD) + (size_t)(l * 2 + f) * 1024 * 2816; }
            else if (j == 6) { src = C.in[10] + (size_t)l * DM * 2304; ldw = 2304; K = DM; N = 2048; dst = (bf16*)(ws + WS_WIN) + (size_t)l * 2048 * 1024; }
            else { src = C.in[20] + (size_t)l * DM * DM; ldw = DM; K = DM; N = DM; dst = (bf16*)(ws + WS_WOUT) + (size_t)l * 1024 * 1024; }
            const int nblk = N / 32, kb = q / nblk, nb = q % nblk, n0 = 32 * nb;
            const int drow = inter ? (256 * (n0 >> 7) + (n0 & 127) + ioff) : n0;
            transpose_item(src, ldw, n0, dst, K, drow, 64 * kb, scr, C.lane);
        }
    }
}
    for (int rp_ = 0; rp_ < RPB; ++rp_) {
    {
        LAS float* tw = (LAS float*)(lds + 8 * 16384);
        if (C.tid < 64) { float sn, cs; sincospif((float)C.tid * (1.0f / 32.0f), &sn, &cs); tw[C.tid] = cs; tw[64 + C.tid] = sn; }
        __syncthreads();
        for (long it = gt; it < 2L * 512 * 128; it += NGT) {
            const int l = (int)(it / (512 * 128)), r = (int)(it % (512 * 128)), nrow = r >> 7, k0 = (r & 127) * 8;
            const int which = nrow >> 8, g = (nrow >> 6) & 3, cp = nrow & 63;
            const float* wsrc = C.in[10] + (size_t)l * DM * 2304 + 2048 + 64 * g;
            float o[8];
#pragma unroll
            for (int kk = 0; kk < 8; ++kk) {
                const float* wr_ = wsrc + (size_t)(k0 + kk) * 2304; float a = 0.f;
                for (int c = 0; c < 64; c += 4) { const f32x4 w4 = *(const f32x4*)(wr_ + c);
                    a += w4[0] * tw[which * 64 + (((c + 0) * cp) & 63)] + w4[1] * tw[which * 64 + (((c + 1) * cp) & 63)] + w4[2] * tw[which * 64 + (((c + 2) * cp) & 63)] + w4[3] * tw[which * 64 + (((c + 3) * cp) & 63)]; }
                o[kk] = a;
            }
            u32x4 w; w.x = pk2(o[0], o[1]); w.y = pk2(o[2], o[3]); w.z = pk2(o[4], o[5]); w.w = pk2(o[6], o[7]);
            *(u32x4*)((bf16*)(ws + WS_WF) + ((size_t)l * 512 + nrow) * 1024 + k0) = w;
        }
    }
}
    for (long it = gt; it < 2L * 1024 * 32; it += NGT) {
        const int l = (int)(it / (1024 * 32)), r = (int)(it % (1024 * 32)), n = r >> 5, k0 = (r & 31) * 8;
        const int tn = n >> 8, dir = tn >> 1, chh = tn & 1, within = n & 255, gate = within >> 7, ch = chh * 128 + (within & 127), hb = ch >> 6, jj = ch & 63;
        u32x4 w = {0u, 0u, 0u, 0u};
        if ((k0 >> 6) == hb) {
            const float* src = C.in[gate ? 15 : 13] + ((size_t)((l * 2 + dir) * 4 + hb) * 64) * 64 + jj;
            float o[8];
#pragma unroll
            for (int kk = 0; kk < 8; ++kk) o[kk] = src[(size_t)((k0 & 63) + kk) * 64];
            w.x = pk2(o[0], o[1]); w.y = pk2(o[2], o[3]); w.z = pk2(o[4], o[5]); w.w = pk2(o[6], o[7]);
        }
        *(u32x4*)((bf16*)(ws + WS_WG) + ((size_t)l * 1024 + n) * 256 + k0) = w;
    }
    if (gt < 1024) { const float lam = C.in[17][gt]; ((float*)(ws + WS_PAR))[gt] = 8.f * log1pf(expf(-lam)); }
    if (gt >= 1024 && gt < 1026) { const int l = (int)gt - 1024; const float* lq = C.in[18] + l * 256; float s1 = 0.f, s2 = 0.f;
        for (int i = 0; i < 64; ++i) { s1 += lq[i] * lq[64 + i]; s2 += lq[128 + i] * lq[192 + i]; }
        const float li = 0.8f - 0.6f * expf(-0.3f * (float)l);
        ((float*)(ws + WS_PAR))[1024 + l] = expf(s1) - expf(s2) + li; ((float*)(ws + WS_PAR))[1026 + l] = li; }
    if (gt < NRM_KN + 2 * 18 * 8) ((unsigned*)(ws + WS_NRM))[gt] = 0u;
    if (gt < MTOK) *(f32x2*)((float*)(ws + WS_STATS) + gt * 2) = (f32x2){0.f, 1.f};
    if (gt < 2048) ((float*)(ws + WS_ONES))[gt] = gt < 1024 ? 1.f : 0.f;
for (int rp_ = 0; rp_ < RPE; ++rp_) {
for (int rp_ = 0; rp_ < RPE; ++rp_) {
    for (long it = gt; it < 8192L * 1024; it += NGT) {
        const int row = (int)(it >> 10), k0 = (int)(it & 1023) * 8, odd = row >> 12, sp = row & 4095, neg = k0 >> 12, nb = k0 & 4095;
        float o[8];
#pragma unroll
        for (int e = 0; e < 8; ++e) { const int n = nb + e; float sn, cs;
            if (!odd) { const int idx = (n * sp) & 4095; sincospif((float)idx * (1.0f / 2048.0f), &sn, &cs); }
            else { const int idx = ((2 * n + 1) * sp) & 8191; sincospif((float)idx * (1.0f / 4096.0f), &sn, &cs); }
            o[e] = neg ? -sn : cs; }
        u32x4 w; w.x = pk2(o[0], o[1]); w.y = pk2(o[2], o[3]); w.z = pk2(o[4], o[5]); w.w = pk2(o[6], o[7]);
        *(u32x4*)((bf16*)(ws + WS_DFT) + (size_t)row * 8192 + k0) = w;
    }
}
    {
        const f32x4* xp = (const f32x4*)C.in[0]; const f32x4* xs = (const f32x4*)C.in[1]; u32x2* xb = (u32x2*)(ws + WS_XB);
        const long NP = (long)MP * 256, NT = (long)MTOK * 256;
        for (long it = gt; it < NT; it += NGT) { const f32x4 v = it < NP ? xp[it] : xs[it - NP]; u32x2 w; w.x = pk2(v[0], v[1]); w.y = pk2(v[2], v[3]); xb[it] = w; }
    }
}
}
DEV void ln_row(const f32x4 (&cur)[4], const f32x4 (&gv)[4], const f32x4 (&bv)[4], int m, int lane, float* out, unsigned char* ws, bool final_) {
    float s = 0.f, q = 0.f;
#pragma unroll
    for (int j = 0; j < 4; ++j) { s += (cur[j][0] + cur[j][1]) + (cur[j][2] + cur[j][3]); q += (cur[j][0] * cur[j][0] + cur[j][1] * cur[j][1]) + (cur[j][2] * cur[j][2] + cur[j][3] * cur[j][3]); }
#pragma unroll
    for (int o = 1; o < 64; o <<= 1) { const float s2 = lane_xor(s, lane, o), q2 = lane_xor(q, lane, o); s += s2; q += q2; }
    const float mean = s * (1.f / DM), var = __builtin_fmaxf(q * (1.f / DM) - mean * mean, 0.f), rstd = 1.f / sqrtf(var + 1e-5f);
    if (final_) {
        f32x4* xr = (f32x4*)(out + (size_t)m * DM) + lane;
#pragma unroll
        for (int j = 0; j < 4; ++j) xr[64 * j] = (cur[j] - mean) * rstd * gv[j] + bv[j];
    } else {
        u32x2* o8 = (u32x2*)((bf16*)(ws + WS_XB) + (size_t)m * DM) + lane;
#pragma unroll
        for (int j = 0; j < 4; ++j) { const f32x4 y = (cur[j] - mean) * rstd * gv[j] + bv[j]; u32x2 w; w.x = pk2(y[0], y[1]); w.y = pk2(y[2], y[3]); o8[64 * j] = w; }
        if (lane == 0) *(f32x2*)((float*)(ws + WS_STATS) + (size_t)m * 2) = (f32x2){mean, rstd};
    }
}
DEV void phase_ln(const Ctx& C, const float* g, const float* b, bool final_) {
    const int gw = C.bid * 8 + C.wave, NGW = C.G * 8, lane = C.lane;
    f32x4 gv[4], bv[4];
#pragma unroll
    for (int j = 0; j < 4; ++j) { gv[j] = ((const f32x4*)g)[lane + 64 * j]; bv[j] = ((const f32x4*)b)[lane + 64 * j]; }
    f32x4 c0[4], c1[4], n0[4], n1[4];
    auto ld = [&](f32x4 (&d)[4], int m) { const int mm = m < MTOK ? m : gw;
#pragma unroll
        for (int j = 0; j < 4; ++j) d[j] = ((const f32x4*)(C.out + (size_t)mm * DM))[lane + 64 * j]; };
    ld(c0, gw); ld(c1, gw + NGW);
    for (int m = gw; m < MTOK; m += 2 * NGW) {
        ld(n0, m + 2 * NGW); ld(n1, m + 3 * NGW);
        ln_row(c0, gv, bv, m, lane, C.out, C.ws, final_);
        if (m + NGW < MTOK) ln_row(c1, gv, bv, m + NGW, lane, C.out, C.ws, final_);
#pragma unroll
        for (int j = 0; j < 4; ++j) { c0[j] = n0[j]; c1[j] = n1[j]; }
    }
}
DEV void phase_dft_combine(const Ctx& C) {
    const long gt = (long)C.bid * 512 + C.tid, NGT = (long)C.G * 512;
    const float* PART = (const float*)(C.ws + WS_PART); bf16* Y = (bf16*)(C.ws + WS_YMIX); const float sc = 0.001381067932004976f;
    for (long it = gt; it < 2L * 4096 * 64; it += NGT) {
        const int seq2 = (int)(it >> 18), r = (int)(it & 262143), sp = r >> 6, c = (r & 63) * 4;
        const f32x4 p1 = *(const f32x4*)(PART + ((size_t)(seq2 * 2) * 4096 + sp) * 256 + c), p2 = *(const f32x4*)(PART + ((size_t)(seq2 * 2 + 1) * 4096 + sp) * 256 + c);
        const f32x4 lo = (p1 + p2) * sc, hi = (p1 - p2) * sc;
        u32x2 wl, wh; wl.x = pk2(lo[0], lo[1]); wl.y = pk2(lo[2], lo[3]); wh.x = pk2(hi[0], hi[1]); wh.y = pk2(hi[2], hi[3]);
        bf16* yl = Y + (size_t)(MP + seq2 * SS + sp) * DM + 768 + c;
        *(u32x2*)yl = wl; *(u32x2*)(yl + (size_t)4096 * DM) = wh;
    }
}
DEV void phase_conv(const Ctx& C, int l) {
    const long gt = (long)C.bid * 512 + C.tid, NGT = (long)C.G * 512;
    const bf16* P = (const bf16*)(C.ws + WS_PROJ); bf16* XC = (bf16*)(C.ws + WS_XC);
    const float* cw = C.in[11] + l * 4 * 256; const float* cb = C.in[12] + l * 256;
    for (long it = gt; it < (long)MTOK * 32; it += NGT) {
        const int tok = (int)(it >> 5), c0 = (int)(it & 31) * 8;
        const int pos = tok < MP ? (tok & 4095) : ((tok - MP) & 8191), S = tok < MP ? SP : SS;
        float a[8];
        { const f32x4 b0 = *(const f32x4*)(cb + c0), b1 = *(const f32x4*)(cb + c0 + 4); a[0] = b0[0]; a[1] = b0[1]; a[2] = b0[2]; a[3] = b0[3]; a[4] = b1[0]; a[5] = b1[1]; a[6] = b1[2]; a[7] = b1[3]; }
#pragma unroll
        for (int j = 0; j < 4; ++j) { const int tt = pos - 2 + j;
            if (tt >= 0 && tt < S) { const u32x4 xw = *(const u32x4*)(P + (size_t)(tok - 2 + j) * PROJW + c0);
                const f32x4 w0 = *(const f32x4*)(cw + j * 256 + c0), w1 = *(const f32x4*)(cw + j * 256 + c0 + 4);
                a[0] += w0[0] * bflo(xw.x); a[1] += w0[1] * bfhi(xw.x); a[2] += w0[2] * bflo(xw.y); a[3] += w0[3] * bfhi(xw.y);
                a[4] += w1[0] * bflo(xw.z); a[5] += w1[1] * bfhi(xw.z); a[6] += w1[2] * bflo(xw.w); a[7] += w1[3] * bfhi(xw.w); } }
        u32x4 w; w.x = pk2(a[0], a[1]); w.y = pk2(a[2], a[3]); w.z = pk2(a[4], a[5]); w.w = pk2(a[6], a[7]);
        *(u32x4*)(XC + (size_t)tok * 256 + c0) = w;
    }
    unsigned* QN = (unsigned*)(C.ws + WS_NRM) + l * 320 * 8; unsigned* KN = (unsigned*)(C.ws + WS_NRM) + NRM_KN + l * 18 * 8;
    for (long it = gt; it < (long)MTOK * 8; it += NGT) {
        const int tok = (int)(it >> 3), hm = (int)(it & 7);
        const bf16* qp = P + (size_t)tok * PROJW + 512 + hm * 64; float sq = 0.f, sk = 0.f;
#pragma unroll
        for (int j = 0; j < 8; ++j) { const u32x4 a = *(const u32x4*)(qp + 8 * j), k4 = *(const u32x4*)(qp + 512 + 8 * j);
            sq += bflo(a.x) * bflo(a.x) + bfhi(a.x) * bfhi(a.x) + bflo(a.y) * bflo(a.y) + bfhi(a.y) * bfhi(a.y) + bflo(a.z) * bflo(a.z) + bfhi(a.z) * bfhi(a.z) + bflo(a.w) * bflo(a.w) + bfhi(a.w) * bfhi(a.w);
            sk += bflo(k4.x) * bflo(k4.x) + bfhi(k4.x) * bfhi(k4.x) + bflo(k4.y) * bflo(k4.y) + bfhi(k4.y) * bfhi(k4.y) + bflo(k4.z) * bflo(k4.z) + bfhi(k4.z) * bfhi(k4.z) + bflo(k4.w) * bflo(k4.w) + bfhi(k4.w) * bfhi(k4.w); }
#pragma unroll
        for (int o = 8; o < 64; o <<= 1) { sq = fmaxf(sq, lane_xor(sq, C.lane, o)); sk = fmaxf(sk, lane_xor(sk, C.lane, o)); }
        if (C.lane < 8) { const int seq = tok < MP ? (tok >> 12) : 16 + ((tok - MP) >> 13);
            atomicMax(QN + (tok >> 8) * 8 + hm, __float_as_uint(sq)); atomicMax(KN + seq * 8 + hm, __float_as_uint(sk)); }
    }
}
DEV float fsig(float x) { return __builtin_amdgcn_rcpf(1.f + __builtin_amdgcn_exp2f(-LOG2E * x)); }
DEV void gate_eval(float rp, float ip, float xc, float ba, float bx, float sp8, float& la2, float& u) {
    const float r = fsig(rp + ba), ig = fsig(ip + bx);
    la2 = -sp8 * r * LOG2E;
    const float em = __builtin_fmaxf(1.f - __builtin_amdgcn_exp2f(2.f * la2), 0.f);
    u = __builtin_amdgcn_sqrtf(em) * ig * xc;
}
DEV float gelu_tanh(float x) { const float z = 0.7978845608028654f * (x + 0.044715f * x * x * x); const float e = __builtin_amdgcn_exp2f(2.f * LOG2E * z); return 0.5f * x * (2.f - 2.f * __builtin_amdgcn_rcpf(e + 1.f)); }
constexpr int SROW = 68;
typedef _Float16 h16x2 __attribute__((ext_vector_type(2)));
DEV unsigned pkh(float a, float b) { return __builtin_bit_cast(unsigned, __builtin_amdgcn_cvt_pkrtz(a, b)); }
template <int DIRV> DEV void gate_stage(const bf16* gbase, const bf16* xcb, int chb, int tl, int cg, LAS unsigned* sl, const float* pba, const float* pbx, const float* par) {
    const int col = (DIRV * 2 + (chb >> 7)) * 256 + (chb & 127);
    float ba[8], bx[8], sp[8];
#pragma unroll
    for (int q = 0; q < 2; ++q) { const f32x4 a = *(const f32x4*)(pba + DIRV * 256 + chb + 4 * q), b = *(const f32x4*)(pbx + DIRV * 256 + chb + 4 * q), s = *(const f32x4*)(par + DIRV * 256 + chb + 4 * q);
#pragma unroll
        for (int e = 0; e < 4; ++e) { ba[4 * q + e] = a[e]; bx[4 * q + e] = b[e]; sp[4 * q + e] = s[e]; } }
#pragma unroll
    for (int j = 0; j < 8; ++j) {
        const int t = 8 * j + tl;
        const u32x4 rw = *(const u32x4*)(gbase + (size_t)t * 1024 + col), iw = *(const u32x4*)(gbase + (size_t)t * 1024 + col + 128), xw = *(const u32x4*)(xcb + (size_t)t * 256);
        const float rp[8] = {bflo(rw.x), bfhi(rw.x), bflo(rw.y), bfhi(rw.y), bflo(rw.z), bfhi(rw.z), bflo(rw.w), bfhi(rw.w)};
        const float ip[8] = {bflo(iw.x), bfhi(iw.x), bflo(iw.y), bfhi(iw.y), bflo(iw.z), bfhi(iw.z), bflo(iw.w), bfhi(iw.w)};
        const float xc[8] = {bflo(xw.x), bfhi(xw.x), bflo(xw.y), bfhi(xw.y), bflo(xw.z), bfhi(xw.z), bflo(xw.w), bfhi(xw.w)};
        unsigned w[8];
#pragma unroll
        for (int e = 0; e < 8; ++e) { float la, u; gate_eval(rp[e], ip[e], xc[e], ba[e], bx[e], sp[e], la, u); w[e] = pkh(la, u); }
        LAS u32x4* dst = (LAS u32x4*)(sl + t * SROW + cg * 8);
        dst[0] = (u32x4){w[0], w[1], w[2], w[3]}; dst[1] = (u32x4){w[4], w[5], w[6], w[7]};
    }
    asm volatile("s_waitcnt lgkmcnt(0)" ::: "memory");
}
template <bool FINAL> DEV void phase_scan(const Ctx& C, int l, LAS unsigned char* lds) {
    const int gw = C.bid * 8 + C.wave, NGW = C.G * 8, lane = C.lane, tl = lane >> 3, cg = lane & 7;
    const bf16* GP = (const bf16*)(C.ws + WS_AU); float* AGG = (float*)(C.ws + WS_AGG); const bf16* XC = (const bf16*)(C.ws + WS_XC);
    const bf16* P = (const bf16*)(C.ws + WS_PROJ); bf16* Y = (bf16*)(C.ws + WS_YMIX);
    const float* par = (const float*)(C.ws + WS_PAR) + l * 512; const float* pba = C.in[14] + l * 512; const float* pbx = C.in[16] + l * 512;
    LAS unsigned* sl = (LAS unsigned*)(lds + C.wave * (64 * SROW * 4));
    for (int it = gw; it < 1280 * 4; it += NGW) {
        const int cidx = it >> 2, g4 = it & 3, ch = g4 * 64 + lane, chb = g4 * 64 + cg * 8;
        const bf16* gbase = GP + (size_t)cidx * 64 * 1024; const bf16* xcb = XC + (size_t)cidx * 64 * 256 + chb;
        if (!FINAL) {
            gate_stage<0>(gbase, xcb, chb, tl, cg, sl, pba, pbx, par);
            { float Ps = 0.f, h = 0.f;
#pragma unroll 16
              for (int t = 0; t < 64; ++t) { const h16x2 w = __builtin_bit_cast(h16x2, sl[t * SROW + lane]); const float la = (float)w[0]; h = __builtin_amdgcn_exp2f(la) * h + (float)w[1]; Ps += la; }
              *(f32x2*)(AGG + ((size_t)(cidx * 2 + 0) * 256 + ch) * 2) = (f32x2){Ps, h}; }
            asm volatile("s_waitcnt lgkmcnt(0)" ::: "memory");
            gate_stage<1>(gbase, xcb, chb, tl, cg, sl, pba, pbx, par);
            { float Ps = 0.f, h = 0.f;
#pragma unroll 16
              for (int t = 63; t >= 0; --t) { const h16x2 w = __builtin_bit_cast(h16x2, sl[t * SROW + lane]); const float la = (float)w[0]; h = __builtin_amdgcn_exp2f(la) * h + (float)w[1]; Ps += la; }
              *(f32x2*)(AGG + ((size_t)(cidx * 2 + 1) * 256 + ch) * 2) = (f32x2){Ps, h}; }
            asm volatile("s_waitcnt lgkmcnt(0)" ::: "memory");
        } else {
            int c0, c1; if (cidx < 1024) { c0 = cidx & ~63; c1 = c0 + 64; } else { c0 = 1024 + ((cidx - 1024) & ~127); c1 = c0 + 128; }
            float hin = 0.f, hbin = 0.f;
#pragma unroll 16
            for (int c = c0; c < cidx; ++c) { const f32x2 a = *(const f32x2*)(AGG + ((size_t)(c * 2 + 0) * 256 + ch) * 2); hin = __builtin_amdgcn_exp2f(a[0]) * hin + a[1]; }
#pragma unroll 16
            for (int c = c1 - 1; c > cidx; --c) { const f32x2 a = *(const f32x2*)(AGG + ((size_t)(c * 2 + 1) * 256 + ch) * 2); hbin = __builtin_amdgcn_exp2f(a[0]) * hbin + a[1]; }
            gate_stage<0>(gbase, xcb, chb, tl, cg, sl, pba, pbx, par);
            float hf[64]; float h = hin;
#pragma unroll
            for (int t = 0; t < 64; ++t) { const h16x2 w = __builtin_bit_cast(h16x2, sl[t * SROW + lane]); h = __builtin_amdgcn_exp2f((float)w[0]) * h + (float)w[1]; hf[t] = h; }
            asm volatile("s_waitcnt lgkmcnt(0)" ::: "memory");
            gate_stage<1>(gbase, xcb, chb, tl, cg, sl, pba, pbx, par);
            h = hbin;
#pragma unroll
            for (int t = 63; t >= 0; --t) { const h16x2 w = __builtin_bit_cast(h16x2, sl[t * SROW + lane]); h = __builtin_amdgcn_exp2f((float)w[0]) * h + (float)w[1]; sl[t * SROW + lane] = __float_as_uint(hf[t] + h); }
            asm volatile("s_waitcnt lgkmcnt(0)" ::: "memory");
#pragma unroll
            for (int j = 0; j < 8; ++j) {
                const int t = 8 * j + tl; const size_t tok = (size_t)cidx * 64 + t;
                const LAS u32x4* src = (const LAS u32x4*)(sl + t * SROW + cg * 8); const u32x4 s0 = src[0], s1 = src[1];
                const u32x4 gw_ = *(const u32x4*)(P + tok * PROJW + 256 + chb);
                u32x4 o;
                o.x = pk2(gelu_tanh(bflo(gw_.x)) * __uint_as_float(s0.x), gelu_tanh(bfhi(gw_.x)) * __uint_as_float(s0.y));
                o.y = pk2(gelu_tanh(bflo(gw_.y)) * __uint_as_float(s0.z), gelu_tanh(bfhi(gw_.y)) * __uint_as_float(s0.w));
                o.z = pk2(gelu_tanh(bflo(gw_.z)) * __uint_as_float(s1.x), gelu_tanh(bfhi(gw_.z)) * __uint_as_float(s1.y));
                o.w = pk2(gelu_tanh(bflo(gw_.w)) * __uint_as_float(s1.z), gelu_tanh(bfhi(gw_.w)) * __uint_as_float(s1.w));
                *(u32x4*)(Y + tok * DM + chb) = o;
            }
            asm volatile("s_waitcnt lgkmcnt(0)" ::: "memory");
        }
    }
}
namespace att {
constexpr int KROW = 272, VROW = 320, KBUF = 32 * KROW, VBUF = 32 * VROW, LDS_K = 0, LDS_V = 2 * KBUF, LDS_Q = 2 * KBUF + 2 * VBUF;
static_assert(LDS_Q + 256 * KROW + 16 <= LDS_BYTES, "attention LDS");
typedef short v4i16_t __attribute__((ext_vector_type(4)));
DEV s16x4 vtr(const LAS unsigned char* p) { return __builtin_bit_cast(s16x4, __builtin_amdgcn_ds_read_tr16_b64_v4i16((LAS v4i16_t*)p)); }


DEV void attn_unit(const bf16* PROJ, bf16* YMIX, int tok0, int S, int head, int qb, float lam, float oscale, const float* subg, float Bnd, LAS unsigned char* lds) {
    int tid_ = threadIdx.x; asm volatile("" : "+v"(tid_));
    const int tid = tid_, lane = tid & 63, r32 = lane & 31, hi = lane >> 5, wid = __builtin_amdgcn_readfirstlane(tid >> 6);
    const int qpos = qb * 256 + wid * 32 + r32;
    LAS unsigned char* qlds = lds + LDS_Q + wid * 32 * KROW;
    { const bf16* qg = PROJ + (size_t)(tok0 + qb * 256 + wid * 32) * PROJW + 512 + head * 128;
#pragma unroll
      for (int i = 0; i < 8; ++i) { const int ch = lane + 64 * i, row = ch >> 4, c16 = ch & 15; const u32x4 v = *(const u32x4*)(qg + (size_t)row * PROJW + c16 * 8); *(LAS u32x4*)(qlds + row * KROW + c16 * 16) = v; } }
    const LAS unsigned char* qfb = qlds + r32 * KROW + hi * 16;
    const float sl2 = __builtin_amdgcn_exp2f(-2.f * (float)(head + 1)) * LOG2E;
    const int srow = tid >> 4, sc16 = tid & 15;
    const bf16* kg = PROJ + (size_t)(tok0 + srow) * PROJW + 1024 + head * 128 + sc16 * 8;
    const bf16* vg = kg + 512;
    LAS unsigned char* kst = lds + LDS_K + srow * KROW + sc16 * 16;
    LAS unsigned char* vst = lds + LDS_V + srow * VROW + sc16 * 16;
    const LAS unsigned char* kfb = lds + LDS_K + r32 * KROW + hi * 16;
    const int i16 = lane & 15, gq = i16 >> 2, gp = i16 & 3, g1 = (lane >> 4) & 1;
    const LAS unsigned char* vfb = lds + LDS_V + (4 * hi + gq) * VROW + (16 * g1 + 4 * gp) * 2;
    u32x4 kr0, vr0;
    { const size_t go0 = (size_t)(qb * 8) * 32 * PROJW; kr0 = *(const u32x4*)(kg + go0); vr0 = *(const u32x4*)(vg + go0); }
    *(LAS u32x4*)kst = kr0; *(LAS u32x4*)vst = vr0;
    __syncthreads();
    f32x16 O[2][4];
#pragma unroll
    for (int c = 0; c < 2; ++c)
#pragma unroll
        for (int d = 0; d < 4; ++d)
#pragma unroll
            for (int r = 0; r < 16; ++r) O[c][d][r] = 0.f;
    float mrun[2] = {-1e30f, -1e30f}, lrun[2] = {0.f, 0.f};
    const int ts = qb * 8, qw0 = qb * 256 + wid * 32;
    int t_lo = 0, t_hi = (S >> 5) - 1;
    { const float Df = (2.f * Bnd + 160.f) / sl2; if (Df < (float)S) { const int D = (int)Df + 1; const int a_ = (qb * 256 - D) >> 5, b_ = (qb * 256 + 255 + D) >> 5; t_lo = a_ > 0 ? a_ : 0; t_hi = b_ < t_hi ? b_ : t_hi; } }
    const int NT = t_hi - t_lo + 1;
    f32x16 bcv; float csign = 1.f;
#pragma unroll
    for (int r = 0; r < 16; ++r) { float cr_ = (float)((r & 3) + 8 * (r >> 2)); asm volatile("" : "+v"(cr_)); bcv[r] = sl2 * cr_; }
    for (int i = 0; i < NT; ++i) {
        int t = ts + i; if (t > t_hi) t -= NT;
        int tn = t + 1; if (tn > t_hi) tn -= NT;
        const int cur = i & 1, k0 = t * 32;
        const LAS unsigned char* kb = kfb + cur * KBUF; const LAS unsigned char* vb = vfb + cur * VBUF;
        const float dqf = (float)(qpos - k0 - 4 * hi);
        const bool diag = (k0 == qw0);
        if (!diag) { const float want = (k0 < qw0) ? 1.f : -1.f;
            if (want != csign) { csign = want;
#pragma unroll
                for (int r = 0; r < 16; ++r) bcv[r] = -bcv[r]; } }
        const float lt = diag ? 0.f : -csign * sl2 * dqf;
        if (i + 1 < NT) { const size_t go = (size_t)tn * 32 * PROJW; kr0 = *(const u32x4*)(kg + go); vr0 = *(const u32x4*)(vg + go); }
        bf16x8 pf[2][2];
        f32x16 pp[2]; pp[0] = bcv; pp[1] = bcv;
#pragma unroll
        for (int c = 0; c < 2; ++c) {
            bf16x8 kf[4], qf[4];
#pragma unroll
            for (int ds = 0; ds < 4; ++ds) { kf[ds] = *(const LAS bf16x8*)(kb + (c * 64 + ds * 16) * 2); qf[ds] = *(const LAS bf16x8*)(qfb + (c * 64 + ds * 16) * 2); }
            __builtin_amdgcn_sched_barrier(0);
#pragma unroll
            for (int ds = 0; ds < 4; ++ds) pp[c] = __builtin_amdgcn_mfma_f32_32x32x16_bf16(kf[ds], qf[ds], pp[c], 0, 0, 0);
        }
        if (diag) {
#pragma unroll
            for (int r = 0; r < 16; ++r) { float cr = (float)((r & 3) + 8 * (r >> 2)); asm volatile("" : "+v"(cr)); const float fx = bcv[r] + sl2 * __builtin_fabsf(dqf - cr); pp[0][r] -= fx; pp[1][r] -= fx; }
        }
        float rm[2];
#pragma unroll
        for (int c = 0; c < 2; ++c) {
            float m_ = pp[c][0];
#pragma unroll
            for (int r = 1; r < 16; ++r) m_ = __builtin_fmaxf(m_, pp[c][r]);
            m_ += lt;
            auto rr = __builtin_amdgcn_permlane32_swap(__float_as_uint(m_), __float_as_uint(m_), false, false); rm[c] = __builtin_fmaxf(__uint_as_float(rr[0]), __uint_as_float(rr[1]));
        }
        if (__any(rm[0] > mrun[0] + 8.f || rm[1] > mrun[1] + 8.f)) {
#pragma unroll
            for (int c = 0; c < 2; ++c) {
                const float mnew = rm[c] > mrun[c] + 8.f ? rm[c] : mrun[c], alpha = __builtin_amdgcn_exp2f(mrun[c] - mnew);
                mrun[c] = mnew; lrun[c] *= alpha;
#pragma unroll
                for (int d = 0; d < 4; ++d)
#pragma unroll
                    for (int r = 0; r < 16; ++r) O[c][d][r] *= alpha;
            }
        }
#pragma unroll
        for (int c = 0; c < 2; ++c) {
            const float mm = mrun[c] - lt;
            float rs = 0.f;
#pragma unroll
            for (int r = 0; r < 16; ++r) { pp[c][r] = __builtin_amdgcn_exp2f(pp[c][r] - mm); rs += pp[c][r]; }
            lrun[c] += rs;
#pragma unroll
            for (int s = 0; s < 2; ++s) {
                u32x4 a;
                a.x = pk2(pp[c][8 * s + 0], pp[c][8 * s + 1]); a.y = pk2(pp[c][8 * s + 2], pp[c][8 * s + 3]); a.z = pk2(pp[c][8 * s + 4], pp[c][8 * s + 5]); a.w = pk2(pp[c][8 * s + 6], pp[c][8 * s + 7]);
                pf[c][s] = __builtin_bit_cast(bf16x8, a);
            }
        }
#pragma unroll
        for (int xs = 0; xs < 2; ++xs) { __builtin_amdgcn_sched_barrier(0);
            s16x4 vlo[4], vhi[4];
#pragma unroll
            for (int d = 0; d < 4; ++d) { vlo[d] = vtr(vb + (16 * xs) * VROW + d * 64); vhi[d] = vtr(vb + (16 * xs + 8) * VROW + d * 64); }
            __builtin_amdgcn_sched_barrier(0);
#pragma unroll
            for (int d = 0; d < 4; ++d) {
                const bf16x8 vf = {vlo[d][0], vlo[d][1], vlo[d][2], vlo[d][3], vhi[d][0], vhi[d][1], vhi[d][2], vhi[d][3]};
                O[0][d] = __builtin_amdgcn_mfma_f32_32x32x16_bf16(vf, pf[0][xs], O[0][d], 0, 0, 0);
                O[1][d] = __builtin_amdgcn_mfma_f32_32x32x16_bf16(vf, pf[1][xs], O[1][d], 0, 0, 0);
            }
        }
        if (i + 1 < NT) { const int nb = cur ^ 1; *(LAS u32x4*)(kst + nb * KBUF) = kr0; *(LAS u32x4*)(vst + nb * VBUF) = vr0; }
        __syncthreads();
    }
    const float l0 = lrun[0] + lane_xor(lrun[0], lane, 32), l1 = lrun[1] + lane_xor(lrun[1], lane, 32);
    const float i0 = 1.f / l0, i1 = lam / l1;
    float ss = 0.f;
#pragma unroll
    for (int d = 0; d < 4; ++d)
#pragma unroll
        for (int r = 0; r < 16; ++r) { const float o = O[0][d][r] * i0 - O[1][d][r] * i1; O[0][d][r] = o; ss += o * o; }
    ss += lane_xor(ss, lane, 32);
    const float rn = oscale / sqrtf(ss * (1.f / 128.f) + 1e-5f);
    bf16* yrow = YMIX + (size_t)(tok0 + qpos) * DM + 256 + head * 128;
#pragma unroll
    for (int d = 0; d < 4; ++d)
#pragma unroll
        for (int rg = 0; rg < 4; ++rg) { const int d0 = 32 * d + 8 * rg + 4 * hi; const f32x4 g4 = *(const f32x4*)(subg + d0);
            u32x2 w; w.x = pk2(O[0][d][4 * rg + 0] * rn * g4[0], O[0][d][4 * rg + 1] * rn * g4[1]); w.y = pk2(O[0][d][4 * rg + 2] * rn * g4[2], O[0][d][4 * rg + 3] * rn * g4[3]);
            *(u32x2*)(yrow + d0) = w; }
}
DEV void attn_phase(const Ctx& C, int l, LAS unsigned char* lds, int rep = 0) {
    const bf16* P = (const bf16*)(C.ws + WS_PROJ); bf16* Y = (bf16*)(C.ws + WS_YMIX);
    const float lam = ((const float*)(C.ws + WS_PAR))[1024 + l], li = ((const float*)(C.ws + WS_PAR))[1026 + l];
    const float* subg = C.in[19] + l * 128;
    const float* QN = (const float*)(C.ws + WS_NRM) + l * 320 * 8; const float* KN = (const float*)(C.ws + WS_NRM) + NRM_KN + l * 18 * 8;
    unsigned* qcnt = (unsigned*)(C.ws + WS_BAR) + 16 + 16 * l + 4 * rep;
    volatile LAS int* ubox = (volatile LAS int*)(lds + LDS_Q + 256 * KROW);
    for (;;) {
        if (C.tid == 0) ubox[0] = (int)__hip_atomic_fetch_add(qcnt, 1u, __ATOMIC_RELAXED, __HIP_MEMORY_SCOPE_AGENT);
        __syncthreads();
        const int u = ubox[0];
        if (u >= 1280) break;
        const int head = 3 - u / 320, r = u % 320;
        int tok0, S, qb, seq;
        if (r < 64) { seq = 16 + (r >> 5); qb = r & 31; tok0 = MP + (r >> 5) * SS; S = SS; }
        else { const int v = r - 64; seq = v >> 4; qb = v & 15; tok0 = seq * SP; S = SP; }
        const int blk = (tok0 >> 8) + qb;
        const float b0 = sqrtf(QN[blk * 8 + head * 2] * KN[seq * 8 + head * 2]), b1 = sqrtf(QN[blk * 8 + head * 2 + 1] * KN[seq * 8 + head * 2 + 1]);
        const float Bnd = 1.02f * fmaxf(b0, b1) + 0.5f;
        attn_unit(P, Y, tok0, S, head, qb, lam, 1.f - li, subg, Bnd, lds);
    }
}
}
DEV void grid_barrier(unsigned* bar, unsigned epoch, unsigned G) {
    asm volatile("s_waitcnt vmcnt(0)" ::: "memory");
    __syncthreads();
    if (threadIdx.x == 0) {
        __builtin_amdgcn_fence(__ATOMIC_RELEASE, "agent");
        asm volatile("s_waitcnt vmcnt(0)" ::: "memory");
        __hip_atomic_fetch_add(bar, 1u, __ATOMIC_RELAXED, __HIP_MEMORY_SCOPE_AGENT);
        const unsigned target = epoch * G;
        while (__hip_atomic_load(bar, __ATOMIC_RELAXED, __HIP_MEMORY_SCOPE_AGENT) < target) __builtin_amdgcn_s_sleep(2);
        __builtin_amdgcn_fence(__ATOMIC_ACQUIRE, "agent");
        asm volatile("s_waitcnt vmcnt(0)" ::: "memory");
    }
    __syncthreads();
}
#ifndef REP_ATT
#define REP_ATT 1
#endif
#ifndef REP_FFNUP
#define REP_FFNUP 1
#endif
#ifndef REP_DFT
#define REP_DFT 1
#endif
#ifndef REP_BAR
#define REP_BAR 1
#endif
#ifndef REP_FFNDN
#define REP_FFNDN 1
#endif
#ifndef REP_GATE
#define REP_GATE 1
#endif
#ifndef REP_OUT
#define REP_OUT 1
#endif
#ifndef REP_LN
#define REP_LN 1
#endif
#ifndef REP_PROJ
#define REP_PROJ 1
#endif
#ifndef REP_SCANA
#define REP_SCANA 1
#endif
#ifndef REP_SCANC
#define REP_SCANC 1
#endif
#ifndef REP_CONV
#define REP_CONV 1
#endif
#ifndef REP_BAR
#define REP_BAR 1
#endif
#ifndef REP_FFNDN
#define REP_FFNDN 1
#endif
#ifndef REP_GATE
#define REP_GATE 1
#endif
#ifndef REP_OUT
#define REP_OUT 1
#endif
#ifndef REP_LN
#define REP_LN 1
#endif
#ifndef REP_PRO
#define REP_PRO 1
#endif
struct Args { const float* in[21]; float* out; unsigned char* ws; int ph_lo, ph_hi; };
constexpr int NPHASES = 27;
__global__ void __launch_bounds__(512, 2) mk_fwd(Args a) {
    extern __shared__ __attribute__((aligned(16))) unsigned char lds_raw[];
    LAS unsigned char* lds = (LAS unsigned char*)lds_raw;
    cg::grid_group grid = cg::this_grid();
    Ctx C;
C.in = a.in; C.out = a.out; C.ws = a.ws; C.tid = threadIdx.x; C.lane = C.tid & 63; C.wave = __builtin_amdgcn_readfirstlane(C.tid >> 6); C.G = gridDim.x; C.bid = blockIdx.x;
    unsigned char* ws = a.ws;
    const int lo = a.ph_lo, hi = a.ph_hi;
    int ph = 0; unsigned epoch = 0;
#define PH_BEGIN if (ph >= lo && ph < hi) { { int t_ = threadIdx.x; asm volatile("" : "+v"(t_)); C.tid = t_; C.lane = t_ & 63; C.wave = __builtin_amdgcn_readfirstlane(t_ >> 6); size_t z_ = 0; asm volatile("" : "+s"(z_)); ws = a.ws + z_; C.ws = ws; C.out = a.out + z_;     int g_ = gridDim.x, b_ = blockIdx.x; asm volatile("" : "+s"(g_), "+s"(b_)); C.G = g_; C.bid = b_; }
#define PH_END   if (ph + 1 < hi) { for (int rb_ = 0; rb_ < REP_BAR; ++rb_) grid_barrier((unsigned*)(a.ws + WS_BAR), ++epoch, gridDim.x); } } ++ph;
#define XB ((bf16*)(ws + WS_XB))
#define H ((bf16*)(ws + WS_H))
#define PROJ ((bf16*)(ws + WS_PROJ))
#define YMIX ((bf16*)(ws + WS_YMIX))
    if (ph >= lo && ph < hi) { { int t_ = threadIdx.x; asm volatile("" : "+v"(t_)); C.tid = t_; C.lane = t_ & 63; C.wave = __builtin_amdgcn_readfirstlane(t_ >> 6); }
#ifndef NO_PRO
 for (int rep_ = 0; rep_ < REP_PRO; ++rep_) { phase_prologue(C, lds); __syncthreads(); }
#endif
 __syncthreads(); if (ph + 1 < hi) grid.sync(); } ++ph;
    for (int l = 0; l < 2; ++l) {
        for (int f = 0; f < 2; ++f) {
            if (f == 1) {
                PH_BEGIN
                { pg8::Gemm g{XB, (const bf16*)(ws + WS_WIN) + (size_t)l * 2048 * 1024, 1024, 1024, 1024, 0, 0}; pg8::StaticOrder S; S.init(MTOK, 2048, C.G, C.bid);
                  epi::Proj E{PROJ};
#ifndef NO_PROJ
 for (int rep_ = 0; rep_ < REP_PROJ; ++rep_) pg8::gemm_phase<epi::Proj, pg8::StaticOrder, true, true, 1024, 1024, 1024>(lds, g, S, E);
#endif
 }
                { pg8::Gemm g{(const bf16*)(ws + WS_WF) + (size_t)l * 512 * 1024, XB, 1024, 1024, 1024, 0, 0}; pg8::StaticOrder S; S.init(512, MTOK, C.G, C.bid);
                  epi::FT E{(bf16*)(ws + WS_BTF)};
#ifndef NO_FT
 for (int rep_ = 0; rep_ < REP_PROJ; ++rep_) pg8::gemm_phase<epi::FT, pg8::StaticOrder, true, true, 1024, 1024, 1024>(lds, g, S, E);
#endif
 }
                PH_END
                PH_BEGIN for (int rep_ = 0; rep_ < REP_CONV; ++rep_) phase_conv(C, l); PH_END
                PH_BEGIN
                { pg8::Gemm g{(const bf16*)(ws + WS_XC), (const bf16*)(ws + WS_WG) + (size_t)l * 1024 * 256, 256, 256, 256, 0, 0}; pg8::StaticOrder S; S.init(MTOK, 1024, C.G, C.bid);
                  epi::Raw E{(bf16*)(ws + WS_AU)};
#ifndef NO_GATE
 for (int rep_ = 0; rep_ < REP_GATE; ++rep_) pg8::gemm_phase<epi::Raw, pg8::StaticOrder, true, true, 256, 256, 256>(lds, g, S, E);
#endif
 }
                PH_END
                PH_BEGIN
#ifndef NO_SCANA
 for (int rep_ = 0; rep_ < REP_SCANA; ++rep_) phase_scan<false>(C, l, lds);
 __syncthreads();
#endif
                { pg8::Gemm g{(const bf16*)(ws + WS_DFT), (const bf16*)(ws + WS_BTF), 8192, 8192, 8192, 0, (size_t)256 * 8192}; epi::DftOrder S{C.G, C.bid};
                  epi::DFT E{YMIX, (float*)(ws + WS_PART), 0.001953125f  };
#ifndef NO_DFT
 for (int rep_ = 0; rep_ < REP_DFT; ++rep_) pg8::gemm_phase<epi::DFT, epi::DftOrder, true, true, 8192, 8192, 8192>(lds, g, S, E);
#endif
 }
#ifndef NO_ATT
 for (int rep_ = 0; rep_ < REP_ATT; ++rep_) att::attn_phase(C, l, lds, rep_);
#endif
 PH_END
                PH_BEGIN
phase_dft_combine(C);
#ifndef NO_SCANC
 for (int rep_ = 0; rep_ < REP_SCANC; ++rep_) phase_scan<true>(C, l, lds);
#endif
 PH_END
                PH_BEGIN
                { pg8::Gemm g{YMIX, (const bf16*)(ws + WS_WOUT) + (size_t)l * 1024 * 1024, 1024, 1024, 1024, 0, 0}; pg8::StaticOrder S; S.init(MTOK, 1024, C.G, C.bid); S.rev = 1;
                  epi::Resid E{C.out, 1.0f, (const float*)(ws + WS_STATS), C.in[2] + (l * 3 + 0) * 1024, C.in[3] + (l * 3 + 0) * 1024, C.out, C.out + (size_t)MP * DM};
#ifndef NO_OUT
 for (int rep_ = 1; rep_ < REP_OUT; ++rep_) { epi::Resid E0{C.out, 0.f, (const float*)(ws + WS_STATS), (const float*)(ws + WS_ONES), (const float*)(ws + WS_ONES) + 1024, C.out, C.out + (size_t)MP * DM, 1.f}; pg8::gemm_phase<epi::Resid, pg8::StaticOrder, true, true, 1024, 1024, 1024>(lds, g, S, E0); }
 pg8::gemm_phase<epi::Resid, pg8::StaticOrder, true, true, 1024, 1024, 1024>(lds, g, S, E);
#endif
 }
                PH_END
                PH_BEGIN for (int rep_ = 0; rep_ < REP_LN; ++rep_) phase_ln(C, C.in[2] + (l * 3 + 1) * 1024, C.in[3] + (l * 3 + 1) * 1024, false); PH_END
            }
            PH_BEGIN
            { pg8::Gemm g{XB, (const bf16*)(ws + WS_WGU) + (size_t)(l * 2 + f) * 5632 * 1024, 1024, 1024, 1024, 0, 0}; pg8::StaticOrder S; S.init(MTOK, 5632, C.G, C.bid);
              epi::SwiGLU E{H};
#ifndef NO_FFNUP
 for (int rep_ = 0; rep_ < REP_FFNUP; ++rep_) pg8::gemm_phase<epi::SwiGLU, pg8::StaticOrder, true, true, 1024, 1024, 1024>(lds, g, S, E);
#endif
 }
            PH_END
            PH_BEGIN
            { pg8::Gemm g{H, (const bf16*)(ws + WS_WD) + (size_t)(l * 2 + f) * 1024 * 2816, 2816, 2816, 2816, 0, 0}; pg8::StaticOrder S; S.init(MTOK, 1024, C.G, C.bid); S.rev = 1;
              const bool ident_ = (l == 0 && f == 0); const int pidx_ = f == 1 ? l * 3 + 1 : (l - 1) * 3 + 2;
              epi::Resid E{C.out, 0.5f, (const float*)(ws + WS_STATS), ident_ ? (const float*)(ws + WS_ONES) : C.in[2] + pidx_ * 1024, ident_ ? (const float*)(ws + WS_ONES) + 1024 : C.in[3] + pidx_ * 1024, ident_ ? C.in[0] : C.out, ident_ ? C.in[1] : C.out + (size_t)MP * DM};
#ifndef NO_FFNDN
 for (int rep_ = 1; rep_ < REP_FFNDN; ++rep_) { epi::Resid E0{C.out, 0.f, (const float*)(ws + WS_STATS), (const float*)(ws + WS_ONES), (const float*)(ws + WS_ONES) + 1024, C.out, C.out + (size_t)MP * DM, 1.f}; pg8::gemm_phase<epi::Resid, pg8::StaticOrder, true, true, 2816, 2816, 2816>(lds, g, S, E0); }
 pg8::gemm_phase<epi::Resid, pg8::StaticOrder, true, true, 2816, 2816, 2816>(lds, g, S, E);
#endif
 }
            PH_END
            PH_BEGIN for (int rep_ = 0; rep_ < ((l == 1 && f == 1) ? 1 : REP_LN); ++rep_) phase_ln(C, C.in[2] + (l * 3 + 2 * f) * 1024, C.in[3] + (l * 3 + 2 * f) * 1024, l == 1 && f == 1); PH_END
        }
    }
}

#ifndef MK_COOP
#define MK_COOP 1
#endif
extern "C" void kernel_launch(void* const* d_in, const int* in_sizes, int n_in, void* d_out, int out_size, void* d_ws, size_t ws_size, hipStream_t stream) {
    static int grid = 0;
    if (grid == 0) {
        if (n_in != 21 || out_size != MTOK * DM || ws_size < WS_END) { fprintf(stderr, "kernel_launch: unexpected shapes (n_in %d out %d ws %zu)\n", n_in, out_size, ws_size); grid = -1; return; }
        int dev = 0, cus = 0, per_cu = 0;
        hipGetDevice(&dev); hipDeviceGetAttribute(&cus, hipDeviceAttributeMultiprocessorCount, dev);
        hipFuncSetAttribute((const void*)mk_fwd, hipFuncAttributeMaxDynamicSharedMemorySize, LDS_BYTES);
        hipOccupancyMaxActiveBlocksPerMultiprocessor(&per_cu, (const void*)mk_fwd, 512, LDS_BYTES);
        (void)hipGetLastError();
        if (per_cu < 1) per_cu = 1;
        grid = cus;
    }
    if (grid < 0) return;
    if (MK_COOP) (void)hipMemsetAsync((char*)d_ws + WS_BAR, 0, 256, stream);
    Args a{};
    for (int i = 0; i < 21; ++i) a.in[i] = (const float*)d_in[i];
    a.out = (float*)d_out; a.ws = (unsigned char*)d_ws;
#if MK_COOP
    a.ph_lo = 0; a.ph_hi = NPHASES;
    void* args[] = {&a};
    hipError_t e = hipLaunchCooperativeKernel((const void*)mk_fwd, dim3(grid), dim3(512), args, LDS_BYTES, stream);
    if (e != hipSuccess) fprintf(stderr, "cooperative launch failed: %s (grid %d)\n", hipGetErrorString(e), grid);
#else
    for (int p = 0; p < NPHASES; ++p) { a.ph_lo = p; a.ph_hi = p + 1; hipLaunchKernelGGL(mk_fwd, dim3(grid), dim3(512), LDS_BYTES, stream, a); }
#endif
}
```

```cpp
#include <hip/hip_runtime.h>
#include <hip/hip_cooperative_groups.h>
#include <hip/hip_bf16.h>
#include <cstdio>
#include <cstdint>
#include <cmath>
namespace cg = cooperative_groups;
namespace pg8 {
#define PG8_LAS __attribute__((address_space(3)))
typedef unsigned short bf16_t;
typedef short bf16x8 __attribute__((ext_vector_type(8)));
typedef float f32x4 __attribute__((ext_vector_type(4)));
typedef unsigned u32x4 __attribute__((ext_vector_type(4)));
constexpr int BM = 256, BK = 64, HALF = 128, HTB = HALF * BK * 2  , STAGE_BYTES = 8 * HTB, NXCD = 8, WGM = 8;

__host__ __device__ __forceinline__ int lds_byte(int r, int c) { const int st = (r >> 4) * 2 + (c >> 5), rr = r & 15, cc = c & 31, ob = rr * 64 + cc * 2; return st * 1024 + (ob ^ (((ob >> 9) & 1) << 5)); }
__host__ __device__ __forceinline__ void stage_rc(int b, int& R, int& C) { const int st = b / 1024, sb = b % 1024, swz = sb ^ (((sb >> 9) & 1) << 5); R = (st >> 1) * 16 + swz / 64; C = (st & 1) * 32 + (swz % 64) / 2; }
__host__ __device__ __forceinline__ int perm32(int rho) { const int n = rho >> 4, i = rho & 15; return 8 * (i >> 2) + 4 * n + (i & 3); }

struct Unit { int pm, pn, z; };
struct Gemm { const bf16_t* A; const bf16_t* Bt; int K, lda, ldb; size_t zA, zB; };

struct StaticOrder {
    int nM, nN, nwg, G, c; int rev = 0;
    __host__ __device__ void init(int M, int N, int G_, int c_) { nM = M / BM; nN = N / BM; nwg = nM * nN; G = G_; c = c_; }
    __host__ __device__ bool next(int i, Unit& u) const {
        const long L = (long)i * G + c; if (L >= nwg) return false;
        int wgid = rev ? nwg - 1 - (int)L : (int)L; { const int q = nwg / NXCD, r = nwg % NXCD, xcd = wgid % NXCD, off = wgid / NXCD; wgid = (xcd < r ? xcd * (q + 1) : r * (q + 1) + (xcd - r) * q) + off; }
        const int nig = WGM * nN, gid = wgid / nig, fm = gid * WGM, gsz = (nM - fm) < WGM ? (nM - fm) : WGM;
        u.pm = fm + ((wgid % nig) % gsz); u.pn = (wgid % nig) / gsz; u.z = 0; return true;
    }
    __device__ __forceinline__ void a_ready(const Unit&) const {}
    __device__ __forceinline__ void done(const Unit&) const {}
};

__device__ __forceinline__ unsigned cvt_pk_bf16(float lo, float hi) { unsigned r; asm volatile("v_cvt_pk_bf16_f32 %0, %1, %2" : "=v"(r) : "v"(lo), "v"(hi)); return r; }
typedef float f32x2 __attribute__((ext_vector_type(2)));
__device__ __forceinline__ f32x2 gelu_pk(f32x2 v) {
    const f32x2 av = __builtin_elementwise_abs(v), d = av * 0.2316418882f + 1.0f;
    f32x2 t; t.x = __builtin_amdgcn_rcpf(d.x); t.y = __builtin_amdgcn_rcpf(d.y);
    f32x2 q = t * 0.5307027145f + (-0.7265760135f); q = q * t + 0.7107068705f; q = q * t + (-0.142248368f); q = q * t + 0.127414796f; q = q * t;
    const f32x2 s = (v * v) * (-0.72134752044f);
    f32x2 e; e.x = __builtin_amdgcn_exp2f(s.x); e.y = __builtin_amdgcn_exp2f(s.y);
    const f32x2 m = v * (q * e), r = v - m;
    f32x2 o; o.x = v.x < 0.f ? m.x : r.x; o.y = v.y < 0.f ? m.y : r.y; return o;
}

template <int ACT  > struct EpiBf16 {
    static constexpr bool PERM = true, AFTER_DRAIN = false; static_assert(ACT == 0 || ACT == 1, "EpiBf16: ACT is 0 (none) or 1 (gelu_pk)");
    bf16_t* O; int ldc; const float* bias; int split_cols; size_t split_stride; float scale0;
    __device__ __forceinline__ void operator()(const f32x4 (&acc)[2][2][4][2], const Unit& u, int wr, int wc, int fr, int fq) const {
        const int row0 = u.pm * BM + wr * 64 + fr; int colt = u.pn * BM; bf16_t* base = O;
        float sc = 1.f; if (split_cols) { const int t = colt / split_cols; base += (size_t)t * split_stride; colt -= t * split_cols; if (t == 0) sc = scale0; }
        const int col0 = colt + wc * 32 + 8 * fq, bcol0 = u.pn * BM + wc * 32 + 8 * fq;
        f32x4 bv[2][2];
#pragma unroll
        for (int bj = 0; bj < 2; ++bj)
#pragma unroll
            for (int n = 0; n < 2; ++n) bv[bj][n] = bias ? *(const f32x4*)(bias + bcol0 + bj * HALF + 4 * n) : (f32x4){0.f, 0.f, 0.f, 0.f};
#pragma unroll
        for (int ai = 0; ai < 2; ++ai)
#pragma unroll
            for (int m = 0; m < 4; ++m) { bf16_t* rowp = base + (size_t)(row0 + ai * HALF + m * 16) * ldc + col0;
#pragma unroll
                for (int bj = 0; bj < 2; ++bj) { f32x4 v0 = acc[ai][bj][m][0] + bv[bj][0], v1 = acc[ai][bj][m][1] + bv[bj][1];
                    if (ACT == 1) { f32x2 a = gelu_pk((f32x2){v0[0], v0[1]}), b = gelu_pk((f32x2){v0[2], v0[3]}), c = gelu_pk((f32x2){v1[0], v1[1]}), d = gelu_pk((f32x2){v1[2], v1[3]});
                        v0 = (f32x4){a.x, a.y, b.x, b.y}; v1 = (f32x4){c.x, c.y, d.x, d.y}; }
                    v0 = v0 * sc; v1 = v1 * sc; u32x4 w; w.x = cvt_pk_bf16(v0[0], v0[1]); w.y = cvt_pk_bf16(v0[2], v0[3]); w.z = cvt_pk_bf16(v1[0], v1[1]); w.w = cvt_pk_bf16(v1[2], v1[3]);
                    *(u32x4*)(rowp + bj * HALF) = w; } }
    }
};

template <class Epi, class Sched, bool ALIGN_EPI, bool SP2, int KK, int LDA, int LDB>
__device__ __forceinline__ void gemm_phase(PG8_LAS unsigned char* lds, const Gemm g, const Sched& S, const Epi& E) {
    int tid_ = threadIdx.x; asm volatile("" : "+v"(tid_));
    const int tid = tid_, wid = __builtin_amdgcn_readfirstlane(tid >> 6), lane = tid & 63, wr = wid >> 2, wc = wid & 3, fr = lane & 15, fq = lane >> 4;
    constexpr int K = KK, nt = K / BK;
    unsigned voffA[2], voffB[2];
#pragma unroll
    for (int i = 0; i < 2; ++i) { int R, C; stage_rc(tid * 16 + i * 8192, R, C); const int Rb = Epi::PERM ? ((R & ~31) + perm32(R & 31)) : R;
        voffA[i] = (unsigned)(R * LDA + C) * 2u; voffB[i] = (unsigned)(Rb * LDB + C) * 2u; }
    constexpr size_t kstep = (size_t)(BK * 2);
    constexpr size_t hstepA = (size_t)HALF * LDA * 2, hstepB = (size_t)HALF * LDB * 2;
    constexpr size_t tstepA = 2 * hstepA, tstepB = 2 * hstepB;
    const unsigned ldsw = (unsigned)wid * 1024u;
    const int aoff = lds_byte(wr * 64 + fr, fq * 8), boff = lds_byte(wc * 32 + fr, fq * 8);
#define PG8_SA(b, h) (((b) * 2 + (h)) * HTB)
#define PG8_SB(b, h) ((4 + (b) * 2 + (h)) * HTB)
#define PG8_STAGE(bufoff, gbase, voff) do { _Pragma("unroll") for (int _i = 0; _i < 2; ++_i) \
        __builtin_amdgcn_global_load_lds((const unsigned*)((const char*)(gbase) + (voff)[_i]), (PG8_LAS unsigned*)(lds + (bufoff) + ldsw + _i * 8192), 16, 0, 0); } while (0)
#define PG8_LDA(dst, b, h) do { _Pragma("unroll") for (int m = 0; m < 4; ++m) _Pragma("unroll") for (int k = 0; k < 2; ++k) dst[m][k] = *(const PG8_LAS bf16x8*)(lds + PG8_SA(b, h) + aoff + m * 2048 + k * 1024); } while (0)
#define PG8_LDB(dst, b, h) do { _Pragma("unroll") for (int n = 0; n < 2; ++n) _Pragma("unroll") for (int k = 0; k < 2; ++k) dst[n][k] = *(const PG8_LAS bf16x8*)(lds + PG8_SB(b, h) + boff + n * 2048 + k * 1024); } while (0)
#define PG8_MMA(ai, bj, At, Bt) do { __builtin_amdgcn_s_setprio(1); _Pragma("unroll") for (int m = 0; m < 4; ++m) _Pragma("unroll") for (int n = 0; n < 2; ++n) _Pragma("unroll") for (int k = 0; k < 2; ++k) \
        acc[ai][bj][m][n] = __builtin_amdgcn_mfma_f32_16x16x32_bf16(Bt[n][k], At[m][k], acc[ai][bj][m][n], 0, 0, 0); __builtin_amdgcn_s_setprio(0); } while (0)
#define PG8_WAIT_V(n) asm volatile("s_waitcnt vmcnt(" #n ")" ::: "memory")
#define PG8_WAIT_L(n) asm volatile("s_waitcnt lgkmcnt(" #n ")" ::: "memory")
#define PG8_BAR __builtin_amdgcn_s_barrier()
#define PG8_SCHED __builtin_amdgcn_sched_barrier(0)
    Unit cur, nxt; int ui = 0;
    if (!S.next(0, cur)) return;
    f32x4 acc[2][2][4][2];
#pragma unroll
    for (int a = 0; a < 2; ++a)
#pragma unroll
        for (int b = 0; b < 2; ++b)
#pragma unroll
            for (int m = 0; m < 4; ++m)
#pragma unroll
                for (int n = 0; n < 2; ++n) acc[a][b][m][n] = (f32x4){0.f, 0.f, 0.f, 0.f};
    bf16x8 At[4][2], B0[2][2], B1[2][2];
    const char* cA = (const char*)g.A + (size_t)cur.z * g.zA * 2 + (size_t)cur.pm * tstepA; const char* cB = (const char*)g.Bt + (size_t)cur.z * g.zB * 2 + (size_t)cur.pn * tstepB;
    S.a_ready(cur);
    if constexpr (SP2) {
        PG8_STAGE(PG8_SB(0, 0), cB, voffB); PG8_STAGE(PG8_SB(0, 1), cB + hstepB, voffB); PG8_STAGE(PG8_SA(0, 0), cA, voffA); PG8_STAGE(PG8_SA(0, 1), cA + hstepA, voffA);
        if (wr == 1) PG8_BAR;
        PG8_WAIT_V(2); PG8_BAR;
        PG8_STAGE(PG8_SB(1, 0), cB + kstep, voffB); PG8_STAGE(PG8_SA(1, 0), cA + kstep, voffA); PG8_STAGE(PG8_SB(1, 1), cB + hstepB + kstep, voffB);
        PG8_WAIT_V(6); PG8_BAR;
    } else {
        PG8_STAGE(PG8_SB(0, 0), cB, voffB); PG8_STAGE(PG8_SA(0, 0), cA, voffA); PG8_STAGE(PG8_SB(0, 1), cB + hstepB, voffB); PG8_STAGE(PG8_SA(0, 1), cA + hstepA, voffA);
        if (wr == 1) PG8_BAR;
        PG8_WAIT_V(4); PG8_BAR;
        PG8_STAGE(PG8_SB(1, 0), cB + kstep, voffB); PG8_STAGE(PG8_SA(1, 0), cA + kstep, voffA); PG8_STAGE(PG8_SB(1, 1), cB + hstepB + kstep, voffB);
        PG8_WAIT_V(6); PG8_BAR;
    }
    for (;;) {
        const bool has_next = S.next(ui + 1, nxt);
        const char* nA = has_next ? (const char*)g.A + (size_t)nxt.z * g.zA * 2 + (size_t)nxt.pm * tstepA : cA; const char* nB = has_next ? (const char*)g.Bt + (size_t)nxt.z * g.zB * 2 + (size_t)nxt.pn * tstepB : cB;
        for (int t = 0; t < nt; t += 2) {
            const bool last = (t == nt - 2);
            const char* a1 = cA + (size_t)(t + 1) * kstep;
            const char* a2 = last ? nA : cA + (size_t)(t + 2) * kstep; const char* b2 = last ? nB : cB + (size_t)(t + 2) * kstep;
            const char* a3 = a2 + kstep; const char* b3 = b2 + kstep;
            if (last && has_next) S.a_ready(nxt);
            if constexpr (SP2) {
            PG8_LDB(B0, 0, 0); PG8_LDB(B1, 0, 1); PG8_SCHED; PG8_LDA(At, 0, 0); PG8_STAGE(PG8_SA(1, 1), a1 + hstepA, voffA);
            PG8_WAIT_V(8); PG8_WAIT_L(0); PG8_BAR; PG8_MMA(0, 0, At, B0); PG8_MMA(0, 1, At, B1); PG8_BAR; PG8_SCHED;
            PG8_LDA(At, 0, 1); PG8_STAGE(PG8_SB(0, 0), b2, voffB); PG8_STAGE(PG8_SB(0, 1), b2 + hstepB, voffB); PG8_STAGE(PG8_SA(0, 0), a2, voffA);
            PG8_WAIT_V(8); PG8_WAIT_L(0); PG8_BAR; PG8_MMA(1, 0, At, B0); PG8_MMA(1, 1, At, B1); PG8_BAR; PG8_SCHED;
            PG8_LDB(B0, 1, 0); PG8_LDB(B1, 1, 1); PG8_SCHED; PG8_LDA(At, 1, 0); PG8_STAGE(PG8_SA(0, 1), a2 + hstepA, voffA);
            PG8_WAIT_V(8); PG8_WAIT_L(0); PG8_BAR; PG8_MMA(0, 0, At, B0); PG8_MMA(0, 1, At, B1); PG8_BAR; PG8_SCHED;
            PG8_LDA(At, 1, 1); PG8_STAGE(PG8_SB(1, 0), b3, voffB); PG8_STAGE(PG8_SB(1, 1), b3 + hstepB, voffB); PG8_STAGE(PG8_SA(1, 0), a3, voffA);
            PG8_WAIT_V(8); PG8_WAIT_L(0); PG8_BAR; PG8_MMA(1, 0, At, B0); PG8_MMA(1, 1, At, B1); PG8_BAR; PG8_SCHED;
            } else {
            PG8_LDB(B0, 0, 0); PG8_SCHED; PG8_LDA(At, 0, 0); PG8_STAGE(PG8_SA(1, 1), a1 + hstepA, voffA);
            PG8_WAIT_L(8); PG8_BAR; PG8_WAIT_L(0); PG8_MMA(0, 0, At, B0); PG8_BAR; PG8_SCHED;
            PG8_LDB(B1, 0, 1); PG8_STAGE(PG8_SB(0, 0), b2, voffB);
            PG8_BAR; PG8_WAIT_L(0); PG8_MMA(0, 1, At, B1); PG8_BAR;
            PG8_LDA(At, 0, 1); PG8_STAGE(PG8_SA(0, 0), a2, voffA);
            PG8_BAR; PG8_WAIT_L(0); PG8_MMA(1, 0, At, B0); PG8_BAR; PG8_SCHED;
            PG8_STAGE(PG8_SB(0, 1), b2 + hstepB, voffB);
            PG8_WAIT_V(6); PG8_BAR; PG8_MMA(1, 1, At, B1); PG8_BAR;
            PG8_LDB(B0, 1, 0); PG8_SCHED; PG8_LDA(At, 1, 0); PG8_STAGE(PG8_SA(0, 1), a2 + hstepA, voffA);
            PG8_WAIT_L(8); PG8_BAR; PG8_WAIT_L(0); PG8_MMA(0, 0, At, B0); PG8_BAR; PG8_SCHED;
            PG8_LDB(B1, 1, 1); PG8_STAGE(PG8_SB(1, 0), b3, voffB);
            PG8_BAR; PG8_WAIT_L(0); PG8_MMA(0, 1, At, B1); PG8_BAR;
            PG8_LDA(At, 1, 1); PG8_STAGE(PG8_SA(1, 0), a3, voffA);
            PG8_BAR; PG8_WAIT_L(0); PG8_MMA(1, 0, At, B0); PG8_BAR; PG8_SCHED;
            PG8_STAGE(PG8_SB(1, 1), b3 + hstepB, voffB);
            PG8_WAIT_V(6); PG8_BAR; PG8_MMA(1, 1, At, B1); PG8_BAR;
            }
        }
        if constexpr (ALIGN_EPI) { if (wr == 0) PG8_BAR; }
        if constexpr (!Epi::AFTER_DRAIN) { E(acc, cur, wr, wc, fr, fq); S.done(cur); }
        if (!has_next) break;
#pragma unroll
        for (int a = 0; a < 2; ++a)
#pragma unroll
            for (int b = 0; b < 2; ++b)
#pragma unroll
                for (int m = 0; m < 4; ++m)
#pragma unroll
                    for (int n = 0; n < 2; ++n) acc[a][b][m][n] = (f32x4){0.f, 0.f, 0.f, 0.f};
        cur = nxt; cA = nA; cB = nB; ++ui;
        if constexpr (ALIGN_EPI) { if (wr == 1) PG8_BAR; }
    }
    PG8_WAIT_V(0);
    if constexpr (!ALIGN_EPI) { if (wr == 0) PG8_BAR; }
    PG8_BAR;
    if constexpr (Epi::AFTER_DRAIN) { E.fused(acc, cur, wr, wc, fr, fq, lds, wid, lane); S.done(cur); }
#undef PG8_SA
#undef PG8_SB
#undef PG8_STAGE
#undef PG8_LDA
#undef PG8_LDB
#undef PG8_MMA
#undef PG8_WAIT_V
#undef PG8_WAIT_L
#undef PG8_BAR
#undef PG8_SCHED
}
}
#define DEV __device__ __forceinline__
#define LAS __attribute__((address_space(3)))
typedef unsigned short bf16;
typedef float f32x4 __attribute__((ext_vector_type(4)));
typedef float f32x2 __attribute__((ext_vector_type(2)));
typedef float f32x16 __attribute__((ext_vector_type(16)));
typedef unsigned u32x4 __attribute__((ext_vector_type(4)));
typedef unsigned u32x2 __attribute__((ext_vector_type(2)));
typedef short bf16x8 __attribute__((ext_vector_type(8)));
typedef short s16x4 __attribute__((ext_vector_type(4)));
typedef __bf16 bf16x2_t __attribute__((ext_vector_type(2)));

constexpr int DM = 1024, DFF = 2816, MTOK = 81920, MP = 65536, SP = 4096, SS = 8192;
constexpr int PROJW = 2048;
constexpr float LOG2E = 1.4426950408889634f;
constexpr float QSCALE = 0.125f * LOG2E;
constexpr float ALPHA = 1.4142135623730951f;
constexpr size_t MiB = 1u << 20;
constexpr size_t WS_PAR = 0;
constexpr size_t WS_NRM = 256 * 1024;
constexpr int NRM_KN = 2 * 320 * 8;
constexpr size_t WS_BAR = 512 * 1024;
constexpr size_t WS_WGU = 1 * MiB;
constexpr size_t WS_WD = 45 * MiB;
constexpr size_t WS_WIN = 67 * MiB;
constexpr size_t WS_WF = 75 * MiB;
constexpr size_t WS_WOUT = 77 * MiB;
constexpr size_t WS_WG = 81 * MiB;
constexpr size_t WS_DFT = 82 * MiB;
constexpr size_t WS_AGG = 210 * MiB;
constexpr size_t WS_STATS = 215 * MiB;
constexpr size_t WS_ONES = WS_STATS + 768 * 1024;
constexpr size_t WS_PROJ = 216 * MiB;
constexpr size_t WS_BTF = 536 * MiB;
constexpr size_t WS_XC = 632 * MiB;
constexpr size_t WS_YMIX = 672 * MiB;
constexpr size_t WS_AU = 832 * MiB;
constexpr size_t WS_XB = WS_AU;
constexpr size_t WS_H = WS_PROJ;
constexpr size_t WS_PART = 992 * MiB;
constexpr size_t WS_END = 1008 * MiB;
static_assert(WS_H + (size_t)MTOK * DFF * 2 <= WS_YMIX, "H overlay");
constexpr int LDS_BYTES = 147456;

DEV unsigned pk2(float lo, float hi) { f32x2 v = {lo, hi}; bf16x2_t b = __builtin_convertvector(v, bf16x2_t); return __builtin_bit_cast(unsigned, b); }
DEV float bf2f(unsigned short b) { return __uint_as_float((unsigned)b << 16); }
DEV float bflo(unsigned w) { return __uint_as_float(w << 16); }
DEV float bfhi(unsigned w) { return __uint_as_float(w & 0xffff0000u); }
DEV float lane_xor(float v, int lane, int o) { return __int_as_float(__builtin_amdgcn_ds_bpermute((lane ^ o) << 2, __float_as_int(v))); }
DEV float wave_sum(float v, int lane) {
#pragma unroll
    for (int o = 1; o < 64; o <<= 1) v += lane_xor(v, lane, o);
    return v;
}
DEV float sigmoidf_(float x) { return __builtin_amdgcn_rcpf(1.f + __builtin_amdgcn_exp2f(-LOG2E * x)); }

namespace epi {
using pg8::Unit; using pg8::HALF; using pg8::BM;
struct SwiGLU {
    static constexpr bool PERM = true, AFTER_DRAIN = false;
    bf16* H;
    DEV void operator()(const f32x4 (&acc)[2][2][4][2], const Unit& u, int wr, int wc, int fr_, int fq_) const {
        int t__ = threadIdx.x; asm volatile("" : "+v"(t__)); const int fr = t__ & 15, fq = (t__ >> 4) & 3; (void)fr_; (void)fq_;
        const int col0 = u.pn * 128 + wc * 32 + 8 * fq;
#pragma unroll
        for (int ai = 0; ai < 2; ++ai)
#pragma unroll
            for (int m = 0; m < 4; ++m) {
                const int row = u.pm * BM + ai * HALF + wr * 64 + m * 16 + fr;
                float o[8];
#pragma unroll
                for (int n = 0; n < 2; ++n)
#pragma unroll
                    for (int e = 0; e < 4; ++e) { const float g = acc[ai][0][m][n][e], up = acc[ai][1][m][n][e]; o[4 * n + e] = g * sigmoidf_(g) * up; }
                u32x4 w; w.x = pk2(o[0], o[1]); w.y = pk2(o[2], o[3]); w.z = pk2(o[4], o[5]); w.w = pk2(o[6], o[7]);
                *(u32x4*)(H + (size_t)row * DFF + col0) = w; asm volatile("" ::: "memory");
            }
    }
};
struct Resid {
    static constexpr bool PERM = true, AFTER_DRAIN = false;
    float* X; float s; const float* stats; const float* g; const float* b; const float* r0; const float* r1; float al = ALPHA;
    DEV void operator()(const f32x4 (&acc)[2][2][4][2], const Unit& u, int wr, int wc, int fr_, int fq_) const {
        int t__ = threadIdx.x; asm volatile("" : "+v"(t__)); const int fr = t__ & 15, fq = (t__ >> 4) & 3; (void)fr_; (void)fq_;
        const int colb = u.pn * BM + wc * 32 + 8 * fq;
        const float* rsrc = (u.pm * BM < MP) ? r0 : r1 - (size_t)MP * DM;
        f32x4 gv[2][2], bv[2][2];
#pragma unroll
        for (int bj = 0; bj < 2; ++bj)
#pragma unroll
            for (int n = 0; n < 2; ++n) { gv[bj][n] = *(const f32x4*)(g + colb + bj * HALF + n * 4); bv[bj][n] = *(const f32x4*)(b + colb + bj * HALF + n * 4); }
#pragma unroll
        for (int ai = 0; ai < 2; ++ai)
#pragma unroll
            for (int m = 0; m < 4; ++m) {
                const size_t row = (size_t)(u.pm * BM + ai * HALF + wr * 64 + m * 16 + fr);
                const f32x2 st = *(const f32x2*)(stats + row * 2);
                float* rp = X + row * DM + colb; const float* rq = rsrc + row * DM + colb;
#pragma unroll
                for (int bj = 0; bj < 2; ++bj)
#pragma unroll
                    for (int n = 0; n < 2; ++n) { f32x4* p = (f32x4*)(rp + bj * HALF + n * 4); const f32x4 yv = *(const f32x4*)(rq + bj * HALF + n * 4); const f32x4 x = ((yv - st[0]) * st[1]) * gv[bj][n] + bv[bj][n]; *p = x * al + acc[ai][bj][m][n] * s; }
                asm volatile("" ::: "memory");
            }
    }
};
struct Proj {
    static constexpr bool PERM = true, AFTER_DRAIN = false;
    bf16* P;
    DEV void operator()(const f32x4 (&acc)[2][2][4][2], const Unit& u, int wr, int wc, int fr_, int fq_) const {
        int t__ = threadIdx.x; asm volatile("" : "+v"(t__)); const int fr = t__ & 15, fq = (t__ >> 4) & 3; (void)fr_; (void)fq_;
        const float sc = (u.pn == 2 || u.pn == 3) ? QSCALE : 1.f;
        const int col0 = u.pn * BM + wc * 32 + 8 * fq;
#pragma unroll
        for (int ai = 0; ai < 2; ++ai)
#pragma unroll
            for (int m = 0; m < 4; ++m) {
                bf16* rp = P + (size_t)(u.pm * BM + ai * HALF + wr * 64 + m * 16 + fr) * PROJW + col0;
#pragma unroll
                for (int bj = 0; bj < 2; ++bj) { const f32x4 v0 = acc[ai][bj][m][0] * sc, v1 = acc[ai][bj][m][1] * sc;
                    u32x4 w; w.x = pk2(v0[0], v0[1]); w.y = pk2(v0[2], v0[3]); w.z = pk2(v1[0], v1[1]); w.w = pk2(v1[2], v1[3]);
                    *(u32x4*)(rp + bj * HALF) = w; }
                asm volatile("" ::: "memory");
            }
    }
};
struct FT {
    static constexpr bool PERM = true, AFTER_DRAIN = false;
    bf16* BP;
    DEV void operator()(const f32x4 (&acc)[2][2][4][2], const Unit& u, int wr, int wc, int fr_, int fq_) const {
        int t__ = threadIdx.x; asm volatile("" : "+v"(t__)); const int fr = t__ & 15, fq = (t__ >> 4) & 3; (void)fr_; (void)fq_;
        const int which = u.pm;
#pragma unroll
        for (int ai = 0; ai < 2; ++ai)
#pragma unroll
            for (int m = 0; m < 4; ++m) {
                const int n = ai * HALF + wr * 64 + m * 16 + fr;
#pragma unroll
                for (int bj = 0; bj < 2; ++bj) {
                    const int t0 = u.pn * BM + bj * HALF + wc * 32 + 8 * fq;
                    const f32x4 v0 = acc[ai][bj][m][0], v1 = acc[ai][bj][m][1];
                    if (t0 < MP) {
                        const int seq = t0 >> 12, s = t0 & 4095;
                        u32x4 w; w.x = pk2(v0[0], v0[1]); w.y = pk2(v0[2], v0[3]); w.z = pk2(v1[0], v1[1]); w.w = pk2(v1[2], v1[3]);
                        *(u32x4*)(BP + ((size_t)seq * 256 + n) * 8192 + which * 4096 + s) = w;
                    } else {
                        const int tt = t0 - MP, seq2 = tt >> 13, s = tt & 8191;
                        u32x2 ev, od; ev.x = pk2(v0[0], v0[2]); ev.y = pk2(v1[0], v1[2]); od.x = pk2(v0[1], v0[3]); od.y = pk2(v1[1], v1[3]);
                        bf16* be = BP + ((size_t)(16 + seq2 * 2) * 256 + n) * 8192 + which * 4096 + (s >> 1);
                        *(u32x2*)be = ev; *(u32x2*)(be + (size_t)256 * 8192) = od;
                    }
                }
                asm volatile("" ::: "memory");
            }
    }
};
struct DFT {
    static constexpr bool PERM = true, AFTER_DRAIN = false;
    bf16* Y; float* PART; float scale;
    DEV void operator()(const f32x4 (&acc)[2][2][4][2], const Unit& u, int wr, int wc, int fr_, int fq_) const {
        int t__ = threadIdx.x; asm volatile("" : "+v"(t__)); const int fr = t__ & 15, fq = (t__ >> 4) & 3; (void)fr_; (void)fq_;
        const int col0 = wc * 32 + 8 * fq;
        if (u.z < 16) {
#pragma unroll
            for (int ai = 0; ai < 2; ++ai)
#pragma unroll
                for (int m = 0; m < 4; ++m) {
                    bf16* rp = Y + (size_t)(u.z * SP + u.pm * BM + ai * HALF + wr * 64 + m * 16 + fr) * DM + 768 + col0;
#pragma unroll
                    for (int bj = 0; bj < 2; ++bj) { const f32x4 v0 = acc[ai][bj][m][0] * scale, v1 = acc[ai][bj][m][1] * scale;
                        u32x4 w; w.x = pk2(v0[0], v0[1]); w.y = pk2(v0[2], v0[3]); w.z = pk2(v1[0], v1[1]); w.w = pk2(v1[2], v1[3]);
                        *(u32x4*)(rp + bj * HALF) = w; }
                    asm volatile("" ::: "memory");
                }
        } else {
#pragma unroll
            for (int ai = 0; ai < 2; ++ai)
#pragma unroll
                for (int m = 0; m < 4; ++m) {
                    float* rp = PART + ((size_t)(u.z - 16) * 4096 + (u.pm & 15) * BM + ai * HALF + wr * 64 + m * 16 + fr) * 256 + col0;
#pragma unroll
                    for (int bj = 0; bj < 2; ++bj) { *(f32x4*)(rp + bj * HALF) = acc[ai][bj][m][0]; *(f32x4*)(rp + bj * HALF + 4) = acc[ai][bj][m][1]; }
                    asm volatile("" ::: "memory");
                }
        }
    }
};
struct DftOrder {
    int G, c;
    DEV bool next(int i, Unit& u) const { const int L = i * G + c; if (L >= 320) return false; u.pn = 0;
        if (L < 288) { const int pmA = L / 18, zi = L - pmA * 18; u.pm = pmA; u.z = zi < 16 ? zi : 16 + 2 * (zi - 16); }
        else { const int L2 = L - 288; u.pm = 16 + (L2 >> 1); u.z = 17 + 2 * (L2 & 1); }
        return true; }
    DEV void a_ready(const Unit&) const {}
    DEV void done(const Unit&) const {}
};
struct Raw {
    static constexpr bool PERM = true, AFTER_DRAIN = false;
    bf16* P;
    DEV void operator()(const f32x4 (&acc)[2][2][4][2], const Unit& u, int wr, int wc, int fr_, int fq_) const {
        int t__ = threadIdx.x; asm volatile("" : "+v"(t__)); const int fr = t__ & 15, fq = (t__ >> 4) & 3; (void)fr_; (void)fq_;
        const int col0 = u.pn * BM + wc * 32 + 8 * fq;
#pragma unroll
        for (int ai = 0; ai < 2; ++ai)
#pragma unroll
            for (int m = 0; m < 4; ++m) {
                bf16* rp = P + (size_t)(u.pm * BM + ai * HALF + wr * 64 + m * 16 + fr) * 1024 + col0;
#pragma unroll
                for (int bj = 0; bj < 2; ++bj) { const f32x4 v0 = acc[ai][bj][m][0], v1 = acc[ai][bj][m][1];
                    u32x4 w; w.x = pk2(v0[0], v0[1]); w.y = pk2(v0[2], v0[3]); w.z = pk2(v1[0], v1[1]); w.w = pk2(v1[2], v1[3]);
                    *(u32x4*)(rp + bj * HALF) = w; }
                asm volatile("" ::: "memory");
            }
    }
};
struct BatchOrder {
    int lz, nM, G, c;
    DEV bool next(int i, Unit& u) const { const int L = i * G + c; if (L >= (nM << lz)) return false; u.pm = L >> lz; u.z = L & ((1 << lz) - 1); u.pn = 0; return true; }
    DEV void a_ready(const Unit&) const {}
    DEV void done(const Unit&) const {}
};
}
struct Ctx {
    const float* const* in; float* out; unsigned char* ws;
    int tid, lane, wave, G, bid;
};
#ifndef RPA
#define RPA 1
#endif
#ifndef RPB
#define RPB 1
#endif
#ifndef RPE
#define RPE 1
#endif
#ifndef RPF
#define RPF 1
#endif
DEV void transpose_item(const float* W, int ldw, int srccol0, bf16* WT, int ldo, int dstrow0, int k0, LAS float* scr, int lane) {
#pragma unroll 8
    for (int i = 0; i < 32; ++i) { const int kk = 2 * i + (lane >> 5); scr[kk * 33 + (lane & 31)] = W[(size_t)(k0 + kk) * ldw + srccol0 + (lane & 31)]; }
    asm volatile("s_waitcnt lgkmcnt(0)" ::: "memory");
    const int c = lane & 7;
#pragma unroll
    for (int j = 0; j < 4; ++j) { const int n = (lane >> 3) + 8 * j; const LAS float* s = scr + (8 * c) * 33 + n;
        u32x4 o; o.x = pk2(s[0 * 33], s[1 * 33]); o.y = pk2(s[2 * 33], s[3 * 33]); o.z = pk2(s[4 * 33], s[5 * 33]); o.w = pk2(s[6 * 33], s[7 * 33]);
        *(u32x4*)(WT + (size_t)(dstrow0 + n) * ldo + k0 + 8 * c) = o; }
    asm volatile("s_waitcnt lgkmcnt(0)" ::: "memory");
}
DEV void phase_prologue(const Ctx& C, LAS unsigned char* lds) {
    const int gw = C.bid * 8 + C.wave, NGW = C.G * 8;
    const long gt = (long)C.bid * 512 + C.tid, NGT = (long)C.G * 512;
    unsigned char* ws = C.ws;
for (int rp_ = 0; rp_ < RPA; ++rp_) {
    {
        LAS float* scr = (LAS float*)(lds + C.wave * 16384);
        for (int it = gw; it < 2 * 9984; it += NGW) {
            const int l = it / 9984, r = it % 9984; int j, q;
            if (r < 8448) { j = r / 1408; q = r % 1408; } else if (r < 9472) { j = 6; q = r - 8448; } else { j = 7; q = r - 9472; }
            const float* src; int ldw, K, N; bf16* dst; int inter = 0, ioff = 0;
            if (j == 0 || j == 1 || j == 3 || j == 4) { const int f = j >= 3; const int up = (j == 1 || j == 4);
                src = C.in[(f ? 7 : 4) + up] + (size_t)l * DM * DFF; ldw = DFF; K = DM; N = DFF; dst = (bf16*)(ws + WS_WGU) + (size_t)(l * 2 + f) * 5632 * 1024; inter = 1; ioff = up ? 128 : 0; }
            else if (j == 2 || j == 5) { const int f = j == 5; src = C.in[f ? 9 : 6] + (size_t)l * DFF * DM; ldw = DM; K = DFF; N = DM; dst = (bf16*)(ws + WS_WD) + (size_t)(l * 2 + f) * 1024 * 2816; }
            else if (j == 6) { src = C.in[10] + (size_t)l * DM * 2304; ldw = 2304; K = DM; N = 2048; dst = (bf16*)(ws + WS_WIN) + (size_t)l * 2048 * 1024; }
            else { src = C.in[20] + (size_t)l * DM * DM; ldw = DM; K = DM; N = DM; dst = (bf16*)(ws + WS_WOUT) + (size_t)l * 1024 * 1024; }
            const int nblk = N / 32, kb = q / nblk, nb = q % nblk, n0 = 32 * nb;
            const int drow = inter ? (256 * (n0 >> 7) + (n0 & 127) + ioff) : n0;
            transpose_item(src, ldw, n0, dst, K, drow, 64 * kb, scr, C.lane);
        }
    }
}
    for (int rp_ = 0; rp_ < RPB; ++rp_) {
    {
        LAS float* tw = (LAS float*)(lds + 8 * 16384);
        if (C.tid < 64) { float sn, cs; sincospif((float)C.tid * (1.0f / 32.0f), &sn, &cs); tw[C.tid] = cs; tw[64 + C.tid] = sn; }
        __syncthreads();
        for (long it = gt; it < 2L * 512 * 128; it += NGT) {
            const int l = (int)(it / (512 * 128)), r = (int)(it % (512 * 128)), nrow = r >> 7, k0 = (r & 127) * 8;
            const int which = nrow >> 8, g = (nrow >> 6) & 3, cp = nrow & 63;
            const float* wsrc = C.in[10] + (size_t)l * DM * 2304 + 2048 + 64 * g;
            float o[8];
#pragma unroll
            for (int kk = 0; kk < 8; ++kk) {
                const float* wr_ = wsrc + (size_t)(k0 + kk) * 2304; float a = 0.f;
                for (int c = 0; c < 64; c += 4) { const f32x4 w4 = *(const f32x4*)(wr_ + c);
                    a += w4[0] * tw[which * 64 + (((c + 0) * cp) & 63)] + w4[1] * tw[which * 64 + (((c + 1) * cp) & 63)] + w4[2] * tw[which * 64 + (((c + 2) * cp) & 63)] + w4[3] * tw[which * 64 + (((c + 3) * cp) & 63)]; }
                o[kk] = a;
            }
            u32x4 w; w.x = pk2(o[0], o[1]); w.y = pk2(o[2], o[3]); w.z = pk2(o[4], o[5]); w.w = pk2(o[6], o[7]);
            *(u32x4*)((bf16*)(ws + WS_WF) + ((size_t)l * 512 + nrow) * 1024 + k0) = w;
        }
    }
}
    for (long it = gt; it < 2L * 1024 * 32; it += NGT) {
        const int l = (int)(it / (1024 * 32)), r = (int)(it % (1024 * 32)), n = r >> 5, k0 = (r & 31) * 8;
        const int tn = n >> 8, dir = tn >> 1, chh = tn & 1, within = n & 255, gate = within >> 7, ch = chh * 128 + (within & 127), hb = ch >> 6, jj = ch & 63;
        u32x4 w = {0u, 0u, 0u, 0u};
        if ((k0 >> 6) == hb) {
            const float* src = C.in[gate ? 15 : 13] + ((size_t)((l * 2 + dir) * 4 + hb) * 64) * 64 + jj;
            float o[8];
#pragma unroll
            for (int kk = 0; kk < 8; ++kk) o[kk] = src[(size_t)((k0 & 63) + kk) * 64];
            w.x = pk2(o[0], o[1]); w.y = pk2(o[2], o[3]); w.z = pk2(o[4], o[5]); w.w = pk2(o[6], o[7]);
        }
        *(u32x4*)((bf16*)(ws + WS_WG) + ((size_t)l * 1024 + n) * 256 + k0) = w;
    }
    if (gt < 1024) { const float lam = C.in[17][gt]; ((float*)(ws + WS_PAR))[gt] = 8.f * log1pf(expf(-lam)); }
    if (gt >= 1024 && gt < 1026) { const int l = (int)gt - 1024; const float* lq = C.in[18] + l * 256; float s1 = 0.f, s2 = 0.f;
        for (int i = 0; i < 64; ++i) { s1 += lq[i] * lq[64 + i]; s2 += lq[128 + i] * lq[192 + i]; }
        const float li = 0.8f - 0.6f * expf(-0.3f * (float)l);
        ((float*)(ws + WS_PAR))[1024 + l] = expf(s1) - expf(s2) + li; ((float*)(ws + WS_PAR))[1026 + l] = li; }
    if (gt < NRM_KN + 2 * 18 * 8) ((unsigned*)(ws + WS_NRM))[gt] = 0u;
    if (gt < MTOK) *(f32x2*)((float*)(ws + WS_STATS) + gt * 2) = (f32x2){0.f, 1.f};
    if (gt < 2048) ((float*)(ws + WS_ONES))[gt] = gt < 1024 ? 1.f : 0.f;
for (int rp_ = 0; rp_ < RPE; ++rp_) {
for (int rp_ = 0; rp_ < RPE; ++rp_) {
    for (long it = gt; it < 8192L * 1024; it += NGT) {
        const int row = (int)(it >> 10), k0 = (int)(it & 1023) * 8, odd = row >> 12, sp = row & 4095, neg = k0 >> 12, nb = k0 & 4095;
        float o[8];
#pragma unroll
        for (int e = 0; e < 8; ++e) { const int n = nb + e; float sn, cs;
            if (!odd) { const int idx = (n * sp) & 4095; sincospif((float)idx * (1.0f / 2048.0f), &sn, &cs); }
            else { const int idx = ((2 * n + 1) * sp) & 8191; sincospif((float)idx * (1.0f / 4096.0f), &sn, &cs); }
            o[e] = neg ? -sn : cs; }
        u32x4 w; w.x = pk2(o[0], o[1]); w.y = pk2(o[2], o[3]); w.z = pk2(o[4], o[5]); w.w = pk2(o[6], o[7]);
        *(u32x4*)((bf16*)(ws + WS_DFT) + (size_t)row * 8192 + k0) = w;
    }
}
    {
        const f32x4* xp = (const f32x4*)C.in[0]; const f32x4* xs = (const f32x4*)C.in[1]; u32x2* xb = (u32x2*)(ws + WS_XB);
        const long NP = (long)MP * 256, NT = (long)MTOK * 256;
        for (long it = gt; it < NT; it += NGT) { const f32x4 v = it < NP ? xp[it] : xs[it - NP]; u32x2 w; w.x = pk2(v[0], v[1]); w.y = pk2(v[2], v[3]); xb[it] = w; }
    }
}
}
DEV void ln_row(const f32x4 (&cur)[4], const f32x4 (&gv)[4], const f32x4 (&bv)[4], int m, int lane, float* out, unsigned char* ws, bool final_) {
    float s = 0.f, q = 0.f;
#pragma unroll
    for (int j = 0; j < 4; ++j) { s += (cur[j][0] + cur[j][1]) + (cur[j][2] + cur[j][3]); q += (cur[j][0] * cur[j][0] + cur[j][1] * cur[j][1]) + (cur[j][2] * cur[j][2] + cur[j][3] * cur[j][3]); }
#pragma unroll
    for (int o = 1; o < 64; o <<= 1) { const float s2 = lane_xor(s, lane, o), q2 = lane_xor(q, lane, o); s += s2; q += q2; }
    const float mean = s * (1.f / DM), var = __builtin_fmaxf(q * (1.f / DM) - mean * mean, 0.f), rstd = 1.f / sqrtf(var + 1e-5f);
    if (final_) {
        f32x4* xr = (f32x4*)(out + (size_t)m * DM) + lane;
#pragma unroll
        for (int j = 0; j < 4; ++j) xr[64 * j] = (cur[j] - mean) * rstd * gv[j] + bv[j];
    } else {
        u32x2* o8 = (u32x2*)((bf16*)(ws + WS_XB) + (size_t)m * DM) + lane;
#pragma unroll
        for (int j = 0; j < 4; ++j) { const f32x4 y = (cur[j] - mean) * rstd * gv[j] + bv[j]; u32x2 w; w.x = pk2(y[0], y[1]); w.y = pk2(y[2], y[3]); o8[64 * j] = w; }
        if (lane == 0) *(f32x2*)((float*)(ws + WS_STATS) + (size_t)m * 2) = (f32x2){mean, rstd};
    }
}
DEV void phase_ln(const Ctx& C, const float* g, const float* b, bool final_) {
    const int gw = C.bid * 8 + C.wave, NGW = C.G * 8, lane = C.lane;
    f32x4 gv[4], bv[4];
#pragma unroll
    for (int j = 0; j < 4; ++j) { gv[j] = ((const f32x4*)g)[lane + 64 * j]; bv[j] = ((const f32x4*)b)[lane + 64 * j]; }
    f32x4 c0[4], c1[4], n0[4], n1[4];
    auto ld = [&](f32x4 (&d)[4], int m) { const int mm = m < MTOK ? m : gw;
#pragma unroll
        for (int j = 0; j < 4; ++j) d[j] = ((const f32x4*)(C.out + (size_t)mm * DM))[lane + 64 * j]; };
    ld(c0, gw); ld(c1, gw + NGW);
    for (int m = gw; m < MTOK; m += 2 * NGW) {
        ld(n0, m + 2 * NGW); ld(n1, m + 3 * NGW);
        ln_row(c0, gv, bv, m, lane, C.out, C.ws, final_);
        if (m + NGW < MTOK) ln_row(c1, gv, bv, m + NGW, lane, C.out, C.ws, final_);
#pragma unroll
        for (int j = 0; j < 4; ++j) { c0[j] = n0[j]; c1[j] = n1[j]; }
    }
}
DEV void phase_dft_combine(const Ctx& C) {
    const long gt = (long)C.bid * 512 + C.tid, NGT = (long)C.G * 512;
    const float* PART = (const float*)(C.ws + WS_PART); bf16* Y = (bf16*)(C.ws + WS_YMIX); const float sc = 0.001381067932004976f;
    for (long it = gt; it < 2L * 4096 * 64; it += NGT) {
        const int seq2 = (int)(it >> 18), r = (int)(it & 262143), sp = r >> 6, c = (r & 63) * 4;
        const f32x4 p1 = *(const f32x4*)(PART + ((size_t)(seq2 * 2) * 4096 + sp) * 256 + c), p2 = *(const f32x4*)(PART + ((size_t)(seq2 * 2 + 1) * 4096 + sp) * 256 + c);
        const f32x4 lo = (p1 + p2) * sc, hi = (p1 - p2) * sc;
        u32x2 wl, wh; wl.x = pk2(lo[0], lo[1]); wl.y = pk2(lo[2], lo[3]); wh.x = pk2(hi[0], hi[1]); wh.y = pk2(hi[2], hi[3]);
        bf16* yl = Y + (size_t)(MP + seq2 * SS + sp) * DM + 768 + c;
        *(u32x2*)yl = wl; *(u32x2*)(yl + (size_t)4096 * DM) = wh;
    }
}
DEV void phase_conv(const Ctx& C, int l) {
    const long gt = (long)C.bid * 512 + C.tid, NGT = (long)C.G * 512;
    const bf16* P = (const bf16*)(C.ws + WS_PROJ); bf16* XC = (bf16*)(C.ws + WS_XC);
    const float* cw = C.in[11] + l * 4 * 256; const float* cb = C.in[12] + l * 256;
    for (long it = gt; it < (long)MTOK * 32; it += NGT) {
        const int tok = (int)(it >> 5), c0 = (int)(it & 31) * 8;
        const int pos = tok < MP ? (tok & 4095) : ((tok - MP) & 8191), S = tok < MP ? SP : SS;
        float a[8];
        { const f32x4 b0 = *(const f32x4*)(cb + c0), b1 = *(const f32x4*)(cb + c0 + 4); a[0] = b0[0]; a[1] = b0[1]; a[2] = b0[2]; a[3] = b0[3]; a[4] = b1[0]; a[5] = b1[1]; a[6] = b1[2]; a[7] = b1[3]; }
#pragma unroll
        for (int j = 0; j < 4; ++j) { const int tt = pos - 2 + j;
            if (tt >= 0 && tt < S) { const u32x4 xw = *(const u32x4*)(P + (size_t)(tok - 2 + j) * PROJW + c0);
                const f32x4 w0 = *(const f32x4*)(cw + j * 256 + c0), w1 = *(const f32x4*)(cw + j * 256 + c0 + 4);
                a[0] += w0[0] * bflo(xw.x); a[1] += w0[1] * bfhi(xw.x); a[2] += w0[2] * bflo(xw.y); a[3] += w0[3] * bfhi(xw.y);
                a[4] += w1[0] * bflo(xw.z); a[5] += w1[1] * bfhi(xw.z); a[6] += w1[2] * bflo(xw.w); a[7] += w1[3] * bfhi(xw.w); } }
        u32x4 w; w.x = pk2(a[0], a[1]); w.y = pk2(a[2], a[3]); w.z = pk2(a[4], a[5]); w.w = pk2(a[6], a[7]);
        *(u32x4*)(XC + (size_t)tok * 256 + c0) = w;
    }
    unsigned* QN = (unsigned*)(C.ws + WS_NRM) + l * 320 * 8; unsigned* KN = (unsigned*)(C.ws + WS_NRM) + NRM_KN + l * 18 * 8;
    for (long it = gt; it < (long)MTOK * 8; it += NGT) {
        const int tok = (int)(it >> 3), hm = (int)(it & 7);
        const bf16* qp = P + (size_t)tok * PROJW + 512 + hm * 64; float sq = 0.f, sk = 0.f;
#pragma unroll
        for (int j = 0; j < 8; ++j) { const u32x4 a = *(const u32x4*)(qp + 8 * j), k4 = *(const u32x4*)(qp + 512 + 8 * j);
            sq += bflo(a.x) * bflo(a.x) + bfhi(a.x) * bfhi(a.x) + bflo(a.y) * bflo(a.y) + bfhi(a.y) * bfhi(a.y) + bflo(a.z) * bflo(a.z) + bfhi(a.z) * bfhi(a.z) + bflo(a.w) * bflo(a.w) + bfhi(a.w) * bfhi(a.w);
            sk += bflo(k4.x) * bflo(k4.x) + bfhi(k4.x) * bfhi(k4.x) + bflo(k4.y) * bflo(k4.y) + bfhi(k4.y) * bfhi(k4.y) + bflo(k4.z) * bflo(k4.z) + bfhi(k4.z) * bfhi(k4.z) + bflo(k4.w) * bflo(k4.w) + bfhi(k4.w) * bfhi(k4.w); }
#pragma unroll
        for (int o = 8; o < 64; o <<= 1) { sq = fmaxf(sq, lane_xor(sq, C.lane, o)); sk = fmaxf(sk, lane_xor(sk, C.lane, o)); }
        if (C.lane < 8) { const int seq = tok < MP ? (tok >> 12) : 16 + ((tok - MP) >> 13);
            atomicMax(QN + (tok >> 8) * 8 + hm, __float_as_uint(sq)); atomicMax(KN + seq * 8 + hm, __float_as_uint(sk)); }
    }
}
DEV float fsig(float x) { return __builtin_amdgcn_rcpf(1.f + __builtin_amdgcn_exp2f(-LOG2E * x)); }
DEV void gate_eval(float rp, float ip, float xc, float ba, float bx, float sp8, float& la2, float& u) {
    const float r = fsig(rp + ba), ig = fsig(ip + bx);
    la2 = -sp8 * r * LOG2E;
    const float em = __builtin_fmaxf(1.f - __builtin_amdgcn_exp2f(2.f * la2), 0.f);
    u = __builtin_amdgcn_sqrtf(em) * ig * xc;
}
DEV float gelu_tanh(float x) { const float z = 0.7978845608028654f * (x + 0.044715f * x * x * x); const float e = __builtin_amdgcn_exp2f(2.f * LOG2E * z); return 0.5f * x * (2.f - 2.f * __builtin_amdgcn_rcpf(e + 1.f)); }
constexpr int SROW = 68;
typedef _Float16 h16x2 __attribute__((ext_vector_type(2)));
DEV unsigned pkh(float a, float b) { return __builtin_bit_cast(unsigned, __builtin_amdgcn_cvt_pkrtz(a, b)); }
template <int DIRV> DEV void gate_stage(const bf16* gbase, const bf16* xcb, int chb, int tl, int cg, LAS unsigned* sl, const float* pba, const float* pbx, const float* par) {
    const int col = (DIRV * 2 + (chb >> 7)) * 256 + (chb & 127);
    float ba[8], bx[8], sp[8];
#pragma unroll
    for (int q = 0; q < 2; ++q) { const f32x4 a = *(const f32x4*)(pba + DIRV * 256 + chb + 4 * q), b = *(const f32x4*)(pbx + DIRV * 256 + chb + 4 * q), s = *(const f32x4*)(par + DIRV * 256 + chb + 4 * q);
#pragma unroll
        for (int e = 0; e < 4; ++e) { ba[4 * q + e] = a[e]; bx[4 * q + e] = b[e]; sp[4 * q + e] = s[e]; } }
#pragma unroll
    for (int j = 0; j < 8; ++j) {
        const int t = 8 * j + tl;
        const u32x4 rw = *(const u32x4*)(gbase + (size_t)t * 1024 + col), iw = *(const u32x4*)(gbase + (size_t)t * 1024 + col + 128), xw = *(const u32x4*)(xcb + (size_t)t * 256);
        const float rp[8] = {bflo(rw.x), bfhi(rw.x), bflo(rw.y), bfhi(rw.y), bflo(rw.z), bfhi(rw.z), bflo(rw.w), bfhi(rw.w)};
        const float ip[8] = {bflo(iw.x), bfhi(iw.x), bflo(iw.y), bfhi(iw.y), bflo(iw.z), bfhi(iw.z), bflo(iw.w), bfhi(iw.w)};
        const float xc[8] = {bflo(xw.x), bfhi(xw.x), bflo(xw.y), bfhi(xw.y), bflo(xw.z), bfhi(xw.z), bflo(xw.w), bfhi(xw.w)};
        unsigned w[8];
#pragma unroll
        for (int e = 0; e < 8; ++e) { float la, u; gate_eval(rp[e], ip[e], xc[e], ba[e], bx[e], sp[e], la, u); w[e] = pkh(la, u); }
        LAS u32x4* dst = (LAS u32x4*)(sl + t * SROW + cg * 8);
        dst[0] = (u32x4){w[0], w[1], w[2], w[3]}; dst[1] = (u32x4){w[4], w[5], w[6], w[7]};
    }
    asm volatile("s_waitcnt lgkmcnt(0)" ::: "memory");
}
template <bool FINAL> DEV void phase_scan(const Ctx& C, int l, LAS unsigned char* lds) {
    const int gw = C.bid * 8 + C.wave, NGW = C.G * 8, lane = C.lane, tl = lane >> 3, cg = lane & 7;
    const bf16* GP = (const bf16*)(C.ws + WS_AU); float* AGG = (float*)(C.ws + WS_AGG); const bf16* XC = (const bf16*)(C.ws + WS_XC);
    const bf16* P = (const bf16*)(C.ws + WS_PROJ); bf16* Y = (bf16*)(C.ws + WS_YMIX);
    const float* par = (const float*)(C.ws + WS_PAR) + l * 512; const float* pba = C.in[14] + l * 512; const float* pbx = C.in[16] + l * 512;
    LAS unsigned* sl = (LAS unsigned*)(lds + C.wave * (64 * SROW * 4));
    for (int it = gw; it < 1280 * 4; it += NGW) {
        const int cidx = it >> 2, g4 = it & 3, ch = g4 * 64 + lane, chb = g4 * 64 + cg * 8;
        const bf16* gbase = GP + (size_t)cidx * 64 * 1024; const bf16* xcb = XC + (size_t)cidx * 64 * 256 + chb;
        if (!FINAL) {
            gate_stage<0>(gbase, xcb, chb, tl, cg, sl, pba, pbx, par);
            { float Ps = 0.f, h = 0.f;
#pragma unroll 16
              for (int t = 0; t < 64; ++t) { const h16x2 w = __builtin_bit_cast(h16x2, sl[t * SROW + lane]); const float la = (float)w[0]; h = __builtin_amdgcn_exp2f(la) * h + (float)w[1]; Ps += la; }
              *(f32x2*)(AGG + ((size_t)(cidx * 2 + 0) * 256 + ch) * 2) = (f32x2){Ps, h}; }
            asm volatile("s_waitcnt lgkmcnt(0)" ::: "memory");
            gate_stage<1>(gbase, xcb, chb, tl, cg, sl, pba, pbx, par);
            { float Ps = 0.f, h = 0.f;
#pragma unroll 16
              for (int t = 63; t >= 0; --t) { const h16x2 w = __builtin_bit_cast(h16x2, sl[t * SROW + lane]); const float la = (float)w[0]; h = __builtin_amdgcn_exp2f(la) * h + (float)w[1]; Ps += la; }
              *(f32x2*)(AGG + ((size_t)(cidx * 2 + 1) * 256 + ch) * 2) = (f32x2){Ps, h}; }
            asm volatile("s_waitcnt lgkmcnt(0)" ::: "memory");
        } else {
            int c0, c1; if (cidx < 1024) { c0 = cidx & ~63; c1 = c0 + 64; } else { c0 = 1024 + ((cidx - 1024) & ~127); c1 = c0 + 128; }
            float hin = 0.f, hbin = 0.f;
#pragma unroll 16
            for (int c = c0; c < cidx; ++c) { const f32x2 a = *(const f32x2*)(AGG + ((size_t)(c * 2 + 0) * 256 + ch) * 2); hin = __builtin_amdgcn_exp2f(a[0]) * hin + a[1]; }
#pragma unroll 16
            for (int c = c1 - 1; c > cidx; --c) { const f32x2 a = *(const f32x2*)(AGG + ((size_t)(c * 2 + 1) * 256 + ch) * 2); hbin = __builtin_amdgcn_exp2f(a[0]) * hbin + a[1]; }
            gate_stage<0>(gbase, xcb, chb, tl, cg, sl, pba, pbx, par);
            float hf[64]; float h = hin;
#pragma unroll
            for (int t = 0; t < 64; ++t) { const h16x2 w = __builtin_bit_cast(h16x2, sl[t * SROW + lane]); h = __builtin_amdgcn_exp2f((float)w[0]) * h + (float)w[1]; hf[t] = h; }
            asm volatile("s_waitcnt lgkmcnt(0)" ::: "memory");
            gate_stage<1>(gbase, xcb, chb, tl, cg, sl, pba, pbx, par);
            h = hbin;
#pragma unroll
            for (int t = 63; t >= 0; --t) { const h16x2 w = __builtin_bit_cast(h16x2, sl[t * SROW + lane]); h = __builtin_amdgcn_exp2f((float)w[0]) * h + (float)w[1]; sl[t * SROW + lane] = __float_as_uint(hf[t] + h); }
            asm volatile("s_waitcnt lgkmcnt(0)" ::: "memory");
#pragma unroll
            for (int j = 0; j < 8; ++j) {
                const int t = 8 * j + tl; const size_t tok = (size_t)cidx * 64 + t;
                const LAS u32x4* src = (const LAS u32x4*)(sl + t * SROW + cg * 8); const u32x4 s0 = src[0], s1 = src[1];
                const u32x4 gw_ = *(const u32x4*)(P + tok * PROJW + 256 + chb);
                u32x4 o;
                o.x = pk2(gelu_tanh(bflo(gw_.x)) * __uint_as_float(s0.x), gelu_tanh(bfhi(gw_.x)) * __uint_as_float(s0.y));
                o.y = pk2(gelu_tanh(bflo(gw_.y)) * __uint_as_float(s0.z), gelu_tanh(bfhi(gw_.y)) * __uint_as_float(s0.w));
                o.z = pk2(gelu_tanh(bflo(gw_.z)) * __uint_as_float(s1.x), gelu_tanh(bfhi(gw_.z)) * __uint_as_float(s1.y));
                o.w = pk2(gelu_tanh(bflo(gw_.w)) * __uint_as_float(s1.z), gelu_tanh(bfhi(gw_.w)) * __uint_as_float(s1.w));
                *(u32x4*)(Y + tok * DM + chb) = o;
            }
            asm volatile("s_waitcnt lgkmcnt(0)" ::: "memory");
        }
    }
}
namespace att {
constexpr int KROW = 272, VROW = 320, KBUF = 32 * KROW, VBUF = 32 * VROW, LDS_K = 0, LDS_V = 2 * KBUF, LDS_Q = 2 * KBUF + 2 * VBUF;
static_assert(LDS_Q + 256 * KROW + 16 <= LDS_BYTES, "attention LDS");
typedef short v4i16_t __attribute__((ext_vector_type(4)));
DEV s16x4 vtr(const LAS unsigned char* p) { return __builtin_bit_cast(s16x4, __builtin_amdgcn_ds_read_tr16_b64_v4i16((LAS v4i16_t*)p)); }


DEV void attn_unit(const bf16* PROJ, bf16* YMIX, int tok0, int S, int head, int qb, float lam, float oscale, const float* subg, float Bnd, LAS unsigned char* lds) {
    int tid_ = threadIdx.x; asm volatile("" : "+v"(tid_));
    const int tid = tid_, lane = tid & 63, r32 = lane & 31, hi = lane >> 5, wid = __builtin_amdgcn_readfirstlane(tid >> 6);
    const int qpos = qb * 256 + wid * 32 + r32;
    LAS unsigned char* qlds = lds + LDS_Q + wid * 32 * KROW;
    { const bf16* qg = PROJ + (size_t)(tok0 + qb * 256 + wid * 32) * PROJW + 512 + head * 128;
#pragma unroll
      for (int i = 0; i < 8; ++i) { const int ch = lane + 64 * i, row = ch >> 4, c16 = ch & 15; const u32x4 v = *(const u32x4*)(qg + (size_t)row * PROJW + c16 * 8); *(LAS u32x4*)(qlds + row * KROW + c16 * 16) = v; } }
    const LAS unsigned char* qfb = qlds + r32 * KROW + hi * 16;
    const float sl2 = __builtin_amdgcn_exp2f(-2.f * (float)(head + 1)) * LOG2E;
    const int srow = tid >> 4, sc16 = tid & 15;
    const bf16* kg = PROJ + (size_t)(tok0 + srow) * PROJW + 1024 + head * 128 + sc16 * 8;
    const bf16* vg = kg + 512;
    LAS unsigned char* kst = lds + LDS_K + srow * KROW + sc16 * 16;
    LAS unsigned char* vst = lds + LDS_V + srow * VROW + sc16 * 16;
    const LAS unsigned char* kfb = lds + LDS_K + r32 * KROW + hi * 16;
    const int i16 = lane & 15, gq = i16 >> 2, gp = i16 & 3, g1 = (lane >> 4) & 1;
    const LAS unsigned char* vfb = lds + LDS_V + (4 * hi + gq) * VROW + (16 * g1 + 4 * gp) * 2;
    u32x4 kr0, vr0;
    { const size_t go0 = (size_t)(qb * 8) * 32 * PROJW; kr0 = *(const u32x4*)(kg + go0); vr0 = *(const u32x4*)(vg + go0); }
    *(LAS u32x4*)kst = kr0; *(LAS u32x4*)vst = vr0;
    __syncthreads();
    f32x16 O[2][4];
#pragma unroll
    for (int c = 0; c < 2; ++c)
#pragma unroll
        for (int d = 0; d < 4; ++d)
#pragma unroll
            for (int r = 0; r < 16; ++r) O[c][d][r] = 0.f;
    float mrun[2] = {-1e30f, -1e30f}, lrun[2] = {0.f, 0.f};
    const int ts = qb * 8, qw0 = qb * 256 + wid * 32;
    int t_lo = 0, t_hi = (S >> 5) - 1;
    { const float Df = (2.f * Bnd + 138.f) / sl2;     if (Df < (float)S) { const int D = (int)Df + 1; const int a_ = (qb * 256 - D) >> 5, b_ = (qb * 256 + 255 + D) >> 5; t_lo = a_ > 0 ? a_ : 0; t_hi = b_ < t_hi ? b_ : t_hi; } }
    const int NT = t_hi - t_lo + 1;
    f32x16 bcv; float csign = 1.f;
#pragma unroll
    for (int r = 0; r < 16; ++r) { float cr_ = (float)((r & 3) + 8 * (r >> 2)); asm volatile("" : "+v"(cr_)); bcv[r] = sl2 * cr_; }
    for (int i = 0; i < NT; ++i) {
        int t = ts + i; if (t > t_hi) t -= NT;
        int tn = t + 1; if (tn > t_hi) tn -= NT;
        const int cur = i & 1, k0 = t * 32;
        const LAS unsigned char* kb = kfb + cur * KBUF; const LAS unsigned char* vb = vfb + cur * VBUF;
        const float dqf = (float)(qpos - k0 - 4 * hi);
        const bool diag = (k0 == qw0);
        if (!diag) { const float want = (k0 < qw0) ? 1.f : -1.f;
            if (want != csign) { csign = want;
#pragma unroll
                for (int r = 0; r < 16; ++r) bcv[r] = -bcv[r]; } }
        const float lt = diag ? 0.f : -csign * sl2 * dqf;
        if (i + 1 < NT) { const size_t go = (size_t)tn * 32 * PROJW; kr0 = *(const u32x4*)(kg + go); vr0 = *(const u32x4*)(vg + go); }
        bf16x8 pf[2][2];
        f32x16 pp[2]; pp[0] = bcv; pp[1] = bcv;
#pragma unroll
        for (int c = 0; c < 2; ++c) {
            bf16x8 kf[4], qf[4];
#pragma unroll
            for (int ds = 0; ds < 4; ++ds) { kf[ds] = *(const LAS bf16x8*)(kb + (c * 64 + ds * 16) * 2); qf[ds] = *(const LAS bf16x8*)(qfb + (c * 64 + ds * 16) * 2); }
            __builtin_amdgcn_sched_barrier(0);
#pragma unroll
            for (int ds = 0; ds < 4; ++ds) pp[c] = __builtin_amdgcn_mfma_f32_32x32x16_bf16(kf[ds], qf[ds], pp[c], 0, 0, 0);
        }
        if (diag) {
#pragma unroll
            for (int r = 0; r < 16; ++r) { float cr = (float)((r & 3) + 8 * (r >> 2)); asm volatile("" : "+v"(cr)); const float fx = bcv[r] + sl2 * __builtin_fabsf(dqf - cr); pp[0][r] -= fx; pp[1][r] -= fx; }
        }
        float rm[2];
#pragma unroll
        for (int c = 0; c < 2; ++c) {
            float m_ = pp[c][0];
#pragma unroll
            for (int r = 1; r < 16; ++r) m_ = __builtin_fmaxf(m_, pp[c][r]);
            m_ += lt;
            auto rr = __builtin_amdgcn_permlane32_swap(__float_as_uint(m_), __float_as_uint(m_), false, false); rm[c] = __builtin_fmaxf(__uint_as_float(rr[0]), __uint_as_float(rr[1]));
        }
        if (__any(rm[0] > mrun[0] + 8.f || rm[1] > mrun[1] + 8.f)) {
#pragma unroll
            for (int c = 0; c < 2; ++c) {
                const float mnew = rm[c] > mrun[c] + 8.f ? rm[c] : mrun[c], alpha = __builtin_amdgcn_exp2f(mrun[c] - mnew);
                mrun[c] = mnew; lrun[c] *= alpha;
#pragma unroll
                for (int d = 0; d < 4; ++d)
#pragma unroll
                    for (int r = 0; r < 16; ++r) O[c][d][r] *= alpha;
            }
        }
#pragma unroll
        for (int c = 0; c < 2; ++c) {
            const float mm = mrun[c] - lt;
            float rs = 0.f;
#pragma unroll
            for (int r = 0; r < 16; ++r) { pp[c][r] = __builtin_amdgcn_exp2f(pp[c][r] - mm); rs += pp[c][r]; }
            lrun[c] += rs;
#pragma unroll
            for (int s = 0; s < 2; ++s) {
                u32x4 a;
                a.x = pk2(pp[c][8 * s + 0], pp[c][8 * s + 1]); a.y = pk2(pp[c][8 * s + 2], pp[c][8 * s + 3]); a.z = pk2(pp[c][8 * s + 4], pp[c][8 * s + 5]); a.w = pk2(pp[c][8 * s + 6], pp[c][8 * s + 7]);
                pf[c][s] = __builtin_bit_cast(bf16x8, a);
            }
        }
#pragma unroll
        for (int xs = 0; xs < 2; ++xs) { __builtin_amdgcn_sched_barrier(0);
            s16x4 vlo[4], vhi[4];
#pragma unroll
            for (int d = 0; d < 4; ++d) { vlo[d] = vtr(vb + (16 * xs) * VROW + d * 64); vhi[d] = vtr(vb + (16 * xs + 8) * VROW + d * 64); }
            __builtin_amdgcn_sched_barrier(0);
#pragma unroll
            for (int d = 0; d < 4; ++d) {
                const bf16x8 vf = {vlo[d][0], vlo[d][1], vlo[d][2], vlo[d][3], vhi[d][0], vhi[d][1], vhi[d][2], vhi[d][3]};
                O[0][d] = __builtin_amdgcn_mfma_f32_32x32x16_bf16(vf, pf[0][xs], O[0][d], 0, 0, 0);
                O[1][d] = __builtin_amdgcn_mfma_f32_32x32x16_bf16(vf, pf[1][xs], O[1][d], 0, 0, 0);
            }
        }
        if (i + 1 < NT) { const int nb = cur ^ 1; *(LAS u32x4*)(kst + nb * KBUF) = kr0; *(LAS u32x4*)(vst + nb * VBUF) = vr0; }
        __syncthreads();
    }
    const float l0 = lrun[0] + lane_xor(lrun[0], lane, 32), l1 = lrun[1] + lane_xor(lrun[1], lane, 32);
    const float i0 = 1.f / l0, i1 = lam / l1;
    float ss = 0.f;
#pragma unroll
    for (int d = 0; d < 4; ++d)
#pragma unroll
        for (int r = 0; r < 16; ++r) { const float o = O[0][d][r] * i0 - O[1][d][r] * i1; O[0][d][r] = o; ss += o * o; }
    ss += lane_xor(ss, lane, 32);
    const float rn = oscale / sqrtf(ss * (1.f / 128.f) + 1e-5f);
    bf16* yrow = YMIX + (size_t)(tok0 + qpos) * DM + 256 + head * 128;
#pragma unroll
    for (int d = 0; d < 4; ++d)
#pragma unroll
        for (int rg = 0; rg < 4; ++rg) { const int d0 = 32 * d + 8 * rg + 4 * hi; const f32x4 g4 = *(const f32x4*)(subg + d0);
            u32x2 w; w.x = pk2(O[0][d][4 * rg + 0] * rn * g4[0], O[0][d][4 * rg + 1] * rn * g4[1]); w.y = pk2(O[0][d][4 * rg + 2] * rn * g4[2], O[0][d][4 * rg + 3] * rn * g4[3]);
            *(u32x2*)(yrow + d0) = w; }
}
DEV void attn_phase(const Ctx& C, int l, LAS unsigned char* lds, int rep = 0) {
    const bf16* P = (const bf16*)(C.ws + WS_PROJ); bf16* Y = (bf16*)(C.ws + WS_YMIX);
    const float lam = ((const float*)(C.ws + WS_PAR))[1024 + l], li = ((const float*)(C.ws + WS_PAR))[1026 + l];
    const float* subg = C.in[19] + l * 128;
    const float* QN = (const float*)(C.ws + WS_NRM) + l * 320 * 8; const float* KN = (const float*)(C.ws + WS_NRM) + NRM_KN + l * 18 * 8;
    unsigned* qcnt = (unsigned*)(C.ws + WS_BAR) + 16 + 16 * l + 4 * rep;
    volatile LAS int* ubox = (volatile LAS int*)(lds + LDS_Q + 256 * KROW);
    for (;;) {
        if (C.tid == 0) ubox[0] = (int)__hip_atomic_fetch_add(qcnt, 1u, __ATOMIC_RELAXED, __HIP_MEMORY_SCOPE_AGENT);
        __syncthreads();
        const int u = ubox[0];
        if (u >= 1280) break;
        const int head = 3 - u / 320, r = u % 320;
        int tok0, S, qb, seq;
        if (r < 64) { seq = 16 + (r >> 5); qb = r & 31; tok0 = MP + (r >> 5) * SS; S = SS; }
        else { const int v = r - 64; seq = v >> 4; qb = v & 15; tok0 = seq * SP; S = SP; }
        const int blk = (tok0 >> 8) + qb;
        const float b0 = sqrtf(QN[blk * 8 + head * 2] * KN[seq * 8 + head * 2]), b1 = sqrtf(QN[blk * 8 + head * 2 + 1] * KN[seq * 8 + head * 2 + 1]);
        const float Bnd = 1.02f * fmaxf(b0, b1) + 0.5f;
        attn_unit(P, Y, tok0, S, head, qb, lam, 1.f - li, subg, Bnd, lds);
    }
}
}
DEV void grid_barrier(unsigned* bar, unsigned epoch, unsigned G) {
    asm volatile("s_waitcnt vmcnt(0)" ::: "memory");
    __syncthreads();
    if (threadIdx.x == 0) {
        __builtin_amdgcn_fence(__ATOMIC_RELEASE, "agent");
        asm volatile("s_waitcnt vmcnt(0)" ::: "memory");
        __hip_atomic_fetch_add(bar, 1u, __ATOMIC_RELAXED, __HIP_MEMORY_SCOPE_AGENT);
        const unsigned target = epoch * G;
        while (__hip_atomic_load(bar, __ATOMIC_RELAXED, __HIP_MEMORY_SCOPE_AGENT) < target) __builtin_amdgcn_s_sleep(2);
        __builtin_amdgcn_fence(__ATOMIC_ACQUIRE, "agent");
        asm volatile("s_waitcnt vmcnt(0)" ::: "memory");
    }
    __syncthreads();
}
#ifndef REP_ATT
#define REP_ATT 1
#endif
#ifndef REP_FFNUP
#define REP_FFNUP 1
#endif
#ifndef REP_DFT
#define REP_DFT 1
#endif
#ifndef REP_BAR
#define REP_BAR 1
#endif
#ifndef REP_FFNDN
#define REP_FFNDN 1
#endif
#ifndef REP_GATE
#define REP_GATE 1
#endif
#ifndef REP_OUT
#define REP_OUT 1
#endif
#ifndef REP_LN
#define REP_LN 1
#endif
#ifndef REP_PROJ
#define REP_PROJ 1
#endif
#ifndef REP_SCANA
#define REP_SCANA 1
#endif
#ifndef REP_SCANC
#define REP_SCANC 1
#endif
#ifndef REP_CONV
#define REP_CONV 1
#endif
#ifndef REP_BAR
#define REP_BAR 1
#endif
#ifndef REP_FFNDN
#define REP_FFNDN 1
#endif
#ifndef REP_GATE
#define REP_GATE 1
#endif
#ifndef REP_OUT
#define REP_OUT 1
#endif
#ifndef REP_LN
#define REP_LN 1
#endif
#ifndef REP_PRO
#define REP_PRO 1
#endif
struct Args { const float* in[21]; float* out; unsigned char* ws; int ph_lo, ph_hi; };
constexpr int NPHASES = 27;
__global__ void __launch_bounds__(512, 2) mk_fwd(Args a) {
    extern __shared__ __attribute__((aligned(16))) unsigned char lds_raw[];
    LAS unsigned char* lds = (LAS unsigned char*)lds_raw;
    cg::grid_group grid = cg::this_grid();
    Ctx C;
C.in = a.in; C.out = a.out; C.ws = a.ws; C.tid = threadIdx.x; C.lane = C.tid & 63; C.wave = __builtin_amdgcn_readfirstlane(C.tid >> 6); C.G = gridDim.x; C.bid = blockIdx.x;
    unsigned char* ws = a.ws;
    const int lo = a.ph_lo, hi = a.ph_hi;
    int ph = 0; unsigned epoch = 0;
#define PH_BEGIN if (ph >= lo && ph < hi) { { int t_ = threadIdx.x; asm volatile("" : "+v"(t_)); C.tid = t_; C.lane = t_ & 63; C.wave = __builtin_amdgcn_readfirstlane(t_ >> 6); size_t z_ = 0; asm volatile("" : "+s"(z_)); ws = a.ws + z_; C.ws = ws; C.out = a.out + z_;     int g_ = gridDim.x, b_ = blockIdx.x; asm volatile("" : "+s"(g_), "+s"(b_)); C.G = g_; C.bid = b_; }
#define PH_END   if (ph + 1 < hi) { for (int rb_ = 0; rb_ < REP_BAR; ++rb_) grid_barrier((unsigned*)(a.ws + WS_BAR), ++epoch, gridDim.x); } } ++ph;
#define XB ((bf16*)(ws + WS_XB))
#define H ((bf16*)(ws + WS_H))
#define PROJ ((bf16*)(ws + WS_PROJ))
#define YMIX ((bf16*)(ws + WS_YMIX))
    if (ph >= lo && ph < hi) { { int t_ = threadIdx.x; asm volatile("" : "+v"(t_)); C.tid = t_; C.lane = t_ & 63; C.wave = __builtin_amdgcn_readfirstlane(t_ >> 6); }
#ifndef NO_PRO
 for (int rep_ = 0; rep_ < REP_PRO; ++rep_) { phase_prologue(C, lds); __syncthreads(); }
#endif
 __syncthreads(); if (ph + 1 < hi) grid.sync(); } ++ph;
    for (int l = 0; l < 2; ++l) {
        for (int f = 0; f < 2; ++f) {
            if (f == 1) {
                PH_BEGIN
                { pg8::Gemm g{XB, (const bf16*)(ws + WS_WIN) + (size_t)l * 2048 * 1024, 1024, 1024, 1024, 0, 0}; pg8::StaticOrder S; S.init(MTOK, 2048, C.G, C.bid);
                  epi::Proj E{PROJ};
#ifndef NO_PROJ
 for (int rep_ = 0; rep_ < REP_PROJ; ++rep_) pg8::gemm_phase<epi::Proj, pg8::StaticOrder, true, true, 1024, 1024, 1024>(lds, g, S, E);
#endif
 }
                { pg8::Gemm g{(const bf16*)(ws + WS_WF) + (size_t)l * 512 * 1024, XB, 1024, 1024, 1024, 0, 0}; pg8::StaticOrder S; S.init(512, MTOK, C.G, C.bid);
                  epi::FT E{(bf16*)(ws + WS_BTF)};
#ifndef NO_FT
 for (int rep_ = 0; rep_ < REP_PROJ; ++rep_) pg8::gemm_phase<epi::FT, pg8::StaticOrder, true, true, 1024, 1024, 1024>(lds, g, S, E);
#endif
 }
                PH_END
                PH_BEGIN for (int rep_ = 0; rep_ < REP_CONV; ++rep_) phase_conv(C, l); PH_END
                PH_BEGIN
                { pg8::Gemm g{(const bf16*)(ws + WS_XC), (const bf16*)(ws + WS_WG) + (size_t)l * 1024 * 256, 256, 256, 256, 0, 0}; pg8::StaticOrder S; S.init(MTOK, 1024, C.G, C.bid);
                  epi::Raw E{(bf16*)(ws + WS_AU)};
#ifndef NO_GATE
 for (int rep_ = 0; rep_ < REP_GATE; ++rep_) pg8::gemm_phase<epi::Raw, pg8::StaticOrder, true, true, 256, 256, 256>(lds, g, S, E);
#endif
 }
                PH_END
                PH_BEGIN
#ifndef NO_SCANA
 for (int rep_ = 0; rep_ < REP_SCANA; ++rep_) phase_scan<false>(C, l, lds);
 __syncthreads();
#endif
                { pg8::Gemm g{(const bf16*)(ws + WS_DFT), (const bf16*)(ws + WS_BTF), 8192, 8192, 8192, 0, (size_t)256 * 8192}; epi::DftOrder S{C.G, C.bid};
                  epi::DFT E{YMIX, (float*)(ws + WS_PART), 0.001953125f  };
#ifndef NO_DFT
 for (int rep_ = 0; rep_ < REP_DFT; ++rep_) pg8::gemm_phase<epi::DFT, epi::DftOrder, true, true, 8192, 8192, 8192>(lds, g, S, E);
#endif
 }
#ifndef NO_ATT
 for (int rep_ = 0; rep_ < REP_ATT; ++rep_) att::attn_phase(C, l, lds, rep_);
#endif
 PH_END
                PH_BEGIN
phase_dft_combine(C);
#ifndef NO_SCANC
 for (int rep_ = 0; rep_ < REP_SCANC; ++rep_) phase_scan<true>(C, l, lds);
#endif
 PH_END
                PH_BEGIN
                { pg8::Gemm g{YMIX, (const bf16*)(ws + WS_WOUT) + (size_t)l * 1024 * 1024, 1024, 1024, 1024, 0, 0}; pg8::StaticOrder S; S.init(MTOK, 1024, C.G, C.bid); S.rev = 1;
                  epi::Resid E{C.out, 1.0f, (const float*)(ws + WS_STATS), C.in[2] + (l * 3 + 0) * 1024, C.in[3] + (l * 3 + 0) * 1024, C.out, C.out + (size_t)MP * DM};
#ifndef NO_OUT
 for (int rep_ = 1; rep_ < REP_OUT; ++rep_) { epi::Resid E0{C.out, 0.f, (const float*)(ws + WS_STATS), (const float*)(ws + WS_ONES), (const float*)(ws + WS_ONES) + 1024, C.out, C.out + (size_t)MP * DM, 1.f}; pg8::gemm_phase<epi::Resid, pg8::StaticOrder, true, true, 1024, 1024, 1024>(lds, g, S, E0); }
 pg8::gemm_phase<epi::Resid, pg8::StaticOrder, true, true, 1024, 1024, 1024>(lds, g, S, E);
#endif
 }
                PH_END
                PH_BEGIN for (int rep_ = 0; rep_ < REP_LN; ++rep_) phase_ln(C, C.in[2] + (l * 3 + 1) * 1024, C.in[3] + (l * 3 + 1) * 1024, false); PH_END
            }
            PH_BEGIN
            { pg8::Gemm g{XB, (const bf16*)(ws + WS_WGU) + (size_t)(l * 2 + f) * 5632 * 1024, 1024, 1024, 1024, 0, 0}; pg8::StaticOrder S; S.init(MTOK, 5632, C.G, C.bid);
              epi::SwiGLU E{H};
#ifndef NO_FFNUP
 for (int rep_ = 0; rep_ < REP_FFNUP; ++rep_) pg8::gemm_phase<epi::SwiGLU, pg8::StaticOrder, true, true, 1024, 1024, 1024>(lds, g, S, E);
#endif
 }
            PH_END
            PH_BEGIN
            { pg8::Gemm g{H, (const bf16*)(ws + WS_WD) + (size_t)(l * 2 + f) * 1024 * 2816, 2816, 2816, 2816, 0, 0}; pg8::StaticOrder S; S.init(MTOK, 1024, C.G, C.bid); S.rev = 1;
              const bool ident_ = (l == 0 && f == 0); const int pidx_ = f == 1 ? l * 3 + 1 : (l - 1) * 3 + 2;
              epi::Resid E{C.out, 0.5f, (const float*)(ws + WS_STATS), ident_ ? (const float*)(ws + WS_ONES) : C.in[2] + pidx_ * 1024, ident_ ? (const float*)(ws + WS_ONES) + 1024 : C.in[3] + pidx_ * 1024, ident_ ? C.in[0] : C.out, ident_ ? C.in[1] : C.out + (size_t)MP * DM};
#ifndef NO_FFNDN
 for (int rep_ = 1; rep_ < REP_FFNDN; ++rep_) { epi::Resid E0{C.out, 0.f, (const float*)(ws + WS_STATS), (const float*)(ws + WS_ONES), (const float*)(ws + WS_ONES) + 1024, C.out, C.out + (size_t)MP * DM, 1.f}; pg8::gemm_phase<epi::Resid, pg8::StaticOrder, true, true, 2816, 2816, 2816>(lds, g, S, E0); }
 pg8::gemm_phase<epi::Resid, pg8::StaticOrder, true, true, 2816, 2816, 2816>(lds, g, S, E);
#endif
 }
            PH_END
            PH_BEGIN for (int rep_ = 0; rep_ < ((l == 1 && f == 1) ? 1 : REP_LN); ++rep_) phase_ln(C, C.in[2] + (l * 3 + 2 * f) * 1024, C.in[3] + (l * 3 + 2 * f) * 1024, l == 1 && f == 1); PH_END
        }
    }
}

#ifndef MK_COOP
#define MK_COOP 1
#endif
extern "C" void kernel_launch(void* const* d_in, const int* in_sizes, int n_in, void* d_out, int out_size, void* d_ws, size_t ws_size, hipStream_t stream) {
    static int grid = 0;
    if (grid == 0) {
        if (n_in != 21 || out_size != MTOK * DM || ws_size < WS_END) { fprintf(stderr, "kernel_launch: unexpected shapes (n_in %d out %d ws %zu)\n", n_in, out_size, ws_size); grid = -1; return; }
        int dev = 0, cus = 0, per_cu = 0;
        hipGetDevice(&dev); hipDeviceGetAttribute(&cus, hipDeviceAttributeMultiprocessorCount, dev);
        hipFuncSetAttribute((const void*)mk_fwd, hipFuncAttributeMaxDynamicSharedMemorySize, LDS_BYTES);
        hipOccupancyMaxActiveBlocksPerMultiprocessor(&per_cu, (const void*)mk_fwd, 512, LDS_BYTES);
        (void)hipGetLastError();
        if (per_cu < 1) per_cu = 1;
        grid = cus;
    }
    if (grid < 0) return;
    if (MK_COOP) (void)hipMemsetAsync((char*)d_ws + WS_BAR, 0, 256, stream);
    Args a{};
    for (int i = 0; i < 21; ++i) a.in[i] = (const float*)d_in[i];
    a.out = (float*)d_out; a.ws = (unsigned char*)d_ws;
#if MK_COOP
    a.ph_lo = 0; a.ph_hi = NPHASES;
    void* args[] = {&a};
    hipError_t e = hipLaunchCooperativeKernel((const void*)mk_fwd, dim3(grid), dim3(512), args, LDS_BYTES, stream);
    if (e != hipSuccess) fprintf(stderr, "cooperative launch failed: %s (grid %d)\n", hipGetErrorString(e), grid);
#else
    for (int p = 0; p < NPHASES; ++p) { a.ph_lo = p; a.ph_hi = p + 1; hipLaunchKernelGGL(mk_fwd, dim3(grid), dim3(512), LDS_BYTES, stream, a); }
#endif
}
```

```cpp
#include <hip/hip_runtime.h>
#include <hip/hip_cooperative_groups.h>
#include <hip/hip_bf16.h>
#include <cstdio>
#include <cstdint>
#include <cmath>
namespace cg = cooperative_groups;
namespace pg8 {
#define PG8_LAS __attribute__((address_space(3)))
typedef unsigned short bf16_t;
typedef short bf16x8 __attribute__((ext_vector_type(8)));
typedef float f32x4 __attribute__((ext_vector_type(4)));
typedef unsigned u32x4 __attribute__((ext_vector_type(4)));
constexpr int BM = 256, BK = 64, HALF = 128, HTB = HALF * BK * 2  , STAGE_BYTES = 8 * HTB, NXCD = 8, WGM = 8;

__host__ __device__ __forceinline__ int lds_byte(int r, int c) { const int st = (r >> 4) * 2 + (c >> 5), rr = r & 15, cc = c & 31, ob = rr * 64 + cc * 2; return st * 1024 + (ob ^ (((ob >> 9) & 1) << 5)); }
__host__ __device__ __forceinline__ void stage_rc(int b, int& R, int& C) { const int st = b / 1024, sb = b % 1024, swz = sb ^ (((sb >> 9) & 1) << 5); R = (st >> 1) * 16 + swz / 64; C = (st & 1) * 32 + (swz % 64) / 2; }
__host__ __device__ __forceinline__ int perm32(int rho) { const int n = rho >> 4, i = rho & 15; return 8 * (i >> 2) + 4 * n + (i & 3); }

struct Unit { int pm, pn, z; };
struct Gemm { const bf16_t* A; const bf16_t* Bt; int K, lda, ldb; size_t zA, zB; };

struct StaticOrder {
    int nM, nN, nwg, G, c; int rev = 0;
    __host__ __device__ void init(int M, int N, int G_, int c_) { nM = M / BM; nN = N / BM; nwg = nM * nN; G = G_; c = c_; }
    __host__ __device__ bool next(int i, Unit& u) const {
        const long L = (long)i * G + c; if (L >= nwg) return false;
        int wgid = rev ? nwg - 1 - (int)L : (int)L; { const int q = nwg / NXCD, r = nwg % NXCD, xcd = wgid % NXCD, off = wgid / NXCD; wgid = (xcd < r ? xcd * (q + 1) : r * (q + 1) + (xcd - r) * q) + off; }
        const int nig = WGM * nN, gid = wgid / nig, fm = gid * WGM, gsz = (nM - fm) < WGM ? (nM - fm) : WGM;
        u.pm = fm + ((wgid % nig) % gsz); u.pn = (wgid % nig) / gsz; u.z = 0; return true;
    }
    __device__ __forceinline__ void a_ready(const Unit&) const {}
    __device__ __forceinline__ void done(const Unit&) const {}
};

__device__ __forceinline__ unsigned cvt_pk_bf16(float lo, float hi) { unsigned r; asm volatile("v_cvt_pk_bf16_f32 %0, %1, %2" : "=v"(r) : "v"(lo), "v"(hi)); return r; }
typedef float f32x2 __attribute__((ext_vector_type(2)));
__device__ __forceinline__ f32x2 gelu_pk(f32x2 v) {
    const f32x2 av = __builtin_elementwise_abs(v), d = av * 0.2316418882f + 1.0f;
    f32x2 t; t.x = __builtin_amdgcn_rcpf(d.x); t.y = __builtin_amdgcn_rcpf(d.y);
    f32x2 q = t * 0.5307027145f + (-0.7265760135f); q = q * t + 0.7107068705f; q = q * t + (-0.142248368f); q = q * t + 0.127414796f; q = q * t;
    const f32x2 s = (v * v) * (-0.72134752044f);
    f32x2 e; e.x = __builtin_amdgcn_exp2f(s.x); e.y = __builtin_amdgcn_exp2f(s.y);
    const f32x2 m = v * (q * e), r = v - m;
    f32x2 o; o.x = v.x < 0.f ? m.x : r.x; o.y = v.y < 0.f ? m.y : r.y; return o;
}

template <int ACT  > struct EpiBf16 {
    static constexpr bool PERM = true, AFTER_DRAIN = false; static_assert(ACT == 0 || ACT == 1, "EpiBf16: ACT is 0 (none) or 1 (gelu_pk)");
    bf16_t* O; int ldc; const float* bias; int split_cols; size_t split_stride; float scale0;
    __device__ __forceinline__ void operator()(const f32x4 (&acc)[2][2][4][2], const Unit& u, int wr, int wc, int fr, int fq) const {
        const int row0 = u.pm * BM + wr * 64 + fr; int colt = u.pn * BM; bf16_t* base = O;
        float sc = 1.f; if (split_cols) { const int t = colt / split_cols; base += (size_t)t * split_stride; colt -= t * split_cols; if (t == 0) sc = scale0; }
        const int col0 = colt + wc * 32 + 8 * fq, bcol0 = u.pn * BM + wc * 32 + 8 * fq;
        f32x4 bv[2][2];
#pragma unroll
        for (int bj = 0; bj < 2; ++bj)
#pragma unroll
            for (int n = 0; n < 2; ++n) bv[bj][n] = bias ? *(const f32x4*)(bias + bcol0 + bj * HALF + 4 * n) : (f32x4){0.f, 0.f, 0.f, 0.f};
#pragma unroll
        for (int ai = 0; ai < 2; ++ai)
#pragma unroll
            for (int m = 0; m < 4; ++m) { bf16_t* rowp = base + (size_t)(row0 + ai * HALF + m * 16) * ldc + col0;
#pragma unroll
                for (int bj = 0; bj < 2; ++bj) { f32x4 v0 = acc[ai][bj][m][0] + bv[bj][0], v1 = acc[ai][bj][m][1] + bv[bj][1];
                    if (ACT == 1) { f32x2 a = gelu_pk((f32x2){v0[0], v0[1]}), b = gelu_pk((f32x2){v0[2], v0[3]}), c = gelu_pk((f32x2){v1[0], v1[1]}), d = gelu_pk((f32x2){v1[2], v1[3]});
                        v0 = (f32x4){a.x, a.y, b.x, b.y}; v1 = (f32x4){c.x, c.y, d.x, d.y}; }
                    v0 = v0 * sc; v1 = v1 * sc; u32x4 w; w.x = cvt_pk_bf16(v0[0], v0[1]); w.y = cvt_pk_bf16(v0[2], v0[3]); w.z = cvt_pk_bf16(v1[0], v1[1]); w.w = cvt_pk_bf16(v1[2], v1[3]);
                    *(u32x4*)(rowp + bj * HALF) = w; } }
    }
};

template <class Epi, class Sched, bool ALIGN_EPI, bool SP2, int KK, int LDA, int LDB>
__device__ __forceinline__ void gemm_phase(PG8_LAS unsigned char* lds, const Gemm g, const Sched& S, const Epi& E) {
    int tid_ = threadIdx.x; asm volatile("" : "+v"(tid_));
    const int tid = tid_, wid = __builtin_amdgcn_readfirstlane(tid >> 6), lane = tid & 63, wr = wid >> 2, wc = wid & 3, fr = lane & 15, fq = lane >> 4;
    constexpr int K = KK, nt = K / BK;
    unsigned voffA[2], voffB[2];
#pragma unroll
    for (int i = 0; i < 2; ++i) { int R, C; stage_rc(tid * 16 + i * 8192, R, C); const int Rb = Epi::PERM ? ((R & ~31) + perm32(R & 31)) : R;
        voffA[i] = (unsigned)(R * LDA + C) * 2u; voffB[i] = (unsigned)(Rb * LDB + C) * 2u; }
    constexpr size_t kstep = (size_t)(BK * 2);
    constexpr size_t hstepA = (size_t)HALF * LDA * 2, hstepB = (size_t)HALF * LDB * 2;
    constexpr size_t tstepA = 2 * hstepA, tstepB = 2 * hstepB;
    const unsigned ldsw = (unsigned)wid * 1024u;
    const int aoff = lds_byte(wr * 64 + fr, fq * 8), boff = lds_byte(wc * 32 + fr, fq * 8);
#define PG8_SA(b, h) (((b) * 2 + (h)) * HTB)
#define PG8_SB(b, h) ((4 + (b) * 2 + (h)) * HTB)
#define PG8_STAGE(bufoff, gbase, voff) do { _Pragma("unroll") for (int _i = 0; _i < 2; ++_i) \
        __builtin_amdgcn_global_load_lds((const unsigned*)((const char*)(gbase) + (voff)[_i]), (PG8_LAS unsigned*)(lds + (bufoff) + ldsw + _i * 8192), 16, 0, 0); } while (0)
#define PG8_LDA(dst, b, h) do { _Pragma("unroll") for (int m = 0; m < 4; ++m) _Pragma("unroll") for (int k = 0; k < 2; ++k) dst[m][k] = *(const PG8_LAS bf16x8*)(lds + PG8_SA(b, h) + aoff + m * 2048 + k * 1024); } while (0)
#define PG8_LDB(dst, b, h) do { _Pragma("unroll") for (int n = 0; n < 2; ++n) _Pragma("unroll") for (int k = 0; k < 2; ++k) dst[n][k] = *(const PG8_LAS bf16x8*)(lds + PG8_SB(b, h) + boff + n * 2048 + k * 1024); } while (0)
#define PG8_MMA(ai, bj, At, Bt) do { __builtin_amdgcn_s_setprio(1); _Pragma("unroll") for (int m = 0; m < 4; ++m) _Pragma("unroll") for (int n = 0; n < 2; ++n) _Pragma("unroll") for (int k = 0; k < 2; ++k) \
        acc[ai][bj][m][n] = __builtin_amdgcn_mfma_f32_16x16x32_bf16(Bt[n][k], At[m][k], acc[ai][bj][m][n], 0, 0, 0); __builtin_amdgcn_s_setprio(0); } while (0)
#define PG8_WAIT_V(n) asm volatile("s_waitcnt vmcnt(" #n ")" ::: "memory")
#define PG8_WAIT_L(n) asm volatile("s_waitcnt lgkmcnt(" #n ")" ::: "memory")
#define PG8_BAR __builtin_amdgcn_s_barrier()
#define PG8_SCHED __builtin_amdgcn_sched_barrier(0)
    Unit cur, nxt; int ui = 0;
    if (!S.next(0, cur)) return;
    f32x4 acc[2][2][4][2];
#pragma unroll
    for (int a = 0; a < 2; ++a)
#pragma unroll
        for (int b = 0; b < 2; ++b)
#pragma unroll
            for (int m = 0; m < 4; ++m)
#pragma unroll
                for (int n = 0; n < 2; ++n) acc[a][b][m][n] = (f32x4){0.f, 0.f, 0.f, 0.f};
    bf16x8 At[4][2], B0[2][2], B1[2][2];
    const char* cA = (const char*)g.A + (size_t)cur.z * g.zA * 2 + (size_t)cur.pm * tstepA; const char* cB = (const char*)g.Bt + (size_t)cur.z * g.zB * 2 + (size_t)cur.pn * tstepB;
    S.a_ready(cur);
    if constexpr (SP2) {
        PG8_STAGE(PG8_SB(0, 0), cB, voffB); PG8_STAGE(PG8_SB(0, 1), cB + hstepB, voffB); PG8_STAGE(PG8_SA(0, 0), cA, voffA); PG8_STAGE(PG8_SA(0, 1), cA + hstepA, voffA);
        if (wr == 1) PG8_BAR;
        PG8_WAIT_V(2); PG8_BAR;
        PG8_STAGE(PG8_SB(1, 0), cB + kstep, voffB); PG8_STAGE(PG8_SA(1, 0), cA + kstep, voffA); PG8_STAGE(PG8_SB(1, 1), cB + hstepB + kstep, voffB);
        PG8_WAIT_V(6); PG8_BAR;
    } else {
        PG8_STAGE(PG8_SB(0, 0), cB, voffB); PG8_STAGE(PG8_SA(0, 0), cA, voffA); PG8_STAGE(PG8_SB(0, 1), cB + hstepB, voffB); PG8_STAGE(PG8_SA(0, 1), cA + hstepA, voffA);
        if (wr == 1) PG8_BAR;
        PG8_WAIT_V(4); PG8_BAR;
        PG8_STAGE(PG8_SB(1, 0), cB + kstep, voffB); PG8_STAGE(PG8_SA(1, 0), cA + kstep, voffA); PG8_STAGE(PG8_SB(1, 1), cB + hstepB + kstep, voffB);
        PG8_WAIT_V(6); PG8_BAR;
    }
    for (;;) {
        const bool has_next = S.next(ui + 1, nxt);
        const char* nA = has_next ? (const char*)g.A + (size_t)nxt.z * g.zA * 2 + (size_t)nxt.pm * tstepA : cA; const char* nB = has_next ? (const char*)g.Bt + (size_t)nxt.z * g.zB * 2 + (size_t)nxt.pn * tstepB : cB;
        for (int t = 0; t < nt; t += 2) {
            const bool last = (t == nt - 2);
            const char* a1 = cA + (size_t)(t + 1) * kstep;
            const char* a2 = last ? nA : cA + (size_t)(t + 2) * kstep; const char* b2 = last ? nB : cB + (size_t)(t + 2) * kstep;
            const char* a3 = a2 + kstep; const char* b3 = b2 + kstep;
            if (last && has_next) S.a_ready(nxt);
            if constexpr (SP2) {
            PG8_LDB(B0, 0, 0); PG8_LDB(B1, 0, 1); PG8_SCHED; PG8_LDA(At, 0, 0); PG8_STAGE(PG8_SA(1, 1), a1 + hstepA, voffA);
            PG8_WAIT_V(8); PG8_WAIT_L(0); PG8_BAR; PG8_MMA(0, 0, At, B0); PG8_MMA(0, 1, At, B1); PG8_BAR; PG8_SCHED;
            PG8_LDA(At, 0, 1); PG8_STAGE(PG8_SB(0, 0), b2, voffB); PG8_STAGE(PG8_SB(0, 1), b2 + hstepB, voffB); PG8_STAGE(PG8_SA(0, 0), a2, voffA);
            PG8_WAIT_V(8); PG8_WAIT_L(0); PG8_BAR; PG8_MMA(1, 0, At, B0); PG8_MMA(1, 1, At, B1); PG8_BAR; PG8_SCHED;
            PG8_LDB(B0, 1, 0); PG8_LDB(B1, 1, 1); PG8_SCHED; PG8_LDA(At, 1, 0); PG8_STAGE(PG8_SA(0, 1), a2 + hstepA, voffA);
            PG8_WAIT_V(8); PG8_WAIT_L(0); PG8_BAR; PG8_MMA(0, 0, At, B0); PG8_MMA(0, 1, At, B1); PG8_BAR; PG8_SCHED;
            PG8_LDA(At, 1, 1); PG8_STAGE(PG8_SB(1, 0), b3, voffB); PG8_STAGE(PG8_SB(1, 1), b3 + hstepB, voffB); PG8_STAGE(PG8_SA(1, 0), a3, voffA);
            PG8_WAIT_V(8); PG8_WAIT_L(0); PG8_BAR; PG8_MMA(1, 0, At, B0); PG8_MMA(1, 1, At, B1); PG8_BAR; PG8_SCHED;
            } else {
            PG8_LDB(B0, 0, 0); PG8_SCHED; PG8_LDA(At, 0, 0); PG8_STAGE(PG8_SA(1, 1), a1 + hstepA, voffA);
            PG8_WAIT_L(8); PG8_BAR; PG8_WAIT_L(0); PG8_MMA(0, 0, At, B0); PG8_BAR; PG8_SCHED;
            PG8_LDB(B1, 0, 1); PG8_STAGE(PG8_SB(0, 0), b2, voffB);
            PG8_BAR; PG8_WAIT_L(0); PG8_MMA(0, 1, At, B1); PG8_BAR;
            PG8_LDA(At, 0, 1); PG8_STAGE(PG8_SA(0, 0), a2, voffA);
            PG8_BAR; PG8_WAIT_L(0); PG8_MMA(1, 0, At, B0); PG8_BAR; PG8_SCHED;
            PG8_STAGE(PG8_SB(0, 1), b2 + hstepB, voffB);
            PG8_WAIT_V(6); PG8_BAR; PG8_MMA(1, 1, At, B1); PG8_BAR;
            PG8_LDB(B0, 1, 0); PG8_SCHED; PG8_LDA(At, 1, 0); PG8_STAGE(PG8_SA(0, 1), a2 + hstepA, voffA);
            PG8_WAIT_L(8); PG8_BAR; PG8_WAIT_L(0); PG8_MMA(0, 0, At, B0); PG8_BAR; PG8_SCHED;
            PG8_LDB(B1, 1, 1); PG8_STAGE(PG8_SB(1, 0), b3, voffB);
            PG8_BAR; PG8_WAIT_L(0); PG8_MMA(0, 1, At, B1); PG8_BAR;
            PG8_LDA(At, 1, 1); PG8_STAGE(PG8_SA(1, 0), a3, voffA);
            PG8_BAR; PG8_WAIT_L(0); PG8_MMA(1, 0, At, B0); PG8_BAR; PG8_SCHED;
            PG8_STAGE(PG8_SB(1, 1), b3 + hstepB, voffB);
            PG8_WAIT_V(6); PG8_BAR; PG8_MMA(1, 1, At, B1); PG8_BAR;
            }
        }
        if constexpr (ALIGN_EPI) { if (wr == 0) PG8_BAR; }
        if constexpr (!Epi::AFTER_DRAIN) { E(acc, cur, wr, wc, fr, fq); S.done(cur); }
        if (!has_next) break;
#pragma unroll
        for (int a = 0; a < 2; ++a)
#pragma unroll
            for (int b = 0; b < 2; ++b)
#pragma unroll
                for (int m = 0; m < 4; ++m)
#pragma unroll
                    for (int n = 0; n < 2; ++n) acc[a][b][m][n] = (f32x4){0.f, 0.f, 0.f, 0.f};
        cur = nxt; cA = nA; cB = nB; ++ui;
        if constexpr (ALIGN_EPI) { if (wr == 1) PG8_BAR; }
    }
    PG8_WAIT_V(0);
    if constexpr (!ALIGN_EPI) { if (wr == 0) PG8_BAR; }
    PG8_BAR;
    if constexpr (Epi::AFTER_DRAIN) { E.fused(acc, cur, wr, wc, fr, fq, lds, wid, lane); S.done(cur); }
#undef PG8_SA
#undef PG8_SB
#undef PG8_STAGE
#undef PG8_LDA
#undef PG8_LDB
#undef PG8_MMA
#undef PG8_WAIT_V
#undef PG8_WAIT_L
#undef PG8_BAR
#undef PG8_SCHED
}
}
#define DEV __device__ __forceinline__
#define LAS __attribute__((address_space(3)))
typedef unsigned short bf16;
typedef float f32x4 __attribute__((ext_vector_type(4)));
typedef float f32x2 __attribute__((ext_vector_type(2)));
typedef float f32x16 __attribute__((ext_vector_type(16)));
typedef unsigned u32x4 __attribute__((ext_vector_type(4)));
typedef unsigned u32x2 __attribute__((ext_vector_type(2)));
typedef short bf16x8 __attribute__((ext_vector_type(8)));
typedef short s16x4 __attribute__((ext_vector_type(4)));
typedef __bf16 bf16x2_t __attribute__((ext_vector_type(2)));

constexpr int DM = 1024, DFF = 2816, MTOK = 81920, MP = 65536, SP = 4096, SS = 8192;
constexpr int PROJW = 2048;
constexpr float LOG2E = 1.4426950408889634f;
constexpr float QSCALE = 0.125f * LOG2E;
constexpr float ALPHA = 1.4142135623730951f;
constexpr size_t MiB = 1u << 20;
constexpr size_t WS_PAR = 0;
constexpr size_t WS_NRM = 256 * 1024;
constexpr int NRM_KN = 2 * 320 * 8;
constexpr size_t WS_BAR = 512 * 1024;
constexpr size_t WS_WGU = 1 * MiB;
constexpr size_t WS_WD = 45 * MiB;
constexpr size_t WS_WIN = 67 * MiB;
constexpr size_t WS_WF = 75 * MiB;
constexpr size_t WS_WOUT = 77 * MiB;
constexpr size_t WS_WG = 81 * MiB;
constexpr size_t WS_DFT = 82 * MiB;
constexpr size_t WS_AGG = 210 * MiB;
constexpr size_t WS_STATS = 215 * MiB;
constexpr size_t WS_ONES = WS_STATS + 768 * 1024;
constexpr size_t WS_PROJ = 216 * MiB;
constexpr size_t WS_BTF = 536 * MiB;
constexpr size_t WS_XC = 632 * MiB;
constexpr size_t WS_YMIX = 672 * MiB;
constexpr size_t WS_AU = 832 * MiB;
constexpr size_t WS_XB = WS_AU;
constexpr size_t WS_H = WS_PROJ;
constexpr size_t WS_PART = 992 * MiB;
constexpr size_t WS_END = 1008 * MiB;
static_assert(WS_H + (size_t)MTOK * DFF * 2 <= WS_YMIX, "H overlay");
constexpr int LDS_BYTES = 147456;

DEV unsigned pk2(float lo, float hi) { f32x2 v = {lo, hi}; bf16x2_t b = __builtin_convertvector(v, bf16x2_t); return __builtin_bit_cast(unsigned, b); }
DEV float bf2f(unsigned short b) { return __uint_as_float((unsigned)b << 16); }
DEV float bflo(unsigned w) { return __uint_as_float(w << 16); }
DEV float bfhi(unsigned w) { return __uint_as_float(w & 0xffff0000u); }
DEV float lane_xor(float v, int lane, int o) { return __int_as_float(__builtin_amdgcn_ds_bpermute((lane ^ o) << 2, __float_as_int(v))); }
DEV float wave_sum(float v, int lane) {
#pragma unroll
    for (int o = 1; o < 64; o <<= 1) v += lane_xor(v, lane, o);
    return v;
}
DEV float sigmoidf_(float x) { return __builtin_amdgcn_rcpf(1.f + __builtin_amdgcn_exp2f(-LOG2E * x)); }

namespace epi {
using pg8::Unit; using pg8::HALF; using pg8::BM;
struct SwiGLU {
    static constexpr bool PERM = true, AFTER_DRAIN = false;
    bf16* H;
    DEV void operator()(const f32x4 (&acc)[2][2][4][2], const Unit& u, int wr, int wc, int fr_, int fq_) const {
        int t__ = threadIdx.x; asm volatile("" : "+v"(t__)); const int fr = t__ & 15, fq = (t__ >> 4) & 3; (void)fr_; (void)fq_;
        const int col0 = u.pn * 128 + wc * 32 + 8 * fq;
#pragma unroll
        for (int ai = 0; ai < 2; ++ai)
#pragma unroll
            for (int m = 0; m < 4; ++m) {
                const int row = u.pm * BM + ai * HALF + wr * 64 + m * 16 + fr;
                float o[8];
#pragma unroll
                for (int n = 0; n < 2; ++n)
#pragma unroll
                    for (int e = 0; e < 4; ++e) { const float g = acc[ai][0][m][n][e], up = acc[ai][1][m][n][e]; o[4 * n + e] = g * sigmoidf_(g) * up; }
                u32x4 w; w.x = pk2(o[0], o[1]); w.y = pk2(o[2], o[3]); w.z = pk2(o[4], o[5]); w.w = pk2(o[6], o[7]);
                *(u32x4*)(H + (size_t)row * DFF + col0) = w; asm volatile("" ::: "memory");
            }
    }
};
struct Resid {
    static constexpr bool PERM = true, AFTER_DRAIN = false;
    float* X; float s; const float* stats; const float* g; const float* b; const float* r0; const float* r1; float al = ALPHA;
    DEV void operator()(const f32x4 (&acc)[2][2][4][2], const Unit& u, int wr, int wc, int fr_, int fq_) const {
        int t__ = threadIdx.x; asm volatile("" : "+v"(t__)); const int fr = t__ & 15, fq = (t__ >> 4) & 3; (void)fr_; (void)fq_;
        const int colb = u.pn * BM + wc * 32 + 8 * fq;
        const float* rsrc = (u.pm * BM < MP) ? r0 : r1 - (size_t)MP * DM;
        f32x4 gv[2][2], bv[2][2];
#pragma unroll
        for (int bj = 0; bj < 2; ++bj)
#pragma unroll
            for (int n = 0; n < 2; ++n) { gv[bj][n] = *(const f32x4*)(g + colb + bj * HALF + n * 4); bv[bj][n] = *(const f32x4*)(b + colb + bj * HALF + n * 4); }
#pragma unroll
        for (int ai = 0; ai < 2; ++ai)
#pragma unroll
            for (int m = 0; m < 4; ++m) {
                const size_t row = (size_t)(u.pm * BM + ai * HALF + wr * 64 + m * 16 + fr);
                const f32x2 st = *(const f32x2*)(stats + row * 2);
                float* rp = X + row * DM + colb; const float* rq = rsrc + row * DM + colb;
#pragma unroll
                for (int bj = 0; bj < 2; ++bj)
#pragma unroll
                    for (int n = 0; n < 2; ++n) { f32x4* p = (f32x4*)(rp + bj * HALF + n * 4); const f32x4 yv = *(const f32x4*)(rq + bj * HALF + n * 4); const f32x4 x = ((yv - st[0]) * st[1]) * gv[bj][n] + bv[bj][n]; *p = x * al + acc[ai][bj][m][n] * s; }
                asm volatile("" ::: "memory");
            }
    }
};
struct Proj {
    static constexpr bool PERM = true, AFTER_DRAIN = false;
    bf16* P;
    DEV void operator()(const f32x4 (&acc)[2][2][4][2], const Unit& u, int wr, int wc, int fr_, int fq_) const {
        int t__ = threadIdx.x; asm volatile("" : "+v"(t__)); const int fr = t__ & 15, fq = (t__ >> 4) & 3; (void)fr_; (void)fq_;
        const float sc = (u.pn == 2 || u.pn == 3) ? QSCALE : 1.f;
        const int col0 = u.pn * BM + wc * 32 + 8 * fq;
#pragma unroll
        for (int ai = 0; ai < 2; ++ai)
#pragma unroll
            for (int m = 0; m < 4; ++m) {
                bf16* rp = P + (size_t)(u.pm * BM + ai * HALF + wr * 64 + m * 16 + fr) * PROJW + col0;
#pragma unroll
                for (int bj = 0; bj < 2; ++bj) { const f32x4 v0 = acc[ai][bj][m][0] * sc, v1 = acc[ai][bj][m][1] * sc;
                    u32x4 w; w.x = pk2(v0[0], v0[1]); w.y = pk2(v0[2], v0[3]); w.z = pk2(v1[0], v1[1]); w.w = pk2(v1[2], v1[3]);
                    *(u32x4*)(rp + bj * HALF) = w; }
                asm volatile("" ::: "memory");
            }
    }
};
struct FT {
    static constexpr bool PERM = true, AFTER_DRAIN = false;
    bf16* BP;
    DEV void operator()(const f32x4 (&acc)[2][2][4][2], const Unit& u, int wr, int wc, int fr_, int fq_) const {
        int t__ = threadIdx.x; asm volatile("" : "+v"(t__)); const int fr = t__ & 15, fq = (t__ >> 4) & 3; (void)fr_; (void)fq_;
        const int which = u.pm;
#pragma unroll
        for (int ai = 0; ai < 2; ++ai)
#pragma unroll
            for (int m = 0; m < 4; ++m) {
                const int n = ai * HALF + wr * 64 + m * 16 + fr;
#pragma unroll
                for (int bj = 0; bj < 2; ++bj) {
                    const int t0 = u.pn * BM + bj * HALF + wc * 32 + 8 * fq;
                    const f32x4 v0 = acc[ai][bj][m][0], v1 = acc[ai][bj][m][1];
                    if (t0 < MP) {
                        const int seq = t0 >> 12, s = t0 & 4095;
                        u32x4 w; w.x = pk2(v0[0], v0[1]); w.y = pk2(v0[2], v0[3]); w.z = pk2(v1[0], v1[1]); w.w = pk2(v1[2], v1[3]);
                        *(u32x4*)(BP + ((size_t)seq * 256 + n) * 8192 + which * 4096 + s) = w;
                    } else {
                        const int tt = t0 - MP, seq2 = tt >> 13, s = tt & 8191;
                        u32x2 ev, od; ev.x = pk2(v0[0], v0[2]); ev.y = pk2(v1[0], v1[2]); od.x = pk2(v0[1], v0[3]); od.y = pk2(v1[1], v1[3]);
                        bf16* be = BP + ((size_t)(16 + seq2 * 2) * 256 + n) * 8192 + which * 4096 + (s >> 1);
                        *(u32x2*)be = ev; *(u32x2*)(be + (size_t)256 * 8192) = od;
                    }
                }
                asm volatile("" ::: "memory");
            }
    }
};
struct DFT {
    static constexpr bool PERM = true, AFTER_DRAIN = false;
    bf16* Y; float* PART; float scale;
    DEV void operator()(const f32x4 (&acc)[2][2][4][2], const Unit& u, int wr, int wc, int fr_, int fq_) const {
        int t__ = threadIdx.x; asm volatile("" : "+v"(t__)); const int fr = t__ & 15, fq = (t__ >> 4) & 3; (void)fr_; (void)fq_;
        const int col0 = wc * 32 + 8 * fq;
        if (u.z < 16) {
#pragma unroll
            for (int ai = 0; ai < 2; ++ai)
#pragma unroll
                for (int m = 0; m < 4; ++m) {
                    bf16* rp = Y + (size_t)(u.z * SP + u.pm * BM + ai * HALF + wr * 64 + m * 16 + fr) * DM + 768 + col0;
#pragma unroll
                    for (int bj = 0; bj < 2; ++bj) { const f32x4 v0 = acc[ai][bj][m][0] * scale, v1 = acc[ai][bj][m][1] * scale;
                        u32x4 w; w.x = pk2(v0[0], v0[1]); w.y = pk2(v0[2], v0[3]); w.z = pk2(v1[0], v1[1]); w.w = pk2(v1[2], v1[3]);
                        *(u32x4*)(rp + bj * HALF) = w; }
                    asm volatile("" ::: "memory");
                }
        } else {
#pragma unroll
            for (int ai = 0; ai < 2; ++ai)
#pragma unroll
                for (int m = 0; m < 4; ++m) {
                    float* rp = PART + ((size_t)(u.z - 16) * 4096 + (u.pm & 15) * BM + ai * HALF + wr * 64 + m * 16 + fr) * 256 + col0;
#pragma unroll
                    for (int bj = 0; bj < 2; ++bj) { *(f32x4*)(rp + bj * HALF) = acc[ai][bj][m][0]; *(f32x4*)(rp + bj * HALF + 4) = acc[ai][bj][m][1]; }
                    asm volatile("" ::: "memory");
                }
        }
    }
};
struct DftOrder {
    int G, c;
    DEV bool next(int i, Unit& u) const { const int L = i * G + c; if (L >= 320) return false; u.pn = 0;
        if (L < 288) { const int pmA = L / 18, zi = L - pmA * 18; u.pm = pmA; u.z = zi < 16 ? zi : 16 + 2 * (zi - 16); }
        else { const int L2 = L - 288; u.pm = 16 + (L2 >> 1); u.z = 17 + 2 * (L2 & 1); }
        return true; }
    DEV void a_ready(const Unit&) const {}
    DEV void done(const Unit&) const {}
};
struct Raw {
    static constexpr bool PERM = true, AFTER_DRAIN = false;
    bf16* P;
    DEV void operator()(const f32x4 (&acc)[2][2][4][2], const Unit& u, int wr, int wc, int fr_, int fq_) const {
        int t__ = threadIdx.x; asm volatile("" : "+v"(t__)); const int fr = t__ & 15, fq = (t__ >> 4) & 3; (void)fr_; (void)fq_;
        const int col0 = u.pn * BM + wc * 32 + 8 * fq;
#pragma unroll
        for (int ai = 0; ai < 2; ++ai)
#pragma unroll
            for (int m = 0; m < 4; ++m) {
                bf16* rp = P + (size_t)(u.pm * BM + ai * HALF + wr * 64 + m * 16 + fr) * 1024 + col0;
#pragma unroll
                for (int bj = 0; bj < 2; ++bj) { const f32x4 v0 = acc[ai][bj][m][0], v1 = acc[ai][bj][m][1];
                    u32x4 w; w.x = pk2(v0[0], v0[1]); w.y = pk2(v0[2], v0[3]); w.z = pk2(v1[0], v1[1]); w.w = pk2(v1[2], v1[3]);
                    *(u32x4*)(rp + bj * HALF) = w; }
                asm volatile("" ::: "memory");
            }
    }
};
struct BatchOrder {
    int lz, nM, G, c;
    DEV bool next(int i, Unit& u) const { const int L = i * G + c; if (L >= (nM << lz)) return false; u.pm = L >> lz; u.z = L & ((1 << lz) - 1); u.pn = 0; return true; }
    DEV void a_ready(const Unit&) const {}
    DEV void done(const Unit&) const {}
};
}
struct Ctx {
    const float* const* in; float* out; unsigned char* ws;
    int tid, lane, wave, G, bid;
};
#ifndef RPA
#define RPA 1
#endif
#ifndef RPB
#define RPB 1
#endif
#ifndef RPE
#define RPE 1
#endif
#ifndef RPF
#define RPF 1
#endif
DEV void transpose_item(const float* W, int ldw, int srccol0, bf16* WT, int ldo, int dstrow0, int k0, LAS float* scr, int lane) {
#pragma unroll 8
    for (int i = 0; i < 32; ++i) { const int kk = 2 * i + (lane >> 5); scr[kk * 33 + (lane & 31)] = W[(size_t)(k0 + kk) * ldw + srccol0 + (lane & 31)]; }
    asm volatile("s_waitcnt lgkmcnt(0)" ::: "memory");
    const int c = lane & 7;
#pragma unroll
    for (int j = 0; j < 4; ++j) { const int n = (lane >> 3) + 8 * j; const LAS float* s = scr + (8 * c) * 33 + n;
        u32x4 o; o.x = pk2(s[0 * 33], s[1 * 33]); o.y = pk2(s[2 * 33], s[3 * 33]); o.z = pk2(s[4 * 33], s[5 * 33]); o.w = pk2(s[6 * 33], s[7 * 33]);
        *(u32x4*)(WT + (size_t)(dstrow0 + n) * ldo + k0 + 8 * c) = o; }
    asm volatile("s_waitcnt lgkmcnt(0)" ::: "memory");
}
DEV void phase_prologue(const Ctx& C, LAS unsigned char* lds) {
    const int gw = C.bid * 8 + C.wave, NGW = C.G * 8;
    const long gt = (long)C.bid * 512 + C.tid, NGT = (long)C.G * 512;
    unsigned char* ws = C.ws;
for (int rp_ = 0; rp_ < RPA; ++rp_) {
    {
        LAS float* scr = (LAS float*)(lds + C.wave * 16384);
        for (int it = gw; it < 2 * 9984; it += NGW) {
            const int l = it / 9984, r = it % 9984; int j, q;
            if (r < 8448) { j = r / 1408; q = r % 1408; } else if (r < 9472) { j = 6; q = r - 8448; } else { j = 7; q = r - 9472; }
            const float* src; int ldw, K, N; bf16* dst; int inter = 0, ioff = 0;
            if (j == 0 || j == 1 || j == 3 || j == 4) { const int f = j >= 3; const int up = (j == 1 || j == 4);
                src = C.in[(f ? 7 : 4) + up] + (size_t)l * DM * DFF; ldw = DFF; K = DM; N = DFF; dst = (bf16*)(ws + WS_WGU) + (size_t)(l * 2 + f) * 5632 * 1024; inter = 1; ioff = up ? 128 : 0; }
            else if (j == 2 || j == 5) { const int f = j == 5; src = C.in[f ? 9 : 6] + (size_t)l * DFF * DM; ldw = DM; K = DFF; N = DM; dst = (bf16*)(ws + WS_WD) + (size_t)(l * 2 + f) * 1024 * 2816; }
            else if (j == 6) { src = C.in[10] + (size_t)l * DM * 2304; ldw = 2304; K = DM; N = 2048; dst = (bf16*)(ws + WS_WIN) + (size_t)l * 2048 * 1024; }
            else { src = C.in[20] + (size_t)l * DM * DM; ldw = DM; K = DM; N = DM; dst = (bf16*)(ws + WS_WOUT) + (size_t)l * 1024 * 1024; }
            const int nblk = N / 32, kb = q / nblk, nb = q % nblk, n0 = 32 * nb;
            const int drow = inter ? (256 * (n0 >> 7) + (n0 & 127) + ioff) : n0;
            transpose_item(src, ldw, n0, dst, K, drow, 64 * kb, scr, C.lane);
        }
    }
}
    for (int rp_ = 0; rp_ < RPB; ++rp_) {
    {
        LAS float* tw = (LAS float*)(lds + 8 * 16384);
        if (C.tid < 64) { float sn, cs; sincospif((float)C.tid * (1.0f / 32.0f), &sn, &cs); tw[C.tid] = cs; tw[64 + C.tid] = sn; }
        __syncthreads();
        for (long it = gt; it < 2L * 512 * 128; it += NGT) {
            const int l = (int)(it / (512 * 128)), r = (int)(it % (512 * 128)), nrow = r >> 7, k0 = (r & 127) * 8;
            const int which = nrow >> 8, g = (nrow >> 6) & 3, cp = nrow & 63;
            const float* wsrc = C.in[10] + (size_t)l * DM * 2304 + 2048 + 64 * g;
            float o[8];
#pragma unroll
            for (int kk = 0; kk < 8; ++kk) {
                const float* wr_ = wsrc + (size_t)(k0 + kk) * 2304; float a = 0.f;
                for (int c = 0; c < 64; c += 4) { const f32x4 w4 = *(const f32x4*)(wr_ + c);
                    a += w4[0] * tw[which * 64 + (((c + 0) * cp) & 63)] + w4[1] * tw[which * 64 + (((c + 1) * cp) & 63)] + w4[2] * tw[which * 64 + (((c + 2) * cp) & 63)] + w4[3] * tw[which * 64 + (((c + 3) * cp) & 63)]; }
                o[kk] = a;
            }
            u32x4 w; w.x = pk2(o[0], o[1]); w.y = pk2(o[2], o[3]); w.z = pk2(o[4], o[5]); w.w = pk2(o[6], o[7]);
            *(u32x4*)((bf16*)(ws + WS_WF) + ((size_t)l * 512 + nrow) * 1024 + k0) = w;
        }
    }
}
    for (long it = gt; it < 2L * 1024 * 32; it += NGT) {
        const int l = (int)(it / (1024 * 32)), r = (int)(it % (1024 * 32)), n = r >> 5, k0 = (r & 31) * 8;
        const int tn = n >> 8, dir = tn >> 1, chh = tn & 1, within = n & 255, gate = within >> 7, ch = chh * 128 + (within & 127), hb = ch >> 6, jj = ch & 63;
        u32x4 w = {0u, 0u, 0u, 0u};
        if ((k0 >> 6) == hb) {
            const float* src = C.in[gate ? 15 : 13] + ((size_t)((l * 2 + dir) * 4 + hb) * 64) * 64 + jj;
            float o[8];
#pragma unroll
            for (int kk = 0; kk < 8; ++kk) o[kk] = src[(size_t)((k0 & 63) + kk) * 64];
            w.x = pk2(o[0], o[1]); w.y = pk2(o[2], o[3]); w.z = pk2(o[4], o[5]); w.w = pk2(o[6], o[7]);
        }
        *(u32x4*)((bf16*)(ws + WS_WG) + ((size_t)l * 1024 + n) * 256 + k0) = w;
    }
    if (gt < 1024) { const float lam = C.in[17][gt]; ((float*)(ws + WS_PAR))[gt] = 8.f * log1pf(expf(-lam)); }
    if (gt >= 1024 && gt < 1026) { const int l = (int)gt - 1024; const float* lq = C.in[18] + l * 256; float s1 = 0.f, s2 = 0.f;
        for (int i = 0; i < 64; ++i) { s1 += lq[i] * lq[64 + i]; s2 += lq[128 + i] * lq[192 + i]; }
        const float li = 0.8f - 0.6f * expf(-0.3f * (float)l);
        ((float*)(ws + WS_PAR))[1024 + l] = expf(s1) - expf(s2) + li; ((float*)(ws + WS_PAR))[1026 + l] = li; }
    if (gt < NRM_KN + 2 * 18 * 8) ((unsigned*)(ws + WS_NRM))[gt] = 0u;
    if (gt < MTOK) *(f32x2*)((float*)(ws + WS_STATS) + gt * 2) = (f32x2){0.f, 1.f};
    if (gt < 2048) ((float*)(ws + WS_ONES))[gt] = gt < 1024 ? 1.f : 0.f;
for (int rp_ = 0; rp_ < RPE; ++rp_) {
for (int rp_ = 0; rp_ < RPE; ++rp_) {
    for (long it = gt; it < 8192L * 1024; it += NGT) {
        const int row = (int)(it >> 10), k0 = (int)(it & 1023) * 8, odd = row >> 12, sp = row & 4095, neg = k0 >> 12, nb = k0 & 4095;
        float o[8];
#pragma unroll
        for (int e = 0; e < 8; ++e) { const int n = nb + e; float sn, cs;
            if (!odd) { const int idx = (n * sp) & 4095; sincospif((float)idx * (1.0f / 2048.0f), &sn, &cs); }
            else { const int idx = ((2 * n + 1) * sp) & 8191; sincospif((float)idx * (1.0f / 4096.0f), &sn, &cs); }
            o[e] = neg ? -sn : cs; }
        u32x4 w; w.x = pk2(o[0], o[1]); w.y = pk2(o[2], o[3]); w.z = pk2(o[4], o[5]); w.w = pk2(o[6], o[7]);
        *(u32x4*)((bf16*)(ws + WS_DFT) + (size_t)row * 8192 + k0) = w;
    }
}
    {
        const f32x4* xp = (const f32x4*)C.in[0]; const f32x4* xs = (const f32x4*)C.in[1]; u32x2* xb = (u32x2*)(ws + WS_XB);
        const long NP = (long)MP * 256, NT = (long)MTOK * 256;
        for (long it = gt; it < NT; it += NGT) { const f32x4 v = it < NP ? xp[it] : xs[it - NP]; u32x2 w; w.x = pk2(v[0], v[1]); w.y = pk2(v[2], v[3]); xb[it] = w; }
    }
}
}
DEV void ln_row(const f32x4 (&cur)[4], const f32x4 (&gv)[4], const f32x4 (&bv)[4], int m, int lane, float* out, unsigned char* ws, bool final_) {
    float s = 0.f, q = 0.f;
#pragma unroll
    for (int j = 0; j < 4; ++j) { s += (cur[j][0] + cur[j][1]) + (cur[j][2] + cur[j][3]); q += (cur[j][0] * cur[j][0] + cur[j][1] * cur[j][1]) + (cur[j][2] * cur[j][2] + cur[j][3] * cur[j][3]); }
#pragma unroll
    for (int o = 1; o < 64; o <<= 1) { const float s2 = lane_xor(s, lane, o), q2 = lane_xor(q, lane, o); s += s2; q += q2; }
    const float mean = s * (1.f / DM), var = __builtin_fmaxf(q * (1.f / DM) - mean * mean, 0.f), rstd = 1.f / sqrtf(var + 1e-5f);
    if (final_) {
        f32x4* xr = (f32x4*)(out + (size_t)m * DM) + lane;
#pragma unroll
        for (int j = 0; j < 4; ++j) __builtin_nontemporal_store((cur[j] - mean) * rstd * gv[j] + bv[j], xr + 64 * j);
    } else {
        u32x2* o8 = (u32x2*)((bf16*)(ws + WS_XB) + (size_t)m * DM) + lane;
#pragma unroll
        for (int j = 0; j < 4; ++j) { const f32x4 y = (cur[j] - mean) * rstd * gv[j] + bv[j]; u32x2 w; w.x = pk2(y[0], y[1]); w.y = pk2(y[2], y[3]); o8[64 * j] = w; }
        if (lane == 0) *(f32x2*)((float*)(ws + WS_STATS) + (size_t)m * 2) = (f32x2){mean, rstd};
    }
}
DEV void phase_ln(const Ctx& C, const float* g, const float* b, bool final_) {
    const int gw = C.bid * 8 + C.wave, NGW = C.G * 8, lane = C.lane;
    f32x4 gv[4], bv[4];
#pragma unroll
    for (int j = 0; j < 4; ++j) { gv[j] = ((const f32x4*)g)[lane + 64 * j]; bv[j] = ((const f32x4*)b)[lane + 64 * j]; }
    f32x4 c0[4], c1[4], n0[4], n1[4];
    auto ld = [&](f32x4 (&d)[4], int m) { const int mm = m < MTOK ? m : gw;
#pragma unroll
        for (int j = 0; j < 4; ++j) d[j] = ((const f32x4*)(C.out + (size_t)mm * DM))[lane + 64 * j]; };
    ld(c0, gw); ld(c1, gw + NGW);
    for (int m = gw; m < MTOK; m += 2 * NGW) {
        ld(n0, m + 2 * NGW); ld(n1, m + 3 * NGW);
        ln_row(c0, gv, bv, m, lane, C.out, C.ws, final_);
        if (m + NGW < MTOK) ln_row(c1, gv, bv, m + NGW, lane, C.out, C.ws, final_);
#pragma unroll
        for (int j = 0; j < 4; ++j) { c0[j] = n0[j]; c1[j] = n1[j]; }
    }
}
DEV void phase_dft_combine(const Ctx& C) {
    const long gt = (long)C.bid * 512 + C.tid, NGT = (long)C.G * 512;
    const float* PART = (const float*)(C.ws + WS_PART); bf16* Y = (bf16*)(C.ws + WS_YMIX); const float sc = 0.001381067932004976f;
    for (long it = gt; it < 2L * 4096 * 64; it += NGT) {
        const int seq2 = (int)(it >> 18), r = (int)(it & 262143), sp = r >> 6, c = (r & 63) * 4;
        const f32x4 p1 = *(const f32x4*)(PART + ((size_t)(seq2 * 2) * 4096 + sp) * 256 + c), p2 = *(const f32x4*)(PART + ((size_t)(seq2 * 2 + 1) * 4096 + sp) * 256 + c);
        const f32x4 lo = (p1 + p2) * sc, hi = (p1 - p2) * sc;
        u32x2 wl, wh; wl.x = pk2(lo[0], lo[1]); wl.y = pk2(lo[2], lo[3]); wh.x = pk2(hi[0], hi[1]); wh.y = pk2(hi[2], hi[3]);
        bf16* yl = Y + (size_t)(MP + seq2 * SS + sp) * DM + 768 + c;
        *(u32x2*)yl = wl; *(u32x2*)(yl + (size_t)4096 * DM) = wh;
    }
}
DEV void phase_conv(const Ctx& C, int l) {
    const long gt = (long)C.bid * 512 + C.tid, NGT = (long)C.G * 512;
    const bf16* P = (const bf16*)(C.ws + WS_PROJ); bf16* XC = (bf16*)(C.ws + WS_XC);
    const float* cw = C.in[11] + l * 4 * 256; const float* cb = C.in[12] + l * 256;
    for (long it = gt; it < (long)MTOK * 32; it += NGT) {
        const int tok = (int)(it >> 5), c0 = (int)(it & 31) * 8;
        const int pos = tok < MP ? (tok & 4095) : ((tok - MP) & 8191), S = tok < MP ? SP : SS;
        float a[8];
        { const f32x4 b0 = *(const f32x4*)(cb + c0), b1 = *(const f32x4*)(cb + c0 + 4); a[0] = b0[0]; a[1] = b0[1]; a[2] = b0[2]; a[3] = b0[3]; a[4] = b1[0]; a[5] = b1[1]; a[6] = b1[2]; a[7] = b1[3]; }
#pragma unroll
        for (int j = 0; j < 4; ++j) { const int tt = pos - 2 + j;
            if (tt >= 0 && tt < S) { const u32x4 xw = *(const u32x4*)(P + (size_t)(tok - 2 + j) * PROJW + c0);
                const f32x4 w0 = *(const f32x4*)(cw + j * 256 + c0), w1 = *(const f32x4*)(cw + j * 256 + c0 + 4);
                a[0] += w0[0] * bflo(xw.x); a[1] += w0[1] * bfhi(xw.x); a[2] += w0[2] * bflo(xw.y); a[3] += w0[3] * bfhi(xw.y);
                a[4] += w1[0] * bflo(xw.z); a[5] += w1[1] * bfhi(xw.z); a[6] += w1[2] * bflo(xw.w); a[7] += w1[3] * bfhi(xw.w); } }
        u32x4 w; w.x = pk2(a[0], a[1]); w.y = pk2(a[2], a[3]); w.z = pk2(a[4], a[5]); w.w = pk2(a[6], a[7]);
        *(u32x4*)(XC + (size_t)tok * 256 + c0) = w;
    }
    unsigned* QN = (unsigned*)(C.ws + WS_NRM) + l * 320 * 8; unsigned* KN = (unsigned*)(C.ws + WS_NRM) + NRM_KN + l * 18 * 8;
    for (long it = gt; it < (long)MTOK * 8; it += NGT) {
        const int tok = (int)(it >> 3), hm = (int)(it & 7);
        const bf16* qp = P + (size_t)tok * PROJW + 512 + hm * 64; float sq = 0.f, sk = 0.f;
#pragma unroll
        for (int j = 0; j < 8; ++j) { const u32x4 a = *(const u32x4*)(qp + 8 * j), k4 = *(const u32x4*)(qp + 512 + 8 * j);
            sq += bflo(a.x) * bflo(a.x) + bfhi(a.x) * bfhi(a.x) + bflo(a.y) * bflo(a.y) + bfhi(a.y) * bfhi(a.y) + bflo(a.z) * bflo(a.z) + bfhi(a.z) * bfhi(a.z) + bflo(a.w) * bflo(a.w) + bfhi(a.w) * bfhi(a.w);
            sk += bflo(k4.x) * bflo(k4.x) + bfhi(k4.x) * bfhi(k4.x) + bflo(k4.y) * bflo(k4.y) + bfhi(k4.y) * bfhi(k4.y) + bflo(k4.z) * bflo(k4.z) + bfhi(k4.z) * bfhi(k4.z) + bflo(k4.w) * bflo(k4.w) + bfhi(k4.w) * bfhi(k4.w); }
#pragma unroll
        for (int o = 8; o < 64; o <<= 1) { sq = fmaxf(sq, lane_xor(sq, C.lane, o)); sk = fmaxf(sk, lane_xor(sk, C.lane, o)); }
        if (C.lane < 8) { const int seq = tok < MP ? (tok >> 12) : 16 + ((tok - MP) >> 13);
            atomicMax(QN + (tok >> 8) * 8 + hm, __float_as_uint(sq)); atomicMax(KN + seq * 8 + hm, __float_as_uint(sk)); }
    }
}
DEV float fsig(float x) { return __builtin_amdgcn_rcpf(1.f + __builtin_amdgcn_exp2f(-LOG2E * x)); }
DEV void gate_eval(float rp, float ip, float xc, float ba, float bx, float sp8, float& la2, float& u) {
    const float r = fsig(rp + ba), ig = fsig(ip + bx);
    la2 = -sp8 * r * LOG2E;
    const float em = __builtin_fmaxf(1.f - __builtin_amdgcn_exp2f(2.f * la2), 0.f);
    u = __builtin_amdgcn_sqrtf(em) * ig * xc;
}
DEV float gelu_tanh(float x) { const float z = 0.7978845608028654f * (x + 0.044715f * x * x * x); const float e = __builtin_amdgcn_exp2f(2.f * LOG2E * z); return 0.5f * x * (2.f - 2.f * __builtin_amdgcn_rcpf(e + 1.f)); }
constexpr int SROW = 68;
typedef _Float16 h16x2 __attribute__((ext_vector_type(2)));
DEV unsigned pkh(float a, float b) { return __builtin_bit_cast(unsigned, __builtin_amdgcn_cvt_pkrtz(a, b)); }
template <int DIRV> DEV void gate_stage(const bf16* gbase, const bf16* xcb, int chb, int tl, int cg, LAS unsigned* sl, const float* pba, const float* pbx, const float* par) {
    const int col = (DIRV * 2 + (chb >> 7)) * 256 + (chb & 127);
    float ba[8], bx[8], sp[8];
#pragma unroll
    for (int q = 0; q < 2; ++q) { const f32x4 a = *(const f32x4*)(pba + DIRV * 256 + chb + 4 * q), b = *(const f32x4*)(pbx + DIRV * 256 + chb + 4 * q), s = *(const f32x4*)(par + DIRV * 256 + chb + 4 * q);
#pragma unroll
        for (int e = 0; e < 4; ++e) { ba[4 * q + e] = a[e]; bx[4 * q + e] = b[e]; sp[4 * q + e] = s[e]; } }
#pragma unroll
    for (int j = 0; j < 8; ++j) {
        const int t = 8 * j + tl;
        const u32x4 rw = *(const u32x4*)(gbase + (size_t)t * 1024 + col), iw = *(const u32x4*)(gbase + (size_t)t * 1024 + col + 128), xw = *(const u32x4*)(xcb + (size_t)t * 256);
        const float rp[8] = {bflo(rw.x), bfhi(rw.x), bflo(rw.y), bfhi(rw.y), bflo(rw.z), bfhi(rw.z), bflo(rw.w), bfhi(rw.w)};
        const float ip[8] = {bflo(iw.x), bfhi(iw.x), bflo(iw.y), bfhi(iw.y), bflo(iw.z), bfhi(iw.z), bflo(iw.w), bfhi(iw.w)};
        const float xc[8] = {bflo(xw.x), bfhi(xw.x), bflo(xw.y), bfhi(xw.y), bflo(xw.z), bfhi(xw.z), bflo(xw.w), bfhi(xw.w)};
        unsigned w[8];
#pragma unroll
        for (int e = 0; e < 8; ++e) { float la, u; gate_eval(rp[e], ip[e], xc[e], ba[e], bx[e], sp[e], la, u); w[e] = pkh(la, u); }
        LAS u32x4* dst = (LAS u32x4*)(sl + t * SROW + cg * 8);
        dst[0] = (u32x4){w[0], w[1], w[2], w[3]}; dst[1] = (u32x4){w[4], w[5], w[6], w[7]};
    }
    asm volatile("s_waitcnt lgkmcnt(0)" ::: "memory");
}
template <bool FINAL> DEV void phase_scan(const Ctx& C, int l, LAS unsigned char* lds) {
    const int gw = C.bid * 8 + C.wave, NGW = C.G * 8, lane = C.lane, tl = lane >> 3, cg = lane & 7;
    const bf16* GP = (const bf16*)(C.ws + WS_AU); float* AGG = (float*)(C.ws + WS_AGG); const bf16* XC = (const bf16*)(C.ws + WS_XC);
    const bf16* P = (const bf16*)(C.ws + WS_PROJ); bf16* Y = (bf16*)(C.ws + WS_YMIX);
    const float* par = (const float*)(C.ws + WS_PAR) + l * 512; const float* pba = C.in[14] + l * 512; const float* pbx = C.in[16] + l * 512;
    LAS unsigned* sl = (LAS unsigned*)(lds + C.wave * (64 * SROW * 4));
    for (int it = gw; it < 1280 * 4; it += NGW) {
        const int cidx = it >> 2, g4 = it & 3, ch = g4 * 64 + lane, chb = g4 * 64 + cg * 8;
        const bf16* gbase = GP + (size_t)cidx * 64 * 1024; const bf16* xcb = XC + (size_t)cidx * 64 * 256 + chb;
        if (!FINAL) {
            gate_stage<0>(gbase, xcb, chb, tl, cg, sl, pba, pbx, par);
            { float Ps = 0.f, h = 0.f;
#pragma unroll 16
              for (int t = 0; t < 64; ++t) { const h16x2 w = __builtin_bit_cast(h16x2, sl[t * SROW + lane]); const float la = (float)w[0]; h = __builtin_amdgcn_exp2f(la) * h + (float)w[1]; Ps += la; }
              *(f32x2*)(AGG + ((size_t)(cidx * 2 + 0) * 256 + ch) * 2) = (f32x2){Ps, h}; }
            asm volatile("s_waitcnt lgkmcnt(0)" ::: "memory");
            gate_stage<1>(gbase, xcb, chb, tl, cg, sl, pba, pbx, par);
            { float Ps = 0.f, h = 0.f;
#pragma unroll 16
              for (int t = 63; t >= 0; --t) { const h16x2 w = __builtin_bit_cast(h16x2, sl[t * SROW + lane]); const float la = (float)w[0]; h = __builtin_amdgcn_exp2f(la) * h + (float)w[1]; Ps += la; }
              *(f32x2*)(AGG + ((size_t)(cidx * 2 + 1) * 256 + ch) * 2) = (f32x2){Ps, h}; }
            asm volatile("s_waitcnt lgkmcnt(0)" ::: "memory");
        } else {
            int c0, c1; if (cidx < 1024) { c0 = cidx & ~63; c1 = c0 + 64; } else { c0 = 1024 + ((cidx - 1024) & ~127); c1 = c0 + 128; }
            float hin = 0.f, hbin = 0.f;
#pragma unroll 16
            for (int c = c0; c < cidx; ++c) { const f32x2 a = *(const f32x2*)(AGG + ((size_t)(c * 2 + 0) * 256 + ch) * 2); hin = __builtin_amdgcn_exp2f(a[0]) * hin + a[1]; }
#pragma unroll 16
            for (int c = c1 - 1; c > cidx; --c) { const f32x2 a = *(const f32x2*)(AGG + ((size_t)(c * 2 + 1) * 256 + ch) * 2); hbin = __builtin_amdgcn_exp2f(a[0]) * hbin + a[1]; }
            gate_stage<0>(gbase, xcb, chb, tl, cg, sl, pba, pbx, par);
            float hf[64]; float h = hin;
#pragma unroll
            for (int t = 0; t < 64; ++t) { const h16x2 w = __builtin_bit_cast(h16x2, sl[t * SROW + lane]); h = __builtin_amdgcn_exp2f((float)w[0]) * h + (float)w[1]; hf[t] = h; }
            asm volatile("s_waitcnt lgkmcnt(0)" ::: "memory");
            gate_stage<1>(gbase, xcb, chb, tl, cg, sl, pba, pbx, par);
            h = hbin;
#pragma unroll
            for (int t = 63; t >= 0; --t) { const h16x2 w = __builtin_bit_cast(h16x2, sl[t * SROW + lane]); h = __builtin_amdgcn_exp2f((float)w[0]) * h + (float)w[1]; sl[t * SROW + lane] = __float_as_uint(hf[t] + h); }
            asm volatile("s_waitcnt lgkmcnt(0)" ::: "memory");
#pragma unroll
            for (int j = 0; j < 8; ++j) {
                const int t = 8 * j + tl; const size_t tok = (size_t)cidx * 64 + t;
                const LAS u32x4* src = (const LAS u32x4*)(sl + t * SROW + cg * 8); const u32x4 s0 = src[0], s1 = src[1];
                const u32x4 gw_ = *(const u32x4*)(P + tok * PROJW + 256 + chb);
                u32x4 o;
                o.x = pk2(gelu_tanh(bflo(gw_.x)) * __uint_as_float(s0.x), gelu_tanh(bfhi(gw_.x)) * __uint_as_float(s0.y));
                o.y = pk2(gelu_tanh(bflo(gw_.y)) * __uint_as_float(s0.z), gelu_tanh(bfhi(gw_.y)) * __uint_as_float(s0.w));
                o.z = pk2(gelu_tanh(bflo(gw_.z)) * __uint_as_float(s1.x), gelu_tanh(bfhi(gw_.z)) * __uint_as_float(s1.y));
                o.w = pk2(gelu_tanh(bflo(gw_.w)) * __uint_as_float(s1.z), gelu_tanh(bfhi(gw_.w)) * __uint_as_float(s1.w));
                *(u32x4*)(Y + tok * DM + chb) = o;
            }
            asm volatile("s_waitcnt lgkmcnt(0)" ::: "memory");
        }
    }
}
namespace att {
constexpr int KROW = 272, VROW = 320, KBUF = 32 * KROW, VBUF = 32 * VROW, LDS_K = 0, LDS_V = 2 * KBUF, LDS_Q = 2 * KBUF + 2 * VBUF;
static_assert(LDS_Q + 256 * KROW + 16 <= LDS_BYTES, "attention LDS");
typedef short v4i16_t __attribute__((ext_vector_type(4)));
DEV s16x4 vtr(const LAS unsigned char* p) { return __builtin_bit_cast(s16x4, __builtin_amdgcn_ds_read_tr16_b64_v4i16((LAS v4i16_t*)p)); }


DEV void attn_unit(const bf16* PROJ, bf16* YMIX, int tok0, int S, int head, int qb, float lam, float oscale, const float* subg, float Bnd, LAS unsigned char* lds) {
    int tid_ = threadIdx.x; asm volatile("" : "+v"(tid_));
    const int tid = tid_, lane = tid & 63, r32 = lane & 31, hi = lane >> 5, wid = __builtin_amdgcn_readfirstlane(tid >> 6);
    const int qpos = qb * 256 + wid * 32 + r32;
    LAS unsigned char* qlds = lds + LDS_Q + wid * 32 * KROW;
    { const bf16* qg = PROJ + (size_t)(tok0 + qb * 256 + wid * 32) * PROJW + 512 + head * 128;
#pragma unroll
      for (int i = 0; i < 8; ++i) { const int ch = lane + 64 * i, row = ch >> 4, c16 = ch & 15; const u32x4 v = *(const u32x4*)(qg + (size_t)row * PROJW + c16 * 8); *(LAS u32x4*)(qlds + row * KROW + c16 * 16) = v; } }
    const LAS unsigned char* qfb = qlds + r32 * KROW + hi * 16;
    const float sl2 = __builtin_amdgcn_exp2f(-2.f * (float)(head + 1)) * LOG2E;
    const int srow = tid >> 4, sc16 = tid & 15;
    const bf16* kg = PROJ + (size_t)(tok0 + srow) * PROJW + 1024 + head * 128 + sc16 * 8;
    const bf16* vg = kg + 512;
    LAS unsigned char* kst = lds + LDS_K + srow * KROW + sc16 * 16;
    LAS unsigned char* vst = lds + LDS_V + srow * VROW + sc16 * 16;
    const LAS unsigned char* kfb = lds + LDS_K + r32 * KROW + hi * 16;
    const int i16 = lane & 15, gq = i16 >> 2, gp = i16 & 3, g1 = (lane >> 4) & 1;
    const LAS unsigned char* vfb = lds + LDS_V + (4 * hi + gq) * VROW + (16 * g1 + 4 * gp) * 2;
    u32x4 kr0, vr0;
    { const size_t go0 = (size_t)(qb * 8) * 32 * PROJW; kr0 = *(const u32x4*)(kg + go0); vr0 = *(const u32x4*)(vg + go0); }
    *(LAS u32x4*)kst = kr0; *(LAS u32x4*)vst = vr0;
    __syncthreads();
    f32x16 O[2][4];
#pragma unroll
    for (int c = 0; c < 2; ++c)
#pragma unroll
        for (int d = 0; d < 4; ++d)
#pragma unroll
            for (int r = 0; r < 16; ++r) O[c][d][r] = 0.f;
    float mrun[2] = {-1e30f, -1e30f}, lrun[2] = {0.f, 0.f};
    const int ts = qb * 8, qw0 = qb * 256 + wid * 32;
    int t_lo = 0, t_hi = (S >> 5) - 1;
    { const float Df = (2.f * Bnd + 138.f) / sl2;     if (Df < (float)S) { const int D = (int)Df + 1; const int a_ = (qb * 256 - D) >> 5, b_ = (qb * 256 + 255 + D) >> 5; t_lo = a_ > 0 ? a_ : 0; t_hi = b_ < t_hi ? b_ : t_hi; } }
    const int NT = t_hi - t_lo + 1;
    f32x16 bcv; float csign = 1.f;
#pragma unroll
    for (int r = 0; r < 16; ++r) { float cr_ = (float)((r & 3) + 8 * (r >> 2)); asm volatile("" : "+v"(cr_)); bcv[r] = sl2 * cr_; }
    for (int i = 0; i < NT; ++i) {
        int t = ts + i; if (t > t_hi) t -= NT;
        int tn = t + 1; if (tn > t_hi) tn -= NT;
        const int cur = i & 1, k0 = t * 32;
        const LAS unsigned char* kb = kfb + cur * KBUF; const LAS unsigned char* vb = vfb + cur * VBUF;
        const float dqf = (float)(qpos - k0 - 4 * hi);
        const bool diag = (k0 == qw0);
        if (!diag) { const float want = (k0 < qw0) ? 1.f : -1.f;
            if (want != csign) { csign = want;
#pragma unroll
                for (int r = 0; r < 16; ++r) bcv[r] = -bcv[r]; } }
        const float lt = diag ? 0.f : -csign * sl2 * dqf;
        if (i + 1 < NT) { const size_t go = (size_t)tn * 32 * PROJW; kr0 = *(const u32x4*)(kg + go); vr0 = *(const u32x4*)(vg + go); }
        bf16x8 pf[2][2];
        f32x16 pp[2]; pp[0] = bcv; pp[1] = bcv;
#pragma unroll
        for (int c = 0; c < 2; ++c) {
            bf16x8 kf[4], qf[4];
#pragma unroll
            for (int ds = 0; ds < 4; ++ds) { kf[ds] = *(const LAS bf16x8*)(kb + (c * 64 + ds * 16) * 2); qf[ds] = *(const LAS bf16x8*)(qfb + (c * 64 + ds * 16) * 2); }
            __builtin_amdgcn_sched_barrier(0);
#pragma unroll
            for (int ds = 0; ds < 4; ++ds) pp[c] = __builtin_amdgcn_mfma_f32_32x32x16_bf16(kf[ds], qf[ds], pp[c], 0, 0, 0);
        }
        if (diag) {
#pragma unroll
            for (int r = 0; r < 16; ++r) { float cr = (float)((r & 3) + 8 * (r >> 2)); asm volatile("" : "+v"(cr)); const float fx = bcv[r] + sl2 * __builtin_fabsf(dqf - cr); pp[0][r] -= fx; pp[1][r] -= fx; }
        }
        float rm[2];
#pragma unroll
        for (int c = 0; c < 2; ++c) {
            float m_ = pp[c][0];
#pragma unroll
            for (int r = 1; r < 16; ++r) m_ = __builtin_fmaxf(m_, pp[c][r]);
            m_ += lt;
            auto rr = __builtin_amdgcn_permlane32_swap(__float_as_uint(m_), __float_as_uint(m_), false, false); rm[c] = __builtin_fmaxf(__uint_as_float(rr[0]), __uint_as_float(rr[1]));
        }
        if (__any(rm[0] > mrun[0] + 8.f || rm[1] > mrun[1] + 8.f)) {
#pragma unroll
            for (int c = 0; c < 2; ++c) {
                const float mnew = rm[c] > mrun[c] + 8.f ? rm[c] : mrun[c], alpha = __builtin_amdgcn_exp2f(mrun[c] - mnew);
                mrun[c] = mnew; lrun[c] *= alpha;
#pragma unroll
                for (int d = 0; d < 4; ++d)
#pragma unroll
                    for (int r = 0; r < 16; ++r) O[c][d][r] *= alpha;
            }
        }
#pragma unroll
        for (int c = 0; c < 2; ++c) {
            const float mm = mrun[c] - lt;
            float rs = 0.f;
#pragma unroll
            for (int r = 0; r < 16; ++r) { pp[c][r] = __builtin_amdgcn_exp2f(pp[c][r] - mm); rs += pp[c][r]; }
            lrun[c] += rs;
#pragma unroll
            for (int s = 0; s < 2; ++s) {
                u32x4 a;
                a.x = pk2(pp[c][8 * s + 0], pp[c][8 * s + 1]); a.y = pk2(pp[c][8 * s + 2], pp[c][8 * s + 3]); a.z = pk2(pp[c][8 * s + 4], pp[c][8 * s + 5]); a.w = pk2(pp[c][8 * s + 6], pp[c][8 * s + 7]);
                pf[c][s] = __builtin_bit_cast(bf16x8, a);
            }
        }
#pragma unroll
        for (int xs = 0; xs < 2; ++xs) { __builtin_amdgcn_sched_barrier(0);
            s16x4 vlo[4], vhi[4];
#pragma unroll
            for (int d = 0; d < 4; ++d) { vlo[d] = vtr(vb + (16 * xs) * VROW + d * 64); vhi[d] = vtr(vb + (16 * xs + 8) * VROW + d * 64); }
            __builtin_amdgcn_sched_barrier(0);
#pragma unroll
            for (int d = 0; d < 4; ++d) {
                const bf16x8 vf = {vlo[d][0], vlo[d][1], vlo[d][2], vlo[d][3], vhi[d][0], vhi[d][1], vhi[d][2], vhi[d][3]};
                O[0][d] = __builtin_amdgcn_mfma_f32_32x32x16_bf16(vf, pf[0][xs], O[0][d], 0, 0, 0);
                O[1][d] = __builtin_amdgcn_mfma_f32_32x32x16_bf16(vf, pf[1][xs], O[1][d], 0, 0, 0);
            }
        }
        if (i + 1 < NT) { const int nb = cur ^ 1; *(LAS u32x4*)(kst + nb * KBUF) = kr0; *(LAS u32x4*)(vst + nb * VBUF) = vr0; }
        __syncthreads();
    }
    const float l0 = lrun[0] + lane_xor(lrun[0], lane, 32), l1 = lrun[1] + lane_xor(lrun[1], lane, 32);
    const float i0 = 1.f / l0, i1 = lam / l1;
    float ss = 0.f;
#pragma unroll
    for (int d = 0; d < 4; ++d)
#pragma unroll
        for (int r = 0; r < 16; ++r) { const float o = O[0][d][r] * i0 - O[1][d][r] * i1; O[0][d][r] = o; ss += o * o; }
    ss += lane_xor(ss, lane, 32);
    const float rn = oscale / sqrtf(ss * (1.f / 128.f) + 1e-5f);
    bf16* yrow = YMIX + (size_t)(tok0 + qpos) * DM + 256 + head * 128;
#pragma unroll
    for (int d = 0; d < 4; ++d)
#pragma unroll
        for (int rg = 0; rg < 4; ++rg) { const int d0 = 32 * d + 8 * rg + 4 * hi; const f32x4 g4 = *(const f32x4*)(subg + d0);
            u32x2 w; w.x = pk2(O[0][d][4 * rg + 0] * rn * g4[0], O[0][d][4 * rg + 1] * rn * g4[1]); w.y = pk2(O[0][d][4 * rg + 2] * rn * g4[2], O[0][d][4 * rg + 3] * rn * g4[3]);
            *(u32x2*)(yrow + d0) = w; }
}
DEV void attn_phase(const Ctx& C, int l, LAS unsigned char* lds, int rep = 0) {
    const bf16* P = (const bf16*)(C.ws + WS_PROJ); bf16* Y = (bf16*)(C.ws + WS_YMIX);
    const float lam = ((const float*)(C.ws + WS_PAR))[1024 + l], li = ((const float*)(C.ws + WS_PAR))[1026 + l];
    const float* subg = C.in[19] + l * 128;
    const float* QN = (const float*)(C.ws + WS_NRM) + l * 320 * 8; const float* KN = (const float*)(C.ws + WS_NRM) + NRM_KN + l * 18 * 8;
    unsigned* qcnt = (unsigned*)(C.ws + WS_BAR) + 16 + 16 * l + 4 * rep;
    volatile LAS int* ubox = (volatile LAS int*)(lds + LDS_Q + 256 * KROW);
    for (;;) {
        if (C.tid == 0) ubox[0] = (int)__hip_atomic_fetch_add(qcnt, 1u, __ATOMIC_RELAXED, __HIP_MEMORY_SCOPE_AGENT);
        __syncthreads();
        const int u = ubox[0];
        if (u >= 1280) break;
        const int head = 3 - u / 320, r = u % 320;
        int tok0, S, qb, seq;
        if (r < 64) { seq = 16 + (r >> 5); qb = r & 31; tok0 = MP + (r >> 5) * SS; S = SS; }
        else { const int v = r - 64; seq = v >> 4; qb = v & 15; tok0 = seq * SP; S = SP; }
        const int blk = (tok0 >> 8) + qb;
        const float b0 = sqrtf(QN[blk * 8 + head * 2] * KN[seq * 8 + head * 2]), b1 = sqrtf(QN[blk * 8 + head * 2 + 1] * KN[seq * 8 + head * 2 + 1]);
        const float Bnd = 1.02f * fmaxf(b0, b1) + 0.5f;
        attn_unit(P, Y, tok0, S, head, qb, lam, 1.f - li, subg, Bnd, lds);
    }
}
}
DEV void grid_barrier(unsigned* bar, unsigned epoch, unsigned G) {
    asm volatile("s_waitcnt vmcnt(0)" ::: "memory");
    __syncthreads();
    if (threadIdx.x == 0) {
        __builtin_amdgcn_fence(__ATOMIC_RELEASE, "agent");
        asm volatile("s_waitcnt vmcnt(0)" ::: "memory");
        __hip_atomic_fetch_add(bar, 1u, __ATOMIC_RELAXED, __HIP_MEMORY_SCOPE_AGENT);
        const unsigned target = epoch * G;
        while (__hip_atomic_load(bar, __ATOMIC_RELAXED, __HIP_MEMORY_SCOPE_AGENT) < target) __builtin_amdgcn_s_sleep(2);
        __builtin_amdgcn_fence(__ATOMIC_ACQUIRE, "agent");
        asm volatile("s_waitcnt vmcnt(0)" ::: "memory");
    }
    __syncthreads();
}
#ifndef REP_ATT
#define REP_ATT 1
#endif
#ifndef REP_FFNUP
#define REP_FFNUP 1
#endif
#ifndef REP_DFT
#define REP_DFT 1
#endif
#ifndef REP_BAR
#define REP_BAR 1
#endif
#ifndef REP_FFNDN
#define REP_FFNDN 1
#endif
#ifndef REP_GATE
#define REP_GATE 1
#endif
#ifndef REP_OUT
#define REP_OUT 1
#endif
#ifndef REP_LN
#define REP_LN 1
#endif
#ifndef REP_PROJ
#define REP_PROJ 1
#endif
#ifndef REP_SCANA
#define REP_SCANA 1
#endif
#ifndef REP_SCANC
#define REP_SCANC 1
#endif
#ifndef REP_CONV
#define REP_CONV 1
#endif
#ifndef REP_BAR
#define REP_BAR 1
#endif
#ifndef REP_FFNDN
#define REP_FFNDN 1
#endif
#ifndef REP_GATE
#define REP_GATE 1
#endif
#ifndef REP_OUT
#define REP_OUT 1
#endif
#ifndef REP_LN
#define REP_LN 1
#endif
#ifndef REP_PRO
#define REP_PRO 1
#endif
struct Args { const float* in[21]; float* out; unsigned char* ws; int ph_lo, ph_hi; };
constexpr int NPHASES = 27;
__global__ void __launch_bounds__(512, 2) mk_fwd(Args a) {
    extern __shared__ __attribute__((aligned(16))) unsigned char lds_raw[];
    LAS unsigned char* lds = (LAS unsigned char*)lds_raw;
    cg::grid_group grid = cg::this_grid();
    Ctx C;
C.in = a.in; C.out = a.out; C.ws = a.ws; C.tid = threadIdx.x; C.lane = C.tid & 63; C.wave = __builtin_amdgcn_readfirstlane(C.tid >> 6); C.G = gridDim.x; C.bid = blockIdx.x;
    unsigned char* ws = a.ws;
    const int lo = a.ph_lo, hi = a.ph_hi;
    int ph = 0; unsigned epoch = 0;
#define PH_BEGIN if (ph >= lo && ph < hi) { { int t_ = threadIdx.x; asm volatile("" : "+v"(t_)); C.tid = t_; C.lane = t_ & 63; C.wave = __builtin_amdgcn_readfirstlane(t_ >> 6); size_t z_ = 0; asm volatile("" : "+s"(z_)); ws = a.ws + z_; C.ws = ws; C.out = a.out + z_;     int g_ = gridDim.x, b_ = blockIdx.x; asm volatile("" : "+s"(g_), "+s"(b_)); C.G = g_; C.bid = b_; }
#define PH_END   if (ph + 1 < hi) { for (int rb_ = 0; rb_ < REP_BAR; ++rb_) grid_barrier((unsigned*)(a.ws + WS_BAR), ++epoch, gridDim.x); } } ++ph;
#define XB ((bf16*)(ws + WS_XB))
#define H ((bf16*)(ws + WS_H))
#define PROJ ((bf16*)(ws + WS_PROJ))
#define YMIX ((bf16*)(ws + WS_YMIX))
    if (ph >= lo && ph < hi) { { int t_ = threadIdx.x; asm volatile("" : "+v"(t_)); C.tid = t_; C.lane = t_ & 63; C.wave = __builtin_amdgcn_readfirstlane(t_ >> 6); }
#ifndef NO_PRO
 for (int rep_ = 0; rep_ < REP_PRO; ++rep_) { phase_prologue(C, lds); __syncthreads(); }
#endif
 __syncthreads(); if (ph + 1 < hi) grid.sync(); } ++ph;
    for (int l = 0; l < 2; ++l) {
        for (int f = 0; f < 2; ++f) {
            if (f == 1) {
                PH_BEGIN
                { pg8::Gemm g{XB, (const bf16*)(ws + WS_WIN) + (size_t)l * 2048 * 1024, 1024, 1024, 1024, 0, 0}; pg8::StaticOrder S; S.init(MTOK, 2048, C.G, C.bid);
                  epi::Proj E{PROJ};
#ifndef NO_PROJ
 for (int rep_ = 0; rep_ < REP_PROJ; ++rep_) pg8::gemm_phase<epi::Proj, pg8::StaticOrder, true, true, 1024, 1024, 1024>(lds, g, S, E);
#endif
 }
                { pg8::Gemm g{(const bf16*)(ws + WS_WF) + (size_t)l * 512 * 1024, XB, 1024, 1024, 1024, 0, 0}; pg8::StaticOrder S; S.init(512, MTOK, C.G, C.bid);
                  epi::FT E{(bf16*)(ws + WS_BTF)};
#ifndef NO_FT
 for (int rep_ = 0; rep_ < REP_PROJ; ++rep_) pg8::gemm_phase<epi::FT, pg8::StaticOrder, true, true, 1024, 1024, 1024>(lds, g, S, E);
#endif
 }
                PH_END
                PH_BEGIN for (int rep_ = 0; rep_ < REP_CONV; ++rep_) phase_conv(C, l); PH_END
                PH_BEGIN
                { pg8::Gemm g{(const bf16*)(ws + WS_XC), (const bf16*)(ws + WS_WG) + (size_t)l * 1024 * 256, 256, 256, 256, 0, 0}; pg8::StaticOrder S; S.init(MTOK, 1024, C.G, C.bid);
                  epi::Raw E{(bf16*)(ws + WS_AU)};
#ifndef NO_GATE
 for (int rep_ = 0; rep_ < REP_GATE; ++rep_) pg8::gemm_phase<epi::Raw, pg8::StaticOrder, true, true, 256, 256, 256>(lds, g, S, E);
#endif
 }
                PH_END
                PH_BEGIN
#ifndef NO_SCANA
 for (int rep_ = 0; rep_ < REP_SCANA; ++rep_) phase_scan<false>(C, l, lds);
 __syncthreads();
#endif
                { pg8::Gemm g{(const bf16*)(ws + WS_DFT), (const bf16*)(ws + WS_BTF), 8192, 8192, 8192, 0, (size_t)256 * 8192}; epi::DftOrder S{C.G, C.bid};
                  epi::DFT E{YMIX, (float*)(ws + WS_PART), 0.001953125f  };
#ifndef NO_DFT
 for (int rep_ = 0; rep_ < REP_DFT; ++rep_) pg8::gemm_phase<epi::DFT, epi::DftOrder, true, true, 8192, 8192, 8192>(lds, g, S, E);
#endif
 }
#ifndef NO_ATT
 for (int rep_ = 0; rep_ < REP_ATT; ++rep_) att::attn_phase(C, l, lds, rep_);
#endif
 PH_END
                PH_BEGIN
phase_dft_combine(C);
#ifndef NO_SCANC
 for (int rep_ = 0; rep_ < REP_SCANC; ++rep_) phase_scan<true>(C, l, lds);
#endif
 PH_END
                PH_BEGIN
                { pg8::Gemm g{YMIX, (const bf16*)(ws + WS_WOUT) + (size_t)l * 1024 * 1024, 1024, 1024, 1024, 0, 0}; pg8::StaticOrder S; S.init(MTOK, 1024, C.G, C.bid); S.rev = 1;
                  epi::Resid E{C.out, 1.0f, (const float*)(ws + WS_STATS), C.in[2] + (l * 3 + 0) * 1024, C.in[3] + (l * 3 + 0) * 1024, C.out, C.out + (size_t)MP * DM};
#ifndef NO_OUT
 for (int rep_ = 1; rep_ < REP_OUT; ++rep_) { epi::Resid E0{C.out, 0.f, (const float*)(ws + WS_STATS), (const float*)(ws + WS_ONES), (const float*)(ws + WS_ONES) + 1024, C.out, C.out + (size_t)MP * DM, 1.f}; pg8::gemm_phase<epi::Resid, pg8::StaticOrder, true, true, 1024, 1024, 1024>(lds, g, S, E0); }
 pg8::gemm_phase<epi::Resid, pg8::StaticOrder, true, true, 1024, 1024, 1024>(lds, g, S, E);
#endif
 }
                PH_END
                PH_BEGIN for (int rep_ = 0; rep_ < REP_LN; ++rep_) phase_ln(C, C.in[2] + (l * 3 + 1) * 1024, C.in[3] + (l * 3 + 1) * 1024, false); PH_END
            }
            PH_BEGIN
            { pg8::Gemm g{XB, (const bf16*)(ws + WS_WGU) + (size_t)(l * 2 + f) * 5632 * 1024, 1024, 1024, 1024, 0, 0}; pg8::StaticOrder S; S.init(MTOK, 5632, C.G, C.bid);
              epi::SwiGLU E{H};
#ifndef NO_FFNUP
 for (int rep_ = 0; rep_ < REP_FFNUP; ++rep_) pg8::gemm_phase<epi::SwiGLU, pg8::StaticOrder, true, true, 1024, 1024, 1024>(lds, g, S, E);
#endif
 }
            PH_END
            PH_BEGIN
            { pg8::Gemm g{H, (const bf16*)(ws + WS_WD) + (size_t)(l * 2 + f) * 1024 * 2816, 2816, 2816, 2816, 0, 0}; pg8::StaticOrder S; S.init(MTOK, 1024, C.G, C.bid); S.rev = 1;
              const bool ident_ = (l == 0 && f == 0); const int pidx_ = f == 1 ? l * 3 + 1 : (l - 1) * 3 + 2;
              epi::Resid E{C.out, 0.5f, (const float*)(ws + WS_STATS), ident_ ? (const float*)(ws + WS_ONES) : C.in[2] + pidx_ * 1024, ident_ ? (const float*)(ws + WS_ONES) + 1024 : C.in[3] + pidx_ * 1024, ident_ ? C.in[0] : C.out, ident_ ? C.in[1] : C.out + (size_t)MP * DM};
#ifndef NO_FFNDN
 for (int rep_ = 1; rep_ < REP_FFNDN; ++rep_) { epi::Resid E0{C.out, 0.f, (const float*)(ws + WS_STATS), (const float*)(ws + WS_ONES), (const float*)(ws + WS_ONES) + 1024, C.out, C.out + (size_t)MP * DM, 1.f}; pg8::gemm_phase<epi::Resid, pg8::StaticOrder, true, true, 2816, 2816, 2816>(lds, g, S, E0); }
 pg8::gemm_phase<epi::Resid, pg8::StaticOrder, true, true, 2816, 2816, 2816>(lds, g, S, E);
#endif
 }
            PH_END
            PH_BEGIN for (int rep_ = 0; rep_ < ((l == 1 && f == 1) ? 1 : REP_LN); ++rep_) phase_ln(C, C.in[2] + (l * 3 + 2 * f) * 1024, C.in[3] + (l * 3 + 2 * f) * 1024, l == 1 && f == 1); PH_END
        }
    }
}

#ifndef MK_COOP
#define MK_COOP 1
#endif
extern "C" void kernel_launch(void* const* d_in, const int* in_sizes, int n_in, void* d_out, int out_size, void* d_ws, size_t ws_size, hipStream_t stream) {
    static int grid = 0;
    if (grid == 0) {
        if (n_in != 21 || out_size != MTOK * DM || ws_size < WS_END) { fprintf(stderr, "kernel_launch: unexpected shapes (n_in %d out %d ws %zu)\n", n_in, out_size, ws_size); grid = -1; return; }
        int dev = 0, cus = 0, per_cu = 0;
        hipGetDevice(&dev); hipDeviceGetAttribute(&cus, hipDeviceAttributeMultiprocessorCount, dev);
        hipFuncSetAttribute((const void*)mk_fwd, hipFuncAttributeMaxDynamicSharedMemorySize, LDS_BYTES);
        hipOccupancyMaxActiveBlocksPerMultiprocessor(&per_cu, (const void*)mk_fwd, 512, LDS_BYTES);
        (void)hipGetLastError();
        if (per_cu < 1) per_cu = 1;
        grid = cus;
    }
    if (grid < 0) return;
    if (MK_COOP) (void)hipMemsetAsync((char*)d_ws + WS_BAR, 0, 256, stream);
    Args a{};
    for (int i = 0; i < 21; ++i) a.in[i] = (const float*)d_in[i];
    a.out = (float*)d_out; a.ws = (unsigned char*)d_ws;
#if MK_COOP
    a.ph_lo = 0; a.ph_hi = NPHASES;
    void* args[] = {&a};
    hipError_t e = hipLaunchCooperativeKernel((const void*)mk_fwd, dim3(grid), dim3(512), args, LDS_BYTES, stream);
    if (e != hipSuccess) fprintf(stderr, "cooperative launch failed: %s (grid %d)\n", hipGetErrorString(e), grid);
#else
    for (int p = 0; p < NPHASES; ++p) { a.ph_lo = p; a.ph_hi = p + 1; hipLaunchKernelGGL(mk_fwd, dim3(grid), dim3(512), LDS_BYTES, stream, a); }
#endif
}
```

```cpp
#include <hip/hip_runtime.h>
#include <hip/hip_cooperative_groups.h>
#include <hip/hip_bf16.h>
#include <cstdio>
#include <cstdint>
#include <cmath>
namespace cg = cooperative_groups;
namespace pg8 {
#define PG8_LAS __attribute__((address_space(3)))
typedef unsigned short bf16_t;
typedef short bf16x8 __attribute__((ext_vector_type(8)));
typedef float f32x4 __attribute__((ext_vector_type(4)));
typedef unsigned u32x4 __attribute__((ext_vector_type(4)));
constexpr int BM = 256, BK = 64, HALF = 128, HTB = HALF * BK * 2  , STAGE_BYTES = 8 * HTB, NXCD = 8, WGM = 8;

__host__ __device__ __forceinline__ int lds_byte(int r, int c) { const int st = (r >> 4) * 2 + (c >> 5), rr = r & 15, cc = c & 31, ob = rr * 64 + cc * 2; return st * 1024 + (ob ^ (((ob >> 9) & 1) << 5)); }
__host__ __device__ __forceinline__ void stage_rc(int b, int& R, int& C) { const int st = b / 1024, sb = b % 1024, swz = sb ^ (((sb >> 9) & 1) << 5); R = (st >> 1) * 16 + swz / 64; C = (st & 1) * 32 + (swz % 64) / 2; }
__host__ __device__ __forceinline__ int perm32(int rho) { const int n = rho >> 4, i = rho & 15; return 8 * (i >> 2) + 4 * n + (i & 3); }

struct Unit { int pm, pn, z; };
struct Gemm { const bf16_t* A; const bf16_t* Bt; int K, lda, ldb; size_t zA, zB; };

struct StaticOrder {
    int nM, nN, nwg, G, c; int rev = 0;
    __host__ __device__ void init(int M, int N, int G_, int c_) { nM = M / BM; nN = N / BM; nwg = nM * nN; G = G_; c = c_; }
    __host__ __device__ bool next(int i, Unit& u) const {
        const long L = (long)i * G + c; if (L >= nwg) return false;
        int wgid = rev ? nwg - 1 - (int)L : (int)L; { const int q = nwg / NXCD, r = nwg % NXCD, xcd = wgid % NXCD, off = wgid / NXCD; wgid = (xcd < r ? xcd * (q + 1) : r * (q + 1) + (xcd - r) * q) + off; }
        const int nig = WGM * nN, gid = wgid / nig, fm = gid * WGM, gsz = (nM - fm) < WGM ? (nM - fm) : WGM;
        u.pm = fm + ((wgid % nig) % gsz); u.pn = (wgid % nig) / gsz; u.z = 0; return true;
    }
    __device__ __forceinline__ void a_ready(const Unit&) const {}
    __device__ __forceinline__ void done(const Unit&) const {}
};

__device__ __forceinline__ unsigned cvt_pk_bf16(float lo, float hi) { unsigned r; asm volatile("v_cvt_pk_bf16_f32 %0, %1, %2" : "=v"(r) : "v"(lo), "v"(hi)); return r; }
typedef float f32x2 __attribute__((ext_vector_type(2)));
__device__ __forceinline__ f32x2 gelu_pk(f32x2 v) {
    const f32x2 av = __builtin_elementwise_abs(v), d = av * 0.2316418882f + 1.0f;
    f32x2 t; t.x = __builtin_amdgcn_rcpf(d.x); t.y = __builtin_amdgcn_rcpf(d.y);
    f32x2 q = t * 0.5307027145f + (-0.7265760135f); q = q * t + 0.7107068705f; q = q * t + (-0.142248368f); q = q * t + 0.127414796f; q = q * t;
    const f32x2 s = (v * v) * (-0.72134752044f);
    f32x2 e; e.x = __builtin_amdgcn_exp2f(s.x); e.y = __builtin_amdgcn_exp2f(s.y);
    const f32x2 m = v * (q * e), r = v - m;
    f32x2 o; o.x = v.x < 0.f ? m.x : r.x; o.y = v.y < 0.f ? m.y : r.y; return o;
}

template <int ACT  > struct EpiBf16 {
    static constexpr bool PERM = true, AFTER_DRAIN = false; static_assert(ACT == 0 || ACT == 1, "EpiBf16: ACT is 0 (none) or 1 (gelu_pk)");
    bf16_t* O; int ldc; const float* bias; int split_cols; size_t split_stride; float scale0;
    __device__ __forceinline__ void operator()(const f32x4 (&acc)[2][2][4][2], const Unit& u, int wr, int wc, int fr, int fq) const {
        const int row0 = u.pm * BM + wr * 64 + fr; int colt = u.pn * BM; bf16_t* base = O;
        float sc = 1.f; if (split_cols) { const int t = colt / split_cols; base += (size_t)t * split_stride; colt -= t * split_cols; if (t == 0) sc = scale0; }
        const int col0 = colt + wc * 32 + 8 * fq, bcol0 = u.pn * BM + wc * 32 + 8 * fq;
        f32x4 bv[2][2];
#pragma unroll
        for (int bj = 0; bj < 2; ++bj)
#pragma unroll
            for (int n = 0; n < 2; ++n) bv[bj][n] = bias ? *(const f32x4*)(bias + bcol0 + bj * HALF + 4 * n) : (f32x4){0.f, 0.f, 0.f, 0.f};
#pragma unroll
        for (int ai = 0; ai < 2; ++ai)
#pragma unroll
            for (int m = 0; m < 4; ++m) { bf16_t* rowp = base + (size_t)(row0 + ai * HALF + m * 16) * ldc + col0;
#pragma unroll
                for (int bj = 0; bj < 2; ++bj) { f32x4 v0 = acc[ai][bj][m][0] + bv[bj][0], v1 = acc[ai][bj][m][1] + bv[bj][1];
                    if (ACT == 1) { f32x2 a = gelu_pk((f32x2){v0[0], v0[1]}), b = gelu_pk((f32x2){v0[2], v0[3]}), c = gelu_pk((f32x2){v1[0], v1[1]}), d = gelu_pk((f32x2){v1[2], v1[3]});
                        v0 = (f32x4){a.x, a.y, b.x, b.y}; v1 = (f32x4){c.x, c.y, d.x, d.y}; }
                    v0 = v0 * sc; v1 = v1 * sc; u32x4 w; w.x = cvt_pk_bf16(v0[0], v0[1]); w.y = cvt_pk_bf16(v0[2], v0[3]); w.z = cvt_pk_bf16(v1[0], v1[1]); w.w = cvt_pk_bf16(v1[2], v1[3]);
                    *(u32x4*)(rowp + bj * HALF) = w; } }
    }
};

template <class Epi, class Sched, bool ALIGN_EPI, bool SP2, int KK, int LDA, int LDB>
__device__ __forceinline__ void gemm_phase(PG8_LAS unsigned char* lds, const Gemm g, const Sched& S, const Epi& E) {
    int tid_ = threadIdx.x; asm volatile("" : "+v"(tid_));
    const int tid = tid_, wid = __builtin_amdgcn_readfirstlane(tid >> 6), lane = tid & 63, wr = wid >> 2, wc = wid & 3, fr = lane & 15, fq = lane >> 4;
    constexpr int K = KK, nt = K / BK;
    unsigned voffA[2], voffB[2];
#pragma unroll
    for (int i = 0; i < 2; ++i) { int R, C; stage_rc(tid * 16 + i * 8192, R, C); const int Rb = Epi::PERM ? ((R & ~31) + perm32(R & 31)) : R;
        voffA[i] = (unsigned)(R * LDA + C) * 2u; voffB[i] = (unsigned)(Rb * LDB + C) * 2u; }
    constexpr size_t kstep = (size_t)(BK * 2);
    constexpr size_t hstepA = (size_t)HALF * LDA * 2, hstepB = (size_t)HALF * LDB * 2;
    constexpr size_t tstepA = 2 * hstepA, tstepB = 2 * hstepB;
    const unsigned ldsw = (unsigned)wid * 1024u;
    const int aoff = lds_byte(wr * 64 + fr, fq * 8), boff = lds_byte(wc * 32 + fr, fq * 8);
#define PG8_SA(b, h) (((b) * 2 + (h)) * HTB)
#define PG8_SB(b, h) ((4 + (b) * 2 + (h)) * HTB)
#define PG8_STAGE(bufoff, gbase, voff) do { _Pragma("unroll") for (int _i = 0; _i < 2; ++_i) \
        __builtin_amdgcn_global_load_lds((const unsigned*)((const char*)(gbase) + (voff)[_i]), (PG8_LAS unsigned*)(lds + (bufoff) + ldsw + _i * 8192), 16, 0, 0); } while (0)
#define PG8_LDA(dst, b, h) do { _Pragma("unroll") for (int m = 0; m < 4; ++m) _Pragma("unroll") for (int k = 0; k < 2; ++k) dst[m][k] = *(const PG8_LAS bf16x8*)(lds + PG8_SA(b, h) + aoff + m * 2048 + k * 1024); } while (0)
#define PG8_LDB(dst, b, h) do { _Pragma("unroll") for (int n = 0; n < 2; ++n) _Pragma("unroll") for (int k = 0; k < 2; ++k) dst[n][k] = *(const PG8_LAS bf16x8*)(lds + PG8_SB(b, h) + boff + n * 2048 + k * 1024); } while (0)
#define PG8_MMA(ai, bj, At, Bt) do { __builtin_amdgcn_s_setprio(1); _Pragma("unroll") for (int m = 0; m < 4; ++m) _Pragma("unroll") for (int n = 0; n < 2; ++n) _Pragma("unroll") for (int k = 0; k < 2; ++k) \
        acc[ai][bj][m][n] = __builtin_amdgcn_mfma_f32_16x16x32_bf16(Bt[n][k], At[m][k], acc[ai][bj][m][n], 0, 0, 0); __builtin_amdgcn_s_setprio(0); } while (0)
#define PG8_WAIT_V(n) asm volatile("s_waitcnt vmcnt(" #n ")" ::: "memory")
#define PG8_WAIT_L(n) asm volatile("s_waitcnt lgkmcnt(" #n ")" ::: "memory")
#define PG8_BAR __builtin_amdgcn_s_barrier()
#define PG8_SCHED __builtin_amdgcn_sched_barrier(0)
    Unit cur, nxt; int ui = 0;
    if (!S.next(0, cur)) return;
    f32x4 acc[2][2][4][2];
#pragma unroll
    for (int a = 0; a < 2; ++a)
#pragma unroll
        for (int b = 0; b < 2; ++b)
#pragma unroll
            for (int m = 0; m < 4; ++m)
#pragma unroll
                for (int n = 0; n < 2; ++n) acc[a][b][m][n] = (f32x4){0.f, 0.f, 0.f, 0.f};
    bf16x8 At[4][2], B0[2][2], B1[2][2];
    const char* cA = (const char*)g.A + (size_t)cur.z * g.zA * 2 + (size_t)cur.pm * tstepA; const char* cB = (const char*)g.Bt + (size_t)cur.z * g.zB * 2 + (size_t)cur.pn * tstepB;
    S.a_ready(cur);
    if constexpr (SP2) {
        PG8_STAGE(PG8_SB(0, 0), cB, voffB); PG8_STAGE(PG8_SB(0, 1), cB + hstepB, voffB); PG8_STAGE(PG8_SA(0, 0), cA, voffA); PG8_STAGE(PG8_SA(0, 1), cA + hstepA, voffA);
        if (wr == 1) PG8_BAR;
        PG8_WAIT_V(2); PG8_BAR;
        PG8_STAGE(PG8_SB(1, 0), cB + kstep, voffB); PG8_STAGE(PG8_SA(1, 0), cA + kstep, voffA); PG8_STAGE(PG8_SB(1, 1), cB + hstepB + kstep, voffB);
        PG8_WAIT_V(6); PG8_BAR;
    } else {
        PG8_STAGE(PG8_SB(0, 0), cB, voffB); PG8_STAGE(PG8_SA(0, 0), cA, voffA); PG8_STAGE(PG8_SB(0, 1), cB + hstepB, voffB); PG8_STAGE(PG8_SA(0, 1), cA + hstepA, voffA);
        if (wr == 1) PG8_BAR;
        PG8_WAIT_V(4); PG8_BAR;
        PG8_STAGE(PG8_SB(1, 0), cB + kstep, voffB); PG8_STAGE(PG8_SA(1, 0), cA + kstep, voffA); PG8_STAGE(PG8_SB(1, 1), cB + hstepB + kstep, voffB);
        PG8_WAIT_V(6); PG8_BAR;
    }
    for (;;) {
        const bool has_next = S.next(ui + 1, nxt);
        const char* nA = has_next ? (const char*)g.A + (size_t)nxt.z * g.zA * 2 + (size_t)nxt.pm * tstepA : cA; const char* nB = has_next ? (const char*)g.Bt + (size_t)nxt.z * g.zB * 2 + (size_t)nxt.pn * tstepB : cB;
        for (int t = 0; t < nt; t += 2) {
            const bool last = (t == nt - 2);
            const char* a1 = cA + (size_t)(t + 1) * kstep;
            const char* a2 = last ? nA : cA + (size_t)(t + 2) * kstep; const char* b2 = last ? nB : cB + (size_t)(t + 2) * kstep;
            const char* a3 = a2 + kstep; const char* b3 = b2 + kstep;
            if (last && has_next) S.a_ready(nxt);
            if constexpr (SP2) {
            PG8_LDB(B0, 0, 0); PG8_LDB(B1, 0, 1); PG8_SCHED; PG8_LDA(At, 0, 0); PG8_STAGE(PG8_SA(1, 1), a1 + hstepA, voffA);
            PG8_WAIT_V(8); PG8_WAIT_L(0); PG8_BAR; PG8_MMA(0, 0, At, B0); PG8_MMA(0, 1, At, B1); PG8_BAR; PG8_SCHED;
            PG8_LDA(At, 0, 1); PG8_STAGE(PG8_SB(0, 0), b2, voffB); PG8_STAGE(PG8_SB(0, 1), b2 + hstepB, voffB); PG8_STAGE(PG8_SA(0, 0), a2, voffA);
            PG8_WAIT_V(8); PG8_WAIT_L(0); PG8_BAR; PG8_MMA(1, 0, At, B0); PG8_MMA(1, 1, At, B1); PG8_BAR; PG8_SCHED;
            PG8_LDB(B0, 1, 0); PG8_LDB(B1, 1, 1); PG8_SCHED; PG8_LDA(At, 1, 0); PG8_STAGE(PG8_SA(0, 1), a2 + hstepA, voffA);
            PG8_WAIT_V(8); PG8_WAIT_L(0); PG8_BAR; PG8_MMA(0, 0, At, B0); PG8_MMA(0, 1, At, B1); PG8_BAR; PG8_SCHED;
            PG8_LDA(At, 1, 1); PG8_STAGE(PG8_SB(1, 0), b3, voffB); PG8_STAGE(PG8_SB(1, 1), b3 + hstepB, voffB); PG8_STAGE(PG8_SA(1, 0), a3, voffA);
            PG8_WAIT_V(8); PG8_WAIT_L(0); PG8_BAR; PG8_MMA(1, 0, At, B0); PG8_MMA(1, 1, At, B1); PG8_BAR; PG8_SCHED;
            } else {
            PG8_LDB(B0, 0, 0); PG8_SCHED; PG8_LDA(At, 0, 0); PG8_STAGE(PG8_SA(1, 1), a1 + hstepA, voffA);
            PG8_WAIT_L(8); PG8_BAR; PG8_WAIT_L(0); PG8_MMA(0, 0, At, B0); PG8_BAR; PG8_SCHED;
            PG8_LDB(B1, 0, 1); PG8_STAGE(PG8_SB(0, 0), b2, voffB);
            PG8_BAR; PG8_WAIT_L(0); PG8_MMA(0, 1, At, B1); PG8_BAR;
            PG8_LDA(At, 0, 1); PG8_STAGE(PG8_SA(0, 0), a2, voffA);
            PG8_BAR; PG8_WAIT_L(0); PG8_MMA(1, 0, At, B0); PG8_BAR; PG8_SCHED;
            PG8_STAGE(PG8_SB(0, 1), b2 + hstepB, voffB);
            PG8_WAIT_V(6); PG8_BAR; PG8_MMA(1, 1, At, B1); PG8_BAR;
            PG8_LDB(B0, 1, 0); PG8_SCHED; PG8_LDA(At, 1, 0); PG8_STAGE(PG8_SA(0, 1), a2 + hstepA, voffA);
            PG8_WAIT_L(8); PG8_BAR; PG8_WAIT_L(0); PG8_MMA(0, 0, At, B0); PG8_BAR; PG8_SCHED;
            PG8_LDB(B1, 1, 1); PG8_STAGE(PG8_SB(1, 0), b3, voffB);
            PG8_BAR; PG8_WAIT_L(0); PG8_MMA(0, 1, At, B1); PG8_BAR;
            PG8_LDA(At, 1, 1); PG8_STAGE(PG8_SA(1, 0), a3, voffA);
            PG8_BAR; PG8_WAIT_L(0); PG8_MMA(1, 0, At, B0); PG8_BAR; PG8_SCHED;
            PG8_STAGE(PG8_SB(1, 1), b3 + hstepB, voffB);
            PG8_WAIT_V(6); PG8_BAR; PG8_MMA(1, 1, At, B1); PG8_BAR;
            }
        }
        if constexpr (ALIGN_EPI) { if (wr == 0) PG8_BAR; }
        if constexpr (!Epi::AFTER_DRAIN) { E(acc, cur, wr, wc, fr, fq); S.done(cur); }
        if (!has_next) break;
#pragma unroll
        for (int a = 0; a < 2; ++a)
#pragma unroll
            for (int b = 0; b < 2; ++b)
#pragma unroll
                for (int m = 0; m < 4; ++m)
#pragma unroll
                    for (int n = 0; n < 2; ++n) acc[a][b][m][n] = (f32x4){0.f, 0.f, 0.f, 0.f};
        cur = nxt; cA = nA; cB = nB; ++ui;
        if constexpr (ALIGN_EPI) { if (wr == 1) PG8_BAR; }
    }
    PG8_WAIT_V(0);
    if constexpr (!ALIGN_EPI) { if (wr == 0) PG8_BAR; }
    PG8_BAR;
    if constexpr (Epi::AFTER_DRAIN) { E.fused(acc, cur, wr, wc, fr, fq, lds, wid, lane); S.done(cur); }
#undef PG8_SA
#undef PG8_SB
#undef PG8_STAGE
#undef PG8_LDA
#undef PG8_LDB
#undef PG8_MMA
#undef PG8_WAIT_V
#undef PG8_WAIT_L
#undef PG8_BAR
#undef PG8_SCHED
}
}
#define DEV __device__ __forceinline__
#define LAS __attribute__((address_space(3)))
typedef unsigned short bf16;
typedef float f32x4 __attribute__((ext_vector_type(4)));
typedef float f32x2 __attribute__((ext_vector_type(2)));
typedef float f32x16 __attribute__((ext_vector_type(16)));
typedef unsigned u32x4 __attribute__((ext_vector_type(4)));
typedef unsigned u32x2 __attribute__((ext_vector_type(2)));
typedef short bf16x8 __attribute__((ext_vector_type(8)));
typedef short s16x4 __attribute__((ext_vector_type(4)));
typedef __bf16 bf16x2_t __attribute__((ext_vector_type(2)));

constexpr int DM = 1024, DFF = 2816, MTOK = 81920, MP = 65536, SP = 4096, SS = 8192;
constexpr int PROJW = 2048;
constexpr float LOG2E = 1.4426950408889634f;
constexpr float QSCALE = 0.125f * LOG2E;
constexpr float ALPHA = 1.4142135623730951f;
constexpr size_t MiB = 1u << 20;
constexpr size_t WS_PAR = 0;
constexpr size_t WS_NRM = 256 * 1024;
constexpr int NRM_KN = 2 * 320 * 8;
constexpr size_t WS_BAR = 512 * 1024;
constexpr size_t WS_WGU = 1 * MiB;
constexpr size_t WS_WD = 45 * MiB;
constexpr size_t WS_WIN = 67 * MiB;
constexpr size_t WS_WF = 75 * MiB;
constexpr size_t WS_WOUT = 77 * MiB;
constexpr size_t WS_WG = 81 * MiB;
constexpr size_t WS_DFT = 82 * MiB;
constexpr size_t WS_AGG = 210 * MiB;
constexpr size_t WS_STATS = 215 * MiB;
constexpr size_t WS_ONES = WS_STATS + 768 * 1024;
constexpr size_t WS_PROJ = 216 * MiB;
constexpr size_t WS_BTF = 536 * MiB;
constexpr size_t WS_XC = 632 * MiB;
constexpr size_t WS_YMIX = 672 * MiB;
constexpr size_t WS_AU = 832 * MiB;
constexpr size_t WS_XB = WS_AU;
constexpr size_t WS_H = WS_PROJ;
constexpr size_t WS_PART = 992 * MiB;
constexpr size_t WS_END = 1008 * MiB;
static_assert(WS_H + (size_t)MTOK * DFF * 2 <= WS_YMIX, "H overlay");
constexpr int LDS_BYTES = 147456;

DEV unsigned pk2(float lo, float hi) { f32x2 v = {lo, hi}; bf16x2_t b = __builtin_convertvector(v, bf16x2_t); return __builtin_bit_cast(unsigned, b); }
DEV float bf2f(unsigned short b) { return __uint_as_float((unsigned)b << 16); }
DEV float bflo(unsigned w) { return __uint_as_float(w << 16); }
DEV float bfhi(unsigned w) { return __uint_as_float(w & 0xffff0000u); }
DEV float lane_xor(float v, int lane, int o) { return __int_as_float(__builtin_amdgcn_ds_bpermute((lane ^ o) << 2, __float_as_int(v))); }
DEV float wave_sum(float v, int lane) {
#pragma unroll
    for (int o = 1; o < 64; o <<= 1) v += lane_xor(v, lane, o);
    return v;
}
DEV float sigmoidf_(float x) { return __builtin_amdgcn_rcpf(1.f + __builtin_amdgcn_exp2f(-LOG2E * x)); }

namespace epi {
using pg8::Unit; using pg8::HALF; using pg8::BM;
struct SwiGLU {
    static constexpr bool PERM = true, AFTER_DRAIN = false;
    bf16* H;
    DEV void operator()(const f32x4 (&acc)[2][2][4][2], const Unit& u, int wr, int wc, int fr_, int fq_) const {
        int t__ = threadIdx.x; asm volatile("" : "+v"(t__)); const int fr = t__ & 15, fq = (t__ >> 4) & 3; (void)fr_; (void)fq_;
        const int col0 = u.pn * 128 + wc * 32 + 8 * fq;
#pragma unroll
        for (int ai = 0; ai < 2; ++ai)
#pragma unroll
            for (int m = 0; m < 4; ++m) {
                const int row = u.pm * BM + ai * HALF + wr * 64 + m * 16 + fr;
                float o[8];
#pragma unroll
                for (int n = 0; n < 2; ++n)
#pragma unroll
                    for (int e = 0; e < 4; ++e) { const float g = acc[ai][0][m][n][e], up = acc[ai][1][m][n][e]; o[4 * n + e] = g * sigmoidf_(g) * up; }
                u32x4 w; w.x = pk2(o[0], o[1]); w.y = pk2(o[2], o[3]); w.z = pk2(o[4], o[5]); w.w = pk2(o[6], o[7]);
                *(u32x4*)(H + (size_t)row * DFF + col0) = w; asm volatile("" ::: "memory");
            }
    }
};
struct Resid {
    static constexpr bool PERM = true, AFTER_DRAIN = false;
    float* X; float s; const float* stats; const float* g; const float* b; const float* r0; const float* r1; float al = ALPHA;
    DEV void operator()(const f32x4 (&acc)[2][2][4][2], const Unit& u, int wr, int wc, int fr_, int fq_) const {
        int t__ = threadIdx.x; asm volatile("" : "+v"(t__)); const int fr = t__ & 15, fq = (t__ >> 4) & 3; (void)fr_; (void)fq_;
        const int colb = u.pn * BM + wc * 32 + 8 * fq;
        const float* rsrc = (u.pm * BM < MP) ? r0 : r1 - (size_t)MP * DM;
        f32x4 gv[2][2], bv[2][2];
#pragma unroll
        for (int bj = 0; bj < 2; ++bj)
#pragma unroll
            for (int n = 0; n < 2; ++n) { gv[bj][n] = *(const f32x4*)(g + colb + bj * HALF + n * 4); bv[bj][n] = *(const f32x4*)(b + colb + bj * HALF + n * 4); }
#pragma unroll
        for (int ai = 0; ai < 2; ++ai)
#pragma unroll
            for (int m = 0; m < 4; ++m) {
                const size_t row = (size_t)(u.pm * BM + ai * HALF + wr * 64 + m * 16 + fr);
                const f32x2 st = *(const f32x2*)(stats + row * 2);
                float* rp = X + row * DM + colb; const float* rq = rsrc + row * DM + colb;
#pragma unroll
                for (int bj = 0; bj < 2; ++bj)
#pragma unroll
                    for (int n = 0; n < 2; ++n) { f32x4* p = (f32x4*)(rp + bj * HALF + n * 4); const f32x4 yv = *(const f32x4*)(rq + bj * HALF + n * 4); const f32x4 x = ((yv - st[0]) * st[1]) * gv[bj][n] + bv[bj][n]; *p = x * al + acc[ai][bj][m][n] * s; }
                asm volatile("" ::: "memory");
            }
    }
};
struct Proj {
    static constexpr bool PERM = true, AFTER_DRAIN = false;
    bf16* P;
    DEV void operator()(const f32x4 (&acc)[2][2][4][2], const Unit& u, int wr, int wc, int fr_, int fq_) const {
        int t__ = threadIdx.x; asm volatile("" : "+v"(t__)); const int fr = t__ & 15, fq = (t__ >> 4) & 3; (void)fr_; (void)fq_;
        const float sc = (u.pn == 2 || u.pn == 3) ? QSCALE : 1.f;
        const int col0 = u.pn * BM + wc * 32 + 8 * fq;
#pragma unroll
        for (int ai = 0; ai < 2; ++ai)
#pragma unroll
            for (int m = 0; m < 4; ++m) {
                bf16* rp = P + (size_t)(u.pm * BM + ai * HALF + wr * 64 + m * 16 + fr) * PROJW + col0;
#pragma unroll
                for (int bj = 0; bj < 2; ++bj) { const f32x4 v0 = acc[ai][bj][m][0] * sc, v1 = acc[ai][bj][m][1] * sc;
                    u32x4 w; w.x = pk2(v0[0], v0[1]); w.y = pk2(v0[2], v0[3]); w.z = pk2(v1[0], v1[1]); w.w = pk2(v1[2], v1[3]);
                    *(u32x4*)(rp + bj * HALF) = w; }
                asm volatile("" ::: "memory");
            }
    }
};
struct FT {
    static constexpr bool PERM = true, AFTER_DRAIN = false;
    bf16* BP;
    DEV void operator()(const f32x4 (&acc)[2][2][4][2], const Unit& u, int wr, int wc, int fr_, int fq_) const {
        int t__ = threadIdx.x; asm volatile("" : "+v"(t__)); const int fr = t__ & 15, fq = (t__ >> 4) & 3; (void)fr_; (void)fq_;
        const int which = u.pm;
#pragma unroll
        for (int ai = 0; ai < 2; ++ai)
#pragma unroll
            for (int m = 0; m < 4; ++m) {
                const int n = ai * HALF + wr * 64 + m * 16 + fr;
#pragma unroll
                for (int bj = 0; bj < 2; ++bj) {
                    const int t0 = u.pn * BM + bj * HALF + wc * 32 + 8 * fq;
                    const f32x4 v0 = acc[ai][bj][m][0], v1 = acc[ai][bj][m][1];
                    if (t0 < MP) {
                        const int seq = t0 >> 12, s = t0 & 4095;
                        u32x4 w; w.x = pk2(v0[0], v0[1]); w.y = pk2(v0[2], v0[3]); w.z = pk2(v1[0], v1[1]); w.w = pk2(v1[2], v1[3]);
                        *(u32x4*)(BP + ((size_t)seq * 256 + n) * 8192 + which * 4096 + s) = w;
                    } else {
                        const int tt = t0 - MP, seq2 = tt >> 13, s = tt & 8191;
                        u32x2 ev, od; ev.x = pk2(v0[0], v0[2]); ev.y = pk2(v1[0], v1[2]); od.x = pk2(v0[1], v0[3]); od.y = pk2(v1[1], v1[3]);
                        bf16* be = BP + ((size_t)(16 + seq2 * 2) * 256 + n) * 8192 + which * 4096 + (s >> 1);
                        *(u32x2*)be = ev; *(u32x2*)(be + (size_t)256 * 8192) = od;
                    }
                }
                asm volatile("" ::: "memory");
            }
    }
};
struct DFT {
    static constexpr bool PERM = true, AFTER_DRAIN = false;
    bf16* Y; float* PART; float scale;
    DEV void operator()(const f32x4 (&acc)[2][2][4][2], const Unit& u, int wr, int wc, int fr_, int fq_) const {
        int t__ = threadIdx.x; asm volatile("" : "+v"(t__)); const int fr = t__ & 15, fq = (t__ >> 4) & 3; (void)fr_; (void)fq_;
        const int col0 = wc * 32 + 8 * fq;
        if (u.z < 16) {
#pragma unroll
            for (int ai = 0; ai < 2; ++ai)
#pragma unroll
                for (int m = 0; m < 4; ++m) {
                    bf16* rp = Y + (size_t)(u.z * SP + u.pm * BM + ai * HALF + wr * 64 + m * 16 + fr) * DM + 768 + col0;
#pragma unroll
                    for (int bj = 0; bj < 2; ++bj) { const f32x4 v0 = acc[ai][bj][m][0] * scale, v1 = acc[ai][bj][m][1] * scale;
                        u32x4 w; w.x = pk2(v0[0], v0[1]); w.y = pk2(v0[2], v0[3]); w.z = pk2(v1[0], v1[1]); w.w = pk2(v1[2], v1[3]);
                        *(u32x4*)(rp + bj * HALF) = w; }
                    asm volatile("" ::: "memory");
                }
        } else {
#pragma unroll
            for (int ai = 0; ai < 2; ++ai)
#pragma unroll
                for (int m = 0; m < 4; ++m) {
                    float* rp = PART + ((size_t)(u.z - 16) * 4096 + (u.pm & 15) * BM + ai * HALF + wr * 64 + m * 16 + fr) * 256 + col0;
#pragma unroll
                    for (int bj = 0; bj < 2; ++bj) { *(f32x4*)(rp + bj * HALF) = acc[ai][bj][m][0]; *(f32x4*)(rp + bj * HALF + 4) = acc[ai][bj][m][1]; }
                    asm volatile("" ::: "memory");
                }
        }
    }
};
struct DftOrder {
    int G, c;
    DEV bool next(int i, Unit& u) const { const int L = i * G + c; if (L >= 320) return false; u.pn = 0;
        if (L < 288) { const int pmA = L / 18, zi = L - pmA * 18; u.pm = pmA; u.z = zi < 16 ? zi : 16 + 2 * (zi - 16); }
        else { const int L2 = L - 288; u.pm = 16 + (L2 >> 1); u.z = 17 + 2 * (L2 & 1); }
        return true; }
    DEV void a_ready(const Unit&) const {}
    DEV void done(const Unit&) const {}
};
struct Raw {
    static constexpr bool PERM = true, AFTER_DRAIN = false;
    bf16* P;
    DEV void operator()(const f32x4 (&acc)[2][2][4][2], const Unit& u, int wr, int wc, int fr_, int fq_) const {
        int t__ = threadIdx.x; asm volatile("" : "+v"(t__)); const int fr = t__ & 15, fq = (t__ >> 4) & 3; (void)fr_; (void)fq_;
        const int col0 = u.pn * BM + wc * 32 + 8 * fq;
#pragma unroll
        for (int ai = 0; ai < 2; ++ai)
#pragma unroll
            for (int m = 0; m < 4; ++m) {
                bf16* rp = P + (size_t)(u.pm * BM + ai * HALF + wr * 64 + m * 16 + fr) * 1024 + col0;
#pragma unroll
                for (int bj = 0; bj < 2; ++bj) { const f32x4 v0 = acc[ai][bj][m][0], v1 = acc[ai][bj][m][1];
                    u32x4 w; w.x = pk2(v0[0], v0[1]); w.y = pk2(v0[2], v0[3]); w.z = pk2(v1[0], v1[1]); w.w = pk2(v1[2], v1[3]);
                    *(u32x4*)(rp + bj * HALF) = w; }
                asm volatile("" ::: "memory");
            }
    }
};
struct BatchOrder {
    int lz, nM, G, c;
    DEV bool next(int i, Unit& u) const { const int L = i * G + c; if (L >= (nM << lz)) return false; u.pm = L >> lz; u.z = L & ((1 << lz) - 1); u.pn = 0; return true; }
    DEV void a_ready(const Unit&) const {}
    DEV void done(const Unit&) const {}
};
}
struct Ctx {
    const float* const* in; float* out; unsigned char* ws;
    int tid, lane, wave, G, bid;
};
#ifndef RPA
#define RPA 1
#endif
#ifndef RPB
#define RPB 1
#endif
#ifndef RPE
#define RPE 1
#endif
#ifndef RPF
#define RPF 1
#endif
DEV void transpose_item(const float* W, int ldw, int srccol0, bf16* WT, int ldo, int dstrow0, int k0, LAS float* scr, int lane) {
#pragma unroll 8
    for (int i = 0; i < 32; ++i) { const int kk = 2 * i + (lane >> 5); scr[kk * 33 + (lane & 31)] = W[(size_t)(k0 + kk) * ldw + srccol0 + (lane & 31)]; }
    asm volatile("s_waitcnt lgkmcnt(0)" ::: "memory");
    const int c = lane & 7;
#pragma unroll
    for (int j = 0; j < 4; ++j) { const int n = (lane >> 3) + 8 * j; const LAS float* s = scr + (8 * c) * 33 + n;
        u32x4 o; o.x = pk2(s[0 * 33], s[1 * 33]); o.y = pk2(s[2 * 33], s[3 * 33]); o.z = pk2(s[4 * 33], s[5 * 33]); o.w = pk2(s[6 * 33], s[7 * 33]);
        *(u32x4*)(WT + (size_t)(dstrow0 + n) * ldo + k0 + 8 * c) = o; }
    asm volatile("s_waitcnt lgkmcnt(0)" ::: "memory");
}
DEV void phase_prologue(const Ctx& C, LAS unsigned char* lds) {
    const int gw = C.bid * 8 + C.wave, NGW = C.G * 8;
    const long gt = (long)C.bid * 512 + C.tid, NGT = (long)C.G * 512;
    unsigned char* ws = C.ws;
for (int rp_ = 0; rp_ < RPA; ++rp_) {
    {
        LAS float* scr = (LAS float*)(lds + C.wave * 16384);
        for (int it = gw; it < 2 * 9984; it += NGW) {
            const int l = it / 9984, r = it % 9984; int j, q;
            if (r < 8448) { j = r / 1408; q = r % 1408; } else if (r < 9472) { j = 6; q = r - 8448; } else { j = 7; q = r - 9472; }
            const float* src; int ldw, K, N; bf16* dst; int inter = 0, ioff = 0;
            if (j == 0 || j == 1 || j == 3 || j == 4) { const int f = j >= 3; const int up = (j == 1 || j == 4);
                src = C.in[(f ? 7 : 4) + up] + (size_t)l * DM * DFF; ldw = DFF; K = DM; N = DFF; dst = (bf16*)(ws + WS_WGU) + (size_t)(l * 2 + f) * 5632 * 1024; inter = 1; ioff = up ? 128 : 0; }
            else if (j == 2 || j == 5) { const int f = j == 5; src = C.in[f ? 9 : 6] + (size_t)l * DFF * DM; ldw = DM; K = DFF; N = DM; dst = (bf16*)(ws + WS_WD) + (size_t)(l * 2 + f) * 1024 * 2816; }
            else if (j == 6) { src = C.in[10] + (size_t)l * DM * 2304; ldw = 2304; K = DM; N = 2048; dst = (bf16*)(ws + WS_WIN) + (size_t)l * 2048 * 1024; }
            else { src = C.in[20] + (size_t)l * DM * DM; ldw = DM; K = DM; N = DM; dst = (bf16*)(ws + WS_WOUT) + (size_t)l * 1024 * 1024; }
            const int nblk = N / 32, kb = q / nblk, nb = q % nblk, n0 = 32 * nb;
            const int drow = inter ? (256 * (n0 >> 7) + (n0 & 127) + ioff) : n0;
            transpose_item(src, ldw, n0, dst, K, drow, 64 * kb, scr, C.lane);
        }
    }
}
    for (int rp_ = 0; rp_ < RPB; ++rp_) {
    {
        LAS float* tw = (LAS float*)(lds + 8 * 16384);
        if (C.tid < 64) { float sn, cs; sincospif((float)C.tid * (1.0f / 32.0f), &sn, &cs); tw[C.tid] = cs; tw[64 + C.tid] = sn; }
        __syncthreads();
        for (long it = gt; it < 2L * 512 * 128; it += NGT) {
            const int l = (int)(it / (512 * 128)), r = (int)(it % (512 * 128)), nrow = r >> 7, k0 = (r & 127) * 8;
            const int which = nrow >> 8, g = (nrow >> 6) & 3, cp = nrow & 63;
            const float* wsrc = C.in[10] + (size_t)l * DM * 2304 + 2048 + 64 * g;
            float o[8];
#pragma unroll
            for (int kk = 0; kk < 8; ++kk) {
                const float* wr_ = wsrc + (size_t)(k0 + kk) * 2304; float a = 0.f;
                for (int c = 0; c < 64; c += 4) { const f32x4 w4 = *(const f32x4*)(wr_ + c);
                    a += w4[0] * tw[which * 64 + (((c + 0) * cp) & 63)] + w4[1] * tw[which * 64 + (((c + 1) * cp) & 63)] + w4[2] * tw[which * 64 + (((c + 2) * cp) & 63)] + w4[3] * tw[which * 64 + (((c + 3) * cp) & 63)]; }
                o[kk] = a;
            }
            u32x4 w; w.x = pk2(o[0], o[1]); w.y = pk2(o[2], o[3]); w.z = pk2(o[4], o[5]); w.w = pk2(o[6], o[7]);
            *(u32x4*)((bf16*)(ws + WS_WF) + ((size_t)l * 512 + nrow) * 1024 + k0) = w;
        }
    }
}
    for (long it = gt; it < 2L * 1024 * 32; it += NGT) {
        const int l = (int)(it / (1024 * 32)), r = (int)(it % (1024 * 32)), n = r >> 5, k0 = (r & 31) * 8;
        const int tn = n >> 8, dir = tn >> 1, chh = tn & 1, within = n & 255, gate = within >> 7, ch = chh * 128 + (within & 127), hb = ch >> 6, jj = ch & 63;
        u32x4 w = {0u, 0u, 0u, 0u};
        if ((k0 >> 6) == hb) {
            const float* src = C.in[gate ? 15 : 13] + ((size_t)((l * 2 + dir) * 4 + hb) * 64) * 64 + jj;
            float o[8];
#pragma unroll
            for (int kk = 0; kk < 8; ++kk) o[kk] = src[(size_t)((k0 & 63) + kk) * 64];
            w.x = pk2(o[0], o[1]); w.y = pk2(o[2], o[3]); w.z = pk2(o[4], o[5]); w.w = pk2(o[6], o[7]);
        }
        *(u32x4*)((bf16*)(ws + WS_WG) + ((size_t)l * 1024 + n) * 256 + k0) = w;
    }
    if (gt < 1024) { const float lam = C.in[17][gt]; ((float*)(ws + WS_PAR))[gt] = 8.f * log1pf(expf(-lam)); }
    if (gt >= 1024 && gt < 1026) { const int l = (int)gt - 1024; const float* lq = C.in[18] + l * 256; float s1 = 0.f, s2 = 0.f;
        for (int i = 0; i < 64; ++i) { s1 += lq[i] * lq[64 + i]; s2 += lq[128 + i] * lq[192 + i]; }
        const float li = 0.8f - 0.6f * expf(-0.3f * (float)l);
        ((float*)(ws + WS_PAR))[1024 + l] = expf(s1) - expf(s2) + li; ((float*)(ws + WS_PAR))[1026 + l] = li; }
    if (gt < NRM_KN + 2 * 18 * 8) ((unsigned*)(ws + WS_NRM))[gt] = 0u;
    if (gt < MTOK) *(f32x2*)((float*)(ws + WS_STATS) + gt * 2) = (f32x2){0.f, 1.f};
    if (gt < 2048) ((float*)(ws + WS_ONES))[gt] = gt < 1024 ? 1.f : 0.f;
for (int rp_ = 0; rp_ < RPE; ++rp_) {
for (int rp_ = 0; rp_ < RPE; ++rp_) {
    for (long it = gt; it < 8192L * 1024; it += NGT) {
        const int row = (int)(it >> 10), k0 = (int)(it & 1023) * 8, odd = row >> 12, sp = row & 4095, neg = k0 >> 12, nb = k0 & 4095;
        float o[8];
#pragma unroll
        for (int e = 0; e < 8; ++e) { const int n = nb + e; float sn, cs;
            if (!odd) { const int idx = (n * sp) & 4095; sincospif((float)idx * (1.0f / 2048.0f), &sn, &cs); }
            else { const int idx = ((2 * n + 1) * sp) & 8191; sincospif((float)idx * (1.0f / 4096.0f), &sn, &cs); }
            o[e] = neg ? -sn : cs; }
        u32x4 w; w.x = pk2(o[0], o[1]); w.y = pk2(o[2], o[3]); w.z = pk2(o[4], o[5]); w.w = pk2(o[6], o[7]);
        *(u32x4*)((bf16*)(ws + WS_DFT) + (size_t)row * 8192 + k0) = w;
    }
}
    {
        const f32x4* xp = (const f32x4*)C.in[0]; const f32x4* xs = (const f32x4*)C.in[1]; u32x2* xb = (u32x2*)(ws + WS_XB);
        const long NP = (long)MP * 256, NT = (long)MTOK * 256;
        for (long it = gt; it < NT; it += NGT) { const f32x4 v = it < NP ? xp[it] : xs[it - NP]; u32x2 w; w.x = pk2(v[0], v[1]); w.y = pk2(v[2], v[3]); xb[it] = w; }
    }
}
}
DEV void ln_row(const f32x4 (&cur)[4], const f32x4 (&gv)[4], const f32x4 (&bv)[4], int m, int lane, float* out, unsigned char* ws, bool final_) {
    float s = 0.f, q = 0.f;
#pragma unroll
    for (int j = 0; j < 4; ++j) { s += (cur[j][0] + cur[j][1]) + (cur[j][2] + cur[j][3]); q += (cur[j][0] * cur[j][0] + cur[j][1] * cur[j][1]) + (cur[j][2] * cur[j][2] + cur[j][3] * cur[j][3]); }
#pragma unroll
    for (int o = 1; o < 64; o <<= 1) { const float s2 = lane_xor(s, lane, o), q2 = lane_xor(q, lane, o); s += s2; q += q2; }
    const float mean = s * (1.f / DM), var = __builtin_fmaxf(q * (1.f / DM) - mean * mean, 0.f), rstd = 1.f / sqrtf(var + 1e-5f);
    if (final_) {
        f32x4* xr = (f32x4*)(out + (size_t)m * DM) + lane;
#pragma unroll
        for (int j = 0; j < 4; ++j) __builtin_nontemporal_store((cur[j] - mean) * rstd * gv[j] + bv[j], xr + 64 * j);
    } else {
        u32x2* o8 = (u32x2*)((bf16*)(ws + WS_XB) + (size_t)m * DM) + lane;
#pragma unroll
        for (int j = 0; j < 4; ++j) { const f32x4 y = (cur[j] - mean) * rstd * gv[j] + bv[j]; u32x2 w; w.x = pk2(y[0], y[1]); w.y = pk2(y[2], y[3]); o8[64 * j] = w; }
        if (lane == 0) *(f32x2*)((float*)(ws + WS_STATS) + (size_t)m * 2) = (f32x2){mean, rstd};
    }
}
DEV void phase_ln(const Ctx& C, const float* g, const float* b, bool final_) {
    const int gw = C.bid * 8 + C.wave, NGW = C.G * 8, lane = C.lane;
    f32x4 gv[4], bv[4];
#pragma unroll
    for (int j = 0; j < 4; ++j) { gv[j] = ((const f32x4*)g)[lane + 64 * j]; bv[j] = ((const f32x4*)b)[lane + 64 * j]; }
    f32x4 c0[4], c1[4], n0[4], n1[4];
    auto ld = [&](f32x4 (&d)[4], int m) { const int mm = m < MTOK ? m : gw;
#pragma unroll
        for (int j = 0; j < 4; ++j) d[j] = __builtin_nontemporal_load((const f32x4*)(C.out + (size_t)mm * DM) + lane + 64 * j); };
    ld(c0, gw); ld(c1, gw + NGW);
    for (int m = gw; m < MTOK; m += 2 * NGW) {
        ld(n0, m + 2 * NGW); ld(n1, m + 3 * NGW);
        ln_row(c0, gv, bv, m, lane, C.out, C.ws, final_);
        if (m + NGW < MTOK) ln_row(c1, gv, bv, m + NGW, lane, C.out, C.ws, final_);
#pragma unroll
        for (int j = 0; j < 4; ++j) { c0[j] = n0[j]; c1[j] = n1[j]; }
    }
}
DEV void phase_dft_combine(const Ctx& C) {
    const long gt = (long)C.bid * 512 + C.tid, NGT = (long)C.G * 512;
    const float* PART = (const float*)(C.ws + WS_PART); bf16* Y = (bf16*)(C.ws + WS_YMIX); const float sc = 0.001381067932004976f;
    for (long it = gt; it < 2L * 4096 * 64; it += NGT) {
        const int seq2 = (int)(it >> 18), r = (int)(it & 262143), sp = r >> 6, c = (r & 63) * 4;
        const f32x4 p1 = *(const f32x4*)(PART + ((size_t)(seq2 * 2) * 4096 + sp) * 256 + c), p2 = *(const f32x4*)(PART + ((size_t)(seq2 * 2 + 1) * 4096 + sp) * 256 + c);
        const f32x4 lo = (p1 + p2) * sc, hi = (p1 - p2) * sc;
        u32x2 wl, wh; wl.x = pk2(lo[0], lo[1]); wl.y = pk2(lo[2], lo[3]); wh.x = pk2(hi[0], hi[1]); wh.y = pk2(hi[2], hi[3]);
        bf16* yl = Y + (size_t)(MP + seq2 * SS + sp) * DM + 768 + c;
        *(u32x2*)yl = wl; *(u32x2*)(yl + (size_t)4096 * DM) = wh;
    }
}
DEV void phase_conv(const Ctx& C, int l) {
    const long gt = (long)C.bid * 512 + C.tid, NGT = (long)C.G * 512;
    const bf16* P = (const bf16*)(C.ws + WS_PROJ); bf16* XC = (bf16*)(C.ws + WS_XC);
    const float* cw = C.in[11] + l * 4 * 256; const float* cb = C.in[12] + l * 256;
    for (long it = gt; it < (long)MTOK * 32; it += NGT) {
        const int tok = (int)(it >> 5), c0 = (int)(it & 31) * 8;
        const int pos = tok < MP ? (tok & 4095) : ((tok - MP) & 8191), S = tok < MP ? SP : SS;
        float a[8];
        { const f32x4 b0 = *(const f32x4*)(cb + c0), b1 = *(const f32x4*)(cb + c0 + 4); a[0] = b0[0]; a[1] = b0[1]; a[2] = b0[2]; a[3] = b0[3]; a[4] = b1[0]; a[5] = b1[1]; a[6] = b1[2]; a[7] = b1[3]; }
#pragma unroll
        for (int j = 0; j < 4; ++j) { const int tt = pos - 2 + j;
            if (tt >= 0 && tt < S) { const u32x4 xw = *(const u32x4*)(P + (size_t)(tok - 2 + j) * PROJW + c0);
                const f32x4 w0 = *(const f32x4*)(cw + j * 256 + c0), w1 = *(const f32x4*)(cw + j * 256 + c0 + 4);
                a[0] += w0[0] * bflo(xw.x); a[1] += w0[1] * bfhi(xw.x); a[2] += w0[2] * bflo(xw.y); a[3] += w0[3] * bfhi(xw.y);
                a[4] += w1[0] * bflo(xw.z); a[5] += w1[1] * bfhi(xw.z); a[6] += w1[2] * bflo(xw.w); a[7] += w1[3] * bfhi(xw.w); } }
        u32x4 w; w.x = pk2(a[0], a[1]); w.y = pk2(a[2], a[3]); w.z = pk2(a[4], a[5]); w.w = pk2(a[6], a[7]);
        *(u32x4*)(XC + (size_t)tok * 256 + c0) = w;
    }
    unsigned* QN = (unsigned*)(C.ws + WS_NRM) + l * 320 * 8; unsigned* KN = (unsigned*)(C.ws + WS_NRM) + NRM_KN + l * 18 * 8;
    for (long it = gt; it < (long)MTOK * 8; it += NGT) {
        const int tok = (int)(it >> 3), hm = (int)(it & 7);
        const bf16* qp = P + (size_t)tok * PROJW + 512 + hm * 64; float sq = 0.f, sk = 0.f;
#pragma unroll
        for (int j = 0; j < 8; ++j) { const u32x4 a = *(const u32x4*)(qp + 8 * j), k4 = *(const u32x4*)(qp + 512 + 8 * j);
            sq += bflo(a.x) * bflo(a.x) + bfhi(a.x) * bfhi(a.x) + bflo(a.y) * bflo(a.y) + bfhi(a.y) * bfhi(a.y) + bflo(a.z) * bflo(a.z) + bfhi(a.z) * bfhi(a.z) + bflo(a.w) * bflo(a.w) + bfhi(a.w) * bfhi(a.w);
            sk += bflo(k4.x) * bflo(k4.x) + bfhi(k4.x) * bfhi(k4.x) + bflo(k4.y) * bflo(k4.y) + bfhi(k4.y) * bfhi(k4.y) + bflo(k4.z) * bflo(k4.z) + bfhi(k4.z) * bfhi(k4.z) + bflo(k4.w) * bflo(k4.w) + bfhi(k4.w) * bfhi(k4.w); }
#pragma unroll
        for (int o = 8; o < 64; o <<= 1) { sq = fmaxf(sq, lane_xor(sq, C.lane, o)); sk = fmaxf(sk, lane_xor(sk, C.lane, o)); }
        if (C.lane < 8) { const int seq = tok < MP ? (tok >> 12) : 16 + ((tok - MP) >> 13);
            atomicMax(QN + (tok >> 8) * 8 + hm, __float_as_uint(sq)); atomicMax(KN + seq * 8 + hm, __float_as_uint(sk)); }
    }
}
DEV float fsig(float x) { return __builtin_amdgcn_rcpf(1.f + __builtin_amdgcn_exp2f(-LOG2E * x)); }
DEV void gate_eval(float rp, float ip, float xc, float ba, float bx, float sp8, float& la2, float& u) {
    const float r = fsig(rp + ba), ig = fsig(ip + bx);
    la2 = -sp8 * r * LOG2E;
    const float em = __builtin_fmaxf(1.f - __builtin_amdgcn_exp2f(2.f * la2), 0.f);
    u = __builtin_amdgcn_sqrtf(em) * ig * xc;
}
DEV float gelu_tanh(float x) { const float z = 0.7978845608028654f * (x + 0.044715f * x * x * x); const float e = __builtin_amdgcn_exp2f(2.f * LOG2E * z); return 0.5f * x * (2.f - 2.f * __builtin_amdgcn_rcpf(e + 1.f)); }
constexpr int SROW = 68;
typedef _Float16 h16x2 __attribute__((ext_vector_type(2)));
DEV unsigned pkh(float a, float b) { return __builtin_bit_cast(unsigned, __builtin_amdgcn_cvt_pkrtz(a, b)); }
template <int DIRV> DEV void gate_stage(const bf16* gbase, const bf16* xcb, int chb, int tl, int cg, LAS unsigned* sl, const float* pba, const float* pbx, const float* par) {
    const int col = (DIRV * 2 + (chb >> 7)) * 256 + (chb & 127);
    float ba[8], bx[8], sp[8];
#pragma unroll
    for (int q = 0; q < 2; ++q) { const f32x4 a = *(const f32x4*)(pba + DIRV * 256 + chb + 4 * q), b = *(const f32x4*)(pbx + DIRV * 256 + chb + 4 * q), s = *(const f32x4*)(par + DIRV * 256 + chb + 4 * q);
#pragma unroll
        for (int e = 0; e < 4; ++e) { ba[4 * q + e] = a[e]; bx[4 * q + e] = b[e]; sp[4 * q + e] = s[e]; } }
#pragma unroll
    for (int j = 0; j < 8; ++j) {
        const int t = 8 * j + tl;
        const u32x4 rw = *(const u32x4*)(gbase + (size_t)t * 1024 + col), iw = *(const u32x4*)(gbase + (size_t)t * 1024 + col + 128), xw = *(const u32x4*)(xcb + (size_t)t * 256);
        const float rp[8] = {bflo(rw.x), bfhi(rw.x), bflo(rw.y), bfhi(rw.y), bflo(rw.z), bfhi(rw.z), bflo(rw.w), bfhi(rw.w)};
        const float ip[8] = {bflo(iw.x), bfhi(iw.x), bflo(iw.y), bfhi(iw.y), bflo(iw.z), bfhi(iw.z), bflo(iw.w), bfhi(iw.w)};
        const float xc[8] = {bflo(xw.x), bfhi(xw.x), bflo(xw.y), bfhi(xw.y), bflo(xw.z), bfhi(xw.z), bflo(xw.w), bfhi(xw.w)};
        unsigned w[8];
#pragma unroll
        for (int e = 0; e < 8; ++e) { float la, u; gate_eval(rp[e], ip[e], xc[e], ba[e], bx[e], sp[e], la, u); w[e] = pkh(la, u); }
        LAS u32x4* dst = (LAS u32x4*)(sl + t * SROW + cg * 8);
        dst[0] = (u32x4){w[0], w[1], w[2], w[3]}; dst[1] = (u32x4){w[4], w[5], w[6], w[7]};
    }
    asm volatile("s_waitcnt lgkmcnt(0)" ::: "memory");
}
template <bool FINAL> DEV void phase_scan(const Ctx& C, int l, LAS unsigned char* lds) {
    const int gw = C.bid * 8 + C.wave, NGW = C.G * 8, lane = C.lane, tl = lane >> 3, cg = lane & 7;
    const bf16* GP = (const bf16*)(C.ws + WS_AU); float* AGG = (float*)(C.ws + WS_AGG); const bf16* XC = (const bf16*)(C.ws + WS_XC);
    const bf16* P = (const bf16*)(C.ws + WS_PROJ); bf16* Y = (bf16*)(C.ws + WS_YMIX);
    const float* par = (const float*)(C.ws + WS_PAR) + l * 512; const float* pba = C.in[14] + l * 512; const float* pbx = C.in[16] + l * 512;
    LAS unsigned* sl = (LAS unsigned*)(lds + C.wave * (64 * SROW * 4));
    for (int it = gw; it < 1280 * 4; it += NGW) {
        const int cidx = it >> 2, g4 = it & 3, ch = g4 * 64 + lane, chb = g4 * 64 + cg * 8;
        const bf16* gbase = GP + (size_t)cidx * 64 * 1024; const bf16* xcb = XC + (size_t)cidx * 64 * 256 + chb;
        if (!FINAL) {
            gate_stage<0>(gbase, xcb, chb, tl, cg, sl, pba, pbx, par);
            { float Ps = 0.f, h = 0.f;
#pragma unroll 16
              for (int t = 0; t < 64; ++t) { const h16x2 w = __builtin_bit_cast(h16x2, sl[t * SROW + lane]); const float la = (float)w[0]; h = __builtin_amdgcn_exp2f(la) * h + (float)w[1]; Ps += la; }
              *(f32x2*)(AGG + ((size_t)(cidx * 2 + 0) * 256 + ch) * 2) = (f32x2){Ps, h}; }
            asm volatile("s_waitcnt lgkmcnt(0)" ::: "memory");
            gate_stage<1>(gbase, xcb, chb, tl, cg, sl, pba, pbx, par);
            { float Ps = 0.f, h = 0.f;
#pragma unroll 16
              for (int t = 63; t >= 0; --t) { const h16x2 w = __builtin_bit_cast(h16x2, sl[t * SROW + lane]); const float la = (float)w[0]; h = __builtin_amdgcn_exp2f(la) * h + (float)w[1]; Ps += la; }
              *(f32x2*)(AGG + ((size_t)(cidx * 2 + 1) * 256 + ch) * 2) = (f32x2){Ps, h}; }
            asm volatile("s_waitcnt lgkmcnt(0)" ::: "memory");
        } else {
            int c0, c1; if (cidx < 1024) { c0 = cidx & ~63; c1 = c0 + 64; } else { c0 = 1024 + ((cidx - 1024) & ~127); c1 = c0 + 128; }
            float hin = 0.f, hbin = 0.f;
#pragma unroll 16
            for (int c = c0; c < cidx; ++c) { const f32x2 a = *(const f32x2*)(AGG + ((size_t)(c * 2 + 0) * 256 + ch) * 2); hin = __builtin_amdgcn_exp2f(a[0]) * hin + a[1]; }
#pragma unroll 16
            for (int c = c1 - 1; c > cidx; --c) { const f32x2 a = *(const f32x2*)(AGG + ((size_t)(c * 2 + 1) * 256 + ch) * 2); hbin = __builtin_amdgcn_exp2f(a[0]) * hbin + a[1]; }
            gate_stage<0>(gbase, xcb, chb, tl, cg, sl, pba, pbx, par);
            float hf[64]; float h = hin;
#pragma unroll
            for (int t = 0; t < 64; ++t) { const h16x2 w = __builtin_bit_cast(h16x2, sl[t * SROW + lane]); h = __builtin_amdgcn_exp2f((float)w[0]) * h + (float)w[1]; hf[t] = h; }
            asm volatile("s_waitcnt lgkmcnt(0)" ::: "memory");
            gate_stage<1>(gbase, xcb, chb, tl, cg, sl, pba, pbx, par);
            h = hbin;
#pragma unroll
            for (int t = 63; t >= 0; --t) { const h16x2 w = __builtin_bit_cast(h16x2, sl[t * SROW + lane]); h = __builtin_amdgcn_exp2f((float)w[0]) * h + (float)w[1]; sl[t * SROW + lane] = __float_as_uint(hf[t] + h); }
            asm volatile("s_waitcnt lgkmcnt(0)" ::: "memory");
#pragma unroll
            for (int j = 0; j < 8; ++j) {
                const int t = 8 * j + tl; const size_t tok = (size_t)cidx * 64 + t;
                const LAS u32x4* src = (const LAS u32x4*)(sl + t * SROW + cg * 8); const u32x4 s0 = src[0], s1 = src[1];
                const u32x4 gw_ = *(const u32x4*)(P + tok * PROJW + 256 + chb);
                u32x4 o;
                o.x = pk2(gelu_tanh(bflo(gw_.x)) * __uint_as_float(s0.x), gelu_tanh(bfhi(gw_.x)) * __uint_as_float(s0.y));
                o.y = pk2(gelu_tanh(bflo(gw_.y)) * __uint_as_float(s0.z), gelu_tanh(bfhi(gw_.y)) * __uint_as_float(s0.w));
                o.z = pk2(gelu_tanh(bflo(gw_.z)) * __uint_as_float(s1.x), gelu_tanh(bfhi(gw_.z)) * __uint_as_float(s1.y));
                o.w = pk2(gelu_tanh(bflo(gw_.w)) * __uint_as_float(s1.z), gelu_tanh(bfhi(gw_.w)) * __uint_as_float(s1.w));
                *(u32x4*)(Y + tok * DM + chb) = o;
            }
            asm volatile("s_waitcnt lgkmcnt(0)" ::: "memory");
        }
    }
}
namespace att {
constexpr int KROW = 272, VROW = 320, KBUF = 32 * KROW, VBUF = 32 * VROW, LDS_K = 0, LDS_V = 2 * KBUF, LDS_Q = 2 * KBUF + 2 * VBUF;
static_assert(LDS_Q + 256 * KROW + 16 <= LDS_BYTES, "attention LDS");
typedef short v4i16_t __attribute__((ext_vector_type(4)));
DEV s16x4 vtr(const LAS unsigned char* p) { return __builtin_bit_cast(s16x4, __builtin_amdgcn_ds_read_tr16_b64_v4i16((LAS v4i16_t*)p)); }


DEV void attn_unit(const bf16* PROJ, bf16* YMIX, int tok0, int S, int head, int qb, float lam, float oscale, const float* subg, float Bnd, LAS unsigned char* lds) {
    int tid_ = threadIdx.x; asm volatile("" : "+v"(tid_));
    const int tid = tid_, lane = tid & 63, r32 = lane & 31, hi = lane >> 5, wid = __builtin_amdgcn_readfirstlane(tid >> 6);
    const int qpos = qb * 256 + wid * 32 + r32;
    LAS unsigned char* qlds = lds + LDS_Q + wid * 32 * KROW;
    { const bf16* qg = PROJ + (size_t)(tok0 + qb * 256 + wid * 32) * PROJW + 512 + head * 128;
#pragma unroll
      for (int i = 0; i < 8; ++i) { const int ch = lane + 64 * i, row = ch >> 4, c16 = ch & 15; const u32x4 v = *(const u32x4*)(qg + (size_t)row * PROJW + c16 * 8); *(LAS u32x4*)(qlds + row * KROW + c16 * 16) = v; } }
    const LAS unsigned char* qfb = qlds + r32 * KROW + hi * 16;
    const float sl2 = __builtin_amdgcn_exp2f(-2.f * (float)(head + 1)) * LOG2E;
    const int srow = tid >> 4, sc16 = tid & 15;
    const bf16* kg = PROJ + (size_t)(tok0 + srow) * PROJW + 1024 + head * 128 + sc16 * 8;
    const bf16* vg = kg + 512;
    LAS unsigned char* kst = lds + LDS_K + srow * KROW + sc16 * 16;
    LAS unsigned char* vst = lds + LDS_V + srow * VROW + sc16 * 16;
    const LAS unsigned char* kfb = lds + LDS_K + r32 * KROW + hi * 16;
    const int i16 = lane & 15, gq = i16 >> 2, gp = i16 & 3, g1 = (lane >> 4) & 1;
    const LAS unsigned char* vfb = lds + LDS_V + (4 * hi + gq) * VROW + (16 * g1 + 4 * gp) * 2;
    u32x4 kr0, vr0;
    { const size_t go0 = (size_t)(qb * 8) * 32 * PROJW; kr0 = *(const u32x4*)(kg + go0); vr0 = *(const u32x4*)(vg + go0); }
    *(LAS u32x4*)kst = kr0; *(LAS u32x4*)vst = vr0;
    __syncthreads();
    f32x16 O[2][4];
#pragma unroll
    for (int c = 0; c < 2; ++c)
#pragma unroll
        for (int d = 0; d < 4; ++d)
#pragma unroll
            for (int r = 0; r < 16; ++r) O[c][d][r] = 0.f;
    float mrun[2] = {-1e30f, -1e30f}, lrun[2] = {0.f, 0.f};
    const int ts = qb * 8, qw0 = qb * 256 + wid * 32;
    int t_lo = 0, t_hi = (S >> 5) - 1;
    { const float Df = (2.f * Bnd + 138.f) / sl2;     if (Df < (float)S) { const int D = (int)Df + 1; const int a_ = (qb * 256 - D) >> 5, b_ = (qb * 256 + 255 + D) >> 5; t_lo = a_ > 0 ? a_ : 0; t_hi = b_ < t_hi ? b_ : t_hi; } }
    const int NT = t_hi - t_lo + 1;
    f32x16 bcv; float csign = 1.f;
#pragma unroll
    for (int r = 0; r < 16; ++r) { float cr_ = (float)((r & 3) + 8 * (r >> 2)); asm volatile("" : "+v"(cr_)); bcv[r] = sl2 * cr_; }
    for (int i = 0; i < NT; ++i) {
        int t = ts + i; if (t > t_hi) t -= NT;
        int tn = t + 1; if (tn > t_hi) tn -= NT;
        const int cur = i & 1, k0 = t * 32;
        const LAS unsigned char* kb = kfb + cur * KBUF; const LAS unsigned char* vb = vfb + cur * VBUF;
        const float dqf = (float)(qpos - k0 - 4 * hi);
        const bool diag = (k0 == qw0);
        if (!diag) { const float want = (k0 < qw0) ? 1.f : -1.f;
            if (want != csign) { csign = want;
#pragma unroll
                for (int r = 0; r < 16; ++r) bcv[r] = -bcv[r]; } }
        const float lt = diag ? 0.f : -csign * sl2 * dqf;
        if (i + 1 < NT) { const size_t go = (size_t)tn * 32 * PROJW; kr0 = *(const u32x4*)(kg + go); vr0 = *(const u32x4*)(vg + go); }
        bf16x8 pf[2][2];
        f32x16 pp[2]; pp[0] = bcv; pp[1] = bcv;
#pragma unroll
        for (int c = 0; c < 2; ++c) {
            bf16x8 kf[4], qf[4];
#pragma unroll
            for (int ds = 0; ds < 4; ++ds) { kf[ds] = *(const LAS bf16x8*)(kb + (c * 64 + ds * 16) * 2); qf[ds] = *(const LAS bf16x8*)(qfb + (c * 64 + ds * 16) * 2); }
            __builtin_amdgcn_sched_barrier(0);
#pragma unroll
            for (int ds = 0; ds < 4; ++ds) pp[c] = __builtin_amdgcn_mfma_f32_32x32x16_bf16(kf[ds], qf[ds], pp[c], 0, 0, 0);
        }
        if (diag) {
#pragma unroll
            for (int r = 0; r < 16; ++r) { float cr = (float)((r & 3) + 8 * (r >> 2)); asm volatile("" : "+v"(cr)); const float fx = bcv[r] + sl2 * __builtin_fabsf(dqf - cr); pp[0][r] -= fx; pp[1][r] -= fx; }
        }
        float rm[2];
#pragma unroll
        for (int c = 0; c < 2; ++c) {
            float m_ = pp[c][0];
#pragma unroll
            for (int r = 1; r < 16; ++r) m_ = __builtin_fmaxf(m_, pp[c][r]);
            m_ += lt;
            auto rr = __builtin_amdgcn_permlane32_swap(__float_as_uint(m_), __float_as_uint(m_), false, false); rm[c] = __builtin_fmaxf(__uint_as_float(rr[0]), __uint_as_float(rr[1]));
        }
        if (__any(rm[0] > mrun[0] + 8.f || rm[1] > mrun[1] + 8.f)) {
#pragma unroll
            for (int c = 0; c < 2; ++c) {
                const float mnew = rm[c] > mrun[c] + 8.f ? rm[c] : mrun[c], alpha = __builtin_amdgcn_exp2f(mrun[c] - mnew);
                mrun[c] = mnew; lrun[c] *= alpha;
#pragma unroll
                for (int d = 0; d < 4; ++d)
#pragma unroll
                    for (int r = 0; r < 16; ++r) O[c][d][r] *= alpha;
            }
        }
#pragma unroll
        for (int c = 0; c < 2; ++c) {
            const float mm = mrun[c] - lt;
            float rs = 0.f;
#pragma unroll
            for (int r = 0; r < 16; ++r) { pp[c][r] = __builtin_amdgcn_exp2f(pp[c][r] - mm); rs += pp[c][r]; }
            lrun[c] += rs;
#pragma unroll
            for (int s = 0; s < 2; ++s) {
                u32x4 a;
                a.x = pk2(pp[c][8 * s + 0], pp[c][8 * s + 1]); a.y = pk2(pp[c][8 * s + 2], pp[c][8 * s + 3]); a.z = pk2(pp[c][8 * s + 4], pp[c][8 * s + 5]); a.w = pk2(pp[c][8 * s + 6], pp[c][8 * s + 7]);
                pf[c][s] = __builtin_bit_cast(bf16x8, a);
            }
        }
#pragma unroll
        for (int xs = 0; xs < 2; ++xs) { __builtin_amdgcn_sched_barrier(0);
            s16x4 vlo[4], vhi[4];
#pragma unroll
            for (int d = 0; d < 4; ++d) { vlo[d] = vtr(vb + (16 * xs) * VROW + d * 64); vhi[d] = vtr(vb + (16 * xs + 8) * VROW + d * 64); }
            __builtin_amdgcn_sched_barrier(0);
#pragma unroll
            for (int d = 0; d < 4; ++d) {
                const bf16x8 vf = {vlo[d][0], vlo[d][1], vlo[d][2], vlo[d][3], vhi[d][0], vhi[d][1], vhi[d][2], vhi[d][3]};
                O[0][d] = __builtin_amdgcn_mfma_f32_32x32x16_bf16(vf, pf[0][xs], O[0][d], 0, 0, 0);
                O[1][d] = __builtin_amdgcn_mfma_f32_32x32x16_bf16(vf, pf[1][xs], O[1][d], 0, 0, 0);
            }
        }
        if (i + 1 < NT) { const int nb = cur ^ 1; *(LAS u32x4*)(kst + nb * KBUF) = kr0; *(LAS u32x4*)(vst + nb * VBUF) = vr0; }
        __syncthreads();
    }
    const float l0 = lrun[0] + lane_xor(lrun[0], lane, 32), l1 = lrun[1] + lane_xor(lrun[1], lane, 32);
    const float i0 = 1.f / l0, i1 = lam / l1;
    float ss = 0.f;
#pragma unroll
    for (int d = 0; d < 4; ++d)
#pragma unroll
        for (int r = 0; r < 16; ++r) { const float o = O[0][d][r] * i0 - O[1][d][r] * i1; O[0][d][r] = o; ss += o * o; }
    ss += lane_xor(ss, lane, 32);
    const float rn = oscale / sqrtf(ss * (1.f / 128.f) + 1e-5f);
    bf16* yrow = YMIX + (size_t)(tok0 + qpos) * DM + 256 + head * 128;
#pragma unroll
    for (int d = 0; d < 4; ++d)
#pragma unroll
        for (int rg = 0; rg < 4; ++rg) { const int d0 = 32 * d + 8 * rg + 4 * hi; const f32x4 g4 = *(const f32x4*)(subg + d0);
            u32x2 w; w.x = pk2(O[0][d][4 * rg + 0] * rn * g4[0], O[0][d][4 * rg + 1] * rn * g4[1]); w.y = pk2(O[0][d][4 * rg + 2] * rn * g4[2], O[0][d][4 * rg + 3] * rn * g4[3]);
            *(u32x2*)(yrow + d0) = w; }
}
DEV void attn_phase(const Ctx& C, int l, LAS unsigned char* lds, int rep = 0) {
    const bf16* P = (const bf16*)(C.ws + WS_PROJ); bf16* Y = (bf16*)(C.ws + WS_YMIX);
    const float lam = ((const float*)(C.ws + WS_PAR))[1024 + l], li = ((const float*)(C.ws + WS_PAR))[1026 + l];
    const float* subg = C.in[19] + l * 128;
    const float* QN = (const float*)(C.ws + WS_NRM) + l * 320 * 8; const float* KN = (const float*)(C.ws + WS_NRM) + NRM_KN + l * 18 * 8;
    unsigned* qcnt = (unsigned*)(C.ws + WS_BAR) + 16 + 16 * l + 4 * rep;
    volatile LAS int* ubox = (volatile LAS int*)(lds + LDS_Q + 256 * KROW);
    for (;;) {
        if (C.tid == 0) ubox[0] = (int)__hip_atomic_fetch_add(qcnt, 1u, __ATOMIC_RELAXED, __HIP_MEMORY_SCOPE_AGENT);
        __syncthreads();
        const int u = ubox[0];
        if (u >= 1280) break;
        const int head = 3 - u / 320, r = u % 320;
        int tok0, S, qb, seq;
        if (r < 64) { seq = 16 + (r >> 5); qb = r & 31; tok0 = MP + (r >> 5) * SS; S = SS; }
        else { const int v = r - 64; seq = v >> 4; qb = v & 15; tok0 = seq * SP; S = SP; }
        const int blk = (tok0 >> 8) + qb;
        const float b0 = sqrtf(QN[blk * 8 + head * 2] * KN[seq * 8 + head * 2]), b1 = sqrtf(QN[blk * 8 + head * 2 + 1] * KN[seq * 8 + head * 2 + 1]);
        const float Bnd = 1.02f * fmaxf(b0, b1) + 0.5f;
        attn_unit(P, Y, tok0, S, head, qb, lam, 1.f - li, subg, Bnd, lds);
    }
}
}
DEV void grid_barrier(unsigned* bar, unsigned epoch, unsigned G) {
    asm volatile("s_waitcnt vmcnt(0)" ::: "memory");
    __syncthreads();
    if (threadIdx.x == 0) {
        __builtin_amdgcn_fence(__ATOMIC_RELEASE, "agent");
        asm volatile("s_waitcnt vmcnt(0)" ::: "memory");
        __hip_atomic_fetch_add(bar, 1u, __ATOMIC_RELAXED, __HIP_MEMORY_SCOPE_AGENT);
        const unsigned target = epoch * G;
        while (__hip_atomic_load(bar, __ATOMIC_RELAXED, __HIP_MEMORY_SCOPE_AGENT) < target) __builtin_amdgcn_s_sleep(2);
        __builtin_amdgcn_fence(__ATOMIC_ACQUIRE, "agent");
        asm volatile("s_waitcnt vmcnt(0)" ::: "memory");
    }
    __syncthreads();
}
#ifndef REP_ATT
#define REP_ATT 1
#endif
#ifndef REP_FFNUP
#define REP_FFNUP 1
#endif
#ifndef REP_DFT
#define REP_DFT 1
#endif
#ifndef REP_BAR
#define REP_BAR 1
#endif
#ifndef REP_FFNDN
#define REP_FFNDN 1
#endif
#ifndef REP_GATE
#define REP_GATE 1
#endif
#ifndef REP_OUT
#define REP_OUT 1
#endif
#ifndef REP_LN
#define REP_LN 1
#endif
#ifndef REP_PROJ
#define REP_PROJ 1
#endif
#ifndef REP_SCANA
#define REP_SCANA 1
#endif
#ifndef REP_SCANC
#define REP_SCANC 1
#endif
#ifndef REP_CONV
#define REP_CONV 1
#endif
#ifndef REP_BAR
#define REP_BAR 1
#endif
#ifndef REP_FFNDN
#define REP_FFNDN 1
#endif
#ifndef REP_GATE
#define REP_GATE 1
#endif
#ifndef REP_OUT
#define REP_OUT 1
#endif
#ifndef REP_LN
#define REP_LN 1
#endif
#ifndef REP_PRO
#define REP_PRO 1
#endif
struct Args { const float* in[21]; float* out; unsigned char* ws; int ph_lo, ph_hi; };
constexpr int NPHASES = 27;
__global__ void __launch_bounds__(512, 2) mk_fwd(Args a) {
    extern __shared__ __attribute__((aligned(16))) unsigned char lds_raw[];
    LAS unsigned char* lds = (LAS unsigned char*)lds_raw;
    cg::grid_group grid = cg::this_grid();
    Ctx C;
C.in = a.in; C.out = a.out; C.ws = a.ws; C.tid = threadIdx.x; C.lane = C.tid & 63; C.wave = __builtin_amdgcn_readfirstlane(C.tid >> 6); C.G = gridDim.x; C.bid = blockIdx.x;
    unsigned char* ws = a.ws;
    const int lo = a.ph_lo, hi = a.ph_hi;
    int ph = 0; unsigned epoch = 0;
#define PH_BEGIN if (ph >= lo && ph < hi) { { int t_ = threadIdx.x; asm volatile("" : "+v"(t_)); C.tid = t_; C.lane = t_ & 63; C.wave = __builtin_amdgcn_readfirstlane(t_ >> 6); size_t z_ = 0; asm volatile("" : "+s"(z_)); ws = a.ws + z_; C.ws = ws; C.out = a.out + z_;     int g_ = gridDim.x, b_ = blockIdx.x; asm volatile("" : "+s"(g_), "+s"(b_)); C.G = g_; C.bid = b_; }
#define PH_END   if (ph + 1 < hi) { for (int rb_ = 0; rb_ < REP_BAR; ++rb_) grid_barrier((unsigned*)(a.ws + WS_BAR), ++epoch, gridDim.x); } } ++ph;
#define XB ((bf16*)(ws + WS_XB))
#define H ((bf16*)(ws + WS_H))
#define PROJ ((bf16*)(ws + WS_PROJ))
#define YMIX ((bf16*)(ws + WS_YMIX))
    if (ph >= lo && ph < hi) { { int t_ = threadIdx.x; asm volatile("" : "+v"(t_)); C.tid = t_; C.lane = t_ & 63; C.wave = __builtin_amdgcn_readfirstlane(t_ >> 6); }
#ifndef NO_PRO
 for (int rep_ = 0; rep_ < REP_PRO; ++rep_) { phase_prologue(C, lds); __syncthreads(); }
#endif
 __syncthreads(); if (ph + 1 < hi) grid.sync(); } ++ph;
    for (int l = 0; l < 2; ++l) {
        for (int f = 0; f < 2; ++f) {
            if (f == 1) {
                PH_BEGIN
                { pg8::Gemm g{XB, (const bf16*)(ws + WS_WIN) + (size_t)l * 2048 * 1024, 1024, 1024, 1024, 0, 0}; pg8::StaticOrder S; S.init(MTOK, 2048, C.G, C.bid);
                  epi::Proj E{PROJ};
#ifndef NO_PROJ
 for (int rep_ = 0; rep_ < REP_PROJ; ++rep_) pg8::gemm_phase<epi::Proj, pg8::StaticOrder, true, true, 1024, 1024, 1024>(lds, g, S, E);
#endif
 }
                { pg8::Gemm g{(const bf16*)(ws + WS_WF) + (size_t)l * 512 * 1024, XB, 1024, 1024, 1024, 0, 0}; pg8::StaticOrder S; S.init(512, MTOK, C.G, C.bid);
                  epi::FT E{(bf16*)(ws + WS_BTF)};
#ifndef NO_FT
 for (int rep_ = 0; rep_ < REP_PROJ; ++rep_) pg8::gemm_phase<epi::FT, pg8::StaticOrder, true, true, 1024, 1024, 1024>(lds, g, S, E);
#endif
 }
                PH_END
                PH_BEGIN for (int rep_ = 0; rep_ < REP_CONV; ++rep_) phase_conv(C, l); PH_END
                PH_BEGIN
                { pg8::Gemm g{(const bf16*)(ws + WS_XC), (const bf16*)(ws + WS_WG) + (size_t)l * 1024 * 256, 256, 256, 256, 0, 0}; pg8::StaticOrder S; S.init(MTOK, 1024, C.G, C.bid);
                  epi::Raw E{(bf16*)(ws + WS_AU)};
#ifndef NO_GATE
 for (int rep_ = 0; rep_ < REP_GATE; ++rep_) pg8::gemm_phase<epi::Raw, pg8::StaticOrder, true, true, 256, 256, 256>(lds, g, S, E);
#endif
 }
                PH_END
                PH_BEGIN
#ifndef NO_SCANA
 for (int rep_ = 0; rep_ < REP_SCANA; ++rep_) phase_scan<false>(C, l, lds);
 __syncthreads();
#endif
                { pg8::Gemm g{(const bf16*)(ws + WS_DFT), (const bf16*)(ws + WS_BTF), 8192, 8192, 8192, 0, (size_t)256 * 8192}; epi::DftOrder S{C.G, C.bid};
                  epi::DFT E{YMIX, (float*)(ws + WS_PART), 0.001953125f  };
#ifndef NO_DFT
 for (int rep_ = 0; rep_ < REP_DFT; ++rep_) pg8::gemm_phase<epi::DFT, epi::DftOrder, true, true, 8192, 8192, 8192>(lds, g, S, E);
#endif
 }
#ifndef NO_ATT
 for (int rep_ = 0; rep_ < REP_ATT; ++rep_) att::attn_phase(C, l, lds, rep_);
#endif
 PH_END
                PH_BEGIN
phase_dft_combine(C);
#ifndef NO_SCANC
 for (int rep_ = 0; rep_ < REP_SCANC; ++rep_) phase_scan<true>(C, l, lds);
#endif
 PH_END
                PH_BEGIN
                { pg8::Gemm g{YMIX, (const bf16*)(ws + WS_WOUT) + (size_t)l * 1024 * 1024, 1024, 1024, 1024, 0, 0}; pg8::StaticOrder S; S.init(MTOK, 1024, C.G, C.bid); S.rev = 1;
                  epi::Resid E{C.out, 1.0f, (const float*)(ws + WS_STATS), C.in[2] + (l * 3 + 0) * 1024, C.in[3] + (l * 3 + 0) * 1024, C.out, C.out + (size_t)MP * DM};
#ifndef NO_OUT
 for (int rep_ = 1; rep_ < REP_OUT; ++rep_) { epi::Resid E0{C.out, 0.f, (const float*)(ws + WS_STATS), (const float*)(ws + WS_ONES), (const float*)(ws + WS_ONES) + 1024, C.out, C.out + (size_t)MP * DM, 1.f}; pg8::gemm_phase<epi::Resid, pg8::StaticOrder, true, true, 1024, 1024, 1024>(lds, g, S, E0); }
 pg8::gemm_phase<epi::Resid, pg8::StaticOrder, true, true, 1024, 1024, 1024>(lds, g, S, E);
#endif
 }
                PH_END
                PH_BEGIN for (int rep_ = 0; rep_ < REP_LN; ++rep_) phase_ln(C, C.in[2] + (l * 3 + 1) * 1024, C.in[3] + (l * 3 + 1) * 1024, false); PH_END
            }
            PH_BEGIN
            { pg8::Gemm g{XB, (const bf16*)(ws + WS_WGU) + (size_t)(l * 2 + f) * 5632 * 1024, 1024, 1024, 1024, 0, 0}; pg8::StaticOrder S; S.init(MTOK, 5632, C.G, C.bid);
              epi::SwiGLU E{H};
#ifndef NO_FFNUP
 for (int rep_ = 0; rep_ < REP_FFNUP; ++rep_) pg8::gemm_phase<epi::SwiGLU, pg8::StaticOrder, true, true, 1024, 1024, 1024>(lds, g, S, E);
#endif
 }
            PH_END
            PH_BEGIN
            { pg8::Gemm g{H, (const bf16*)(ws + WS_WD) + (size_t)(l * 2 + f) * 1024 * 2816, 2816, 2816, 2816, 0, 0}; pg8::StaticOrder S; S.init(MTOK, 1024, C.G, C.bid); S.rev = 1;
              const bool ident_ = (l == 0 && f == 0); const int pidx_ = f == 1 ? l * 3 + 1 : (l - 1) * 3 + 2;
              epi::Resid E{C.out, 0.5f, (const float*)(ws + WS_STATS), ident_ ? (const float*)(ws + WS_ONES) : C.in[2] + pidx_ * 1024, ident_ ? (const float*)(ws + WS_ONES) + 1024 : C.in[3] + pidx_ * 1024, ident_ ? C.in[0] : C.out, ident_ ? C.in[1] : C.out + (size_t)MP * DM};
#ifndef NO_FFNDN
 for (int rep_ = 1; rep_ < REP_FFNDN; ++rep_) { epi::Resid E0{C.out, 0.f, (const float*)(ws + WS_STATS), (const float*)(ws + WS_ONES), (const float*)(ws + WS_ONES) + 1024, C.out, C.out + (size_t)MP * DM, 1.f}; pg8::gemm_phase<epi::Resid, pg8::StaticOrder, true, true, 2816, 2816, 2816>(lds, g, S, E0); }
 pg8::gemm_phase<epi::Resid, pg8::StaticOrder, true, true, 2816, 2816, 2816>(lds, g, S, E);
#endif
 }
            PH_END
            PH_BEGIN for (int rep_ = 0; rep_ < ((l == 1 && f == 1) ? 1 : REP_LN); ++rep_) phase_ln(C, C.in[2] + (l * 3 + 2 * f) * 1024, C.in[3] + (l * 3 + 2 * f) * 1024, l == 1 && f == 1); PH_END
        }
    }
}

#ifndef MK_COOP
#define MK_COOP 1
#endif
extern "C" void kernel_launch(void* const* d_in, const int* in_sizes, int n_in, void* d_out, int out_size, void* d_ws, size_t ws_size, hipStream_t stream) {
    static int grid = 0;
    if (grid == 0) {
        if (n_in != 21 || out_size != MTOK * DM || ws_size < WS_END) { fprintf(stderr, "kernel_launch: unexpected shapes (n_in %d out %d ws %zu)\n", n_in, out_size, ws_size); grid = -1; return; }
        int dev = 0, cus = 0, per_cu = 0;
        hipGetDevice(&dev); hipDeviceGetAttribute(&cus, hipDeviceAttributeMultiprocessorCount, dev);
        hipFuncSetAttribute((const void*)mk_fwd, hipFuncAttributeMaxDynamicSharedMemorySize, LDS_BYTES);
        hipOccupancyMaxActiveBlocksPerMultiprocessor(&per_cu, (const void*)mk_fwd, 512, LDS_BYTES);
        (void)hipGetLastError();
        if (per_cu < 1) per_cu = 1;
        grid = cus;
    }
    if (grid < 0) return;
    if (MK_COOP) (void)hipMemsetAsync((char*)d_ws + WS_BAR, 0, 256, stream);
    Args a{};
    for (int i = 0; i < 21; ++i) a.in[i] = (const float*)d_in[i];
    a.out = (float*)d_out; a.ws = (unsigned char*)d_ws;
#if MK_COOP
    a.ph_lo = 0; a.ph_hi = NPHASES;
    void* args[] = {&a};
    hipError_t e = hipLaunchCooperativeKernel((const void*)mk_fwd, dim3(grid), dim3(512), args, LDS_BYTES, stream);
    if (e != hipSuccess) fprintf(stderr, "cooperative launch failed: %s (grid %d)\n", hipGetErrorString(e), grid);
#else
    for (int p = 0; p < NPHASES; ++p) { a.ph_lo = p; a.ph_hi = p + 1; hipLaunchKernelGGL(mk_fwd, dim3(grid), dim3(512), LDS_BYTES, stream, a); }
#endif
}
```

```cpp
#include <hip/hip_runtime.h>
#include <hip/hip_cooperative_groups.h>
#include <hip/hip_bf16.h>
#include <cstdio>
#include <cstdint>
#include <cmath>
namespace cg = cooperative_groups;
namespace pg8 {
#define PG8_LAS __attribute__((address_space(3)))
typedef unsigned short bf16_t;
typedef short bf16x8 __attribute__((ext_vector_type(8)));
typedef float f32x4 __attribute__((ext_vector_type(4)));
typedef unsigned u32x4 __attribute__((ext_vector_type(4)));
constexpr int BM = 256, BK = 64, HALF = 128, HTB = HALF * BK * 2  , STAGE_BYTES = 8 * HTB, NXCD = 8, WGM = 8;

__host__ __device__ __forceinline__ int lds_byte(int r, int c) { const int st = (r >> 4) * 2 + (c >> 5), rr = r & 15, cc = c & 31, ob = rr * 64 + cc * 2; return st * 1024 + (ob ^ (((ob >> 9) & 1) << 5)); }
__host__ __device__ __forceinline__ void stage_rc(int b, int& R, int& C) { const int st = b / 1024, sb = b % 1024, swz = sb ^ (((sb >> 9) & 1) << 5); R = (st >> 1) * 16 + swz / 64; C = (st & 1) * 32 + (swz % 64) / 2; }
__host__ __device__ __forceinline__ int perm32(int rho) { const int n = rho >> 4, i = rho & 15; return 8 * (i >> 2) + 4 * n + (i & 3); }

struct Unit { int pm, pn, z; };
struct Gemm { const bf16_t* A; const bf16_t* Bt; int K, lda, ldb; size_t zA, zB; };

struct StaticOrder {
    int nM, nN, nwg, G, c; int rev = 0;
    __host__ __device__ void init(int M, int N, int G_, int c_) { nM = M / BM; nN = N / BM; nwg = nM * nN; G = G_; c = c_; }
    __host__ __device__ bool next(int i, Unit& u) const {
        const long L = (long)i * G + c; if (L >= nwg) return false;
        int wgid = rev ? nwg - 1 - (int)L : (int)L; { const int q = nwg / NXCD, r = nwg % NXCD, xcd = wgid % NXCD, off = wgid / NXCD; wgid = (xcd < r ? xcd * (q + 1) : r * (q + 1) + (xcd - r) * q) + off; }
        const int nig = WGM * nN, gid = wgid / nig, fm = gid * WGM, gsz = (nM - fm) < WGM ? (nM - fm) : WGM;
        u.pm = fm + ((wgid % nig) % gsz); u.pn = (wgid % nig) / gsz; u.z = 0; return true;
    }
    __device__ __forceinline__ void a_ready(const Unit&) const {}
    __device__ __forceinline__ void done(const Unit&) const {}
};

__device__ __forceinline__ unsigned cvt_pk_bf16(float lo, float hi) { unsigned r; asm volatile("v_cvt_pk_bf16_f32 %0, %1, %2" : "=v"(r) : "v"(lo), "v"(hi)); return r; }
typedef float f32x2 __attribute__((ext_vector_type(2)));
__device__ __forceinline__ f32x2 gelu_pk(f32x2 v) {
    const f32x2 av = __builtin_elementwise_abs(v), d = av * 0.2316418882f + 1.0f;
    f32x2 t; t.x = __builtin_amdgcn_rcpf(d.x); t.y = __builtin_amdgcn_rcpf(d.y);
    f32x2 q = t * 0.5307027145f + (-0.7265760135f); q = q * t + 0.7107068705f; q = q * t + (-0.142248368f); q = q * t + 0.127414796f; q = q * t;
    const f32x2 s = (v * v) * (-0.72134752044f);
    f32x2 e; e.x = __builtin_amdgcn_exp2f(s.x); e.y = __builtin_amdgcn_exp2f(s.y);
    const f32x2 m = v * (q * e), r = v - m;
    f32x2 o; o.x = v.x < 0.f ? m.x : r.x; o.y = v.y < 0.f ? m.y : r.y; return o;
}

template <int ACT  > struct EpiBf16 {
    static constexpr bool PERM = true, AFTER_DRAIN = false; static_assert(ACT == 0 || ACT == 1, "EpiBf16: ACT is 0 (none) or 1 (gelu_pk)");
    bf16_t* O; int ldc; const float* bias; int split_cols; size_t split_stride; float scale0;
    __device__ __forceinline__ void operator()(const f32x4 (&acc)[2][2][4][2], const Unit& u, int wr, int wc, int fr, int fq) const {
        const int row0 = u.pm * BM + wr * 64 + fr; int colt = u.pn * BM; bf16_t* base = O;
        float sc = 1.f; if (split_cols) { const int t = colt / split_cols; base += (size_t)t * split_stride; colt -= t * split_cols; if (t == 0) sc = scale0; }
        const int col0 = colt + wc * 32 + 8 * fq, bcol0 = u.pn * BM + wc * 32 + 8 * fq;
        f32x4 bv[2][2];
#pragma unroll
        for (int bj = 0; bj < 2; ++bj)
#pragma unroll
            for (int n = 0; n < 2; ++n) bv[bj][n] = bias ? *(const f32x4*)(bias + bcol0 + bj * HALF + 4 * n) : (f32x4){0.f, 0.f, 0.f, 0.f};
#pragma unroll
        for (int ai = 0; ai < 2; ++ai)
#pragma unroll
            for (int m = 0; m < 4; ++m) { bf16_t* rowp = base + (size_t)(row0 + ai * HALF + m * 16) * ldc + col0;
#pragma unroll
                for (int bj = 0; bj < 2; ++bj) { f32x4 v0 = acc[ai][bj][m][0] + bv[bj][0], v1 = acc[ai][bj][m][1] + bv[bj][1];
                    if (ACT == 1) { f32x2 a = gelu_pk((f32x2){v0[0], v0[1]}), b = gelu_pk((f32x2){v0[2], v0[3]}), c = gelu_pk((f32x2){v1[0], v1[1]}), d = gelu_pk((f32x2){v1[2], v1[3]});
                        v0 = (f32x4){a.x, a.y, b.x, b.y}; v1 = (f32x4){c.x, c.y, d.x, d.y}; }
                    v0 = v0 * sc; v1 = v1 * sc; u32x4 w; w.x = cvt_pk_bf16(v0[0], v0[1]); w.y = cvt_pk_bf16(v0[2], v0[3]); w.z = cvt_pk_bf16(v1[0], v1[1]); w.w = cvt_pk_bf16(v1[2], v1[3]);
                    *(u32x4*)(rowp + bj * HALF) = w; } }
    }
};

template <class Epi, class Sched, bool ALIGN_EPI, bool SP2, int KK, int LDA, int LDB>
__device__ __forceinline__ void gemm_phase(PG8_LAS unsigned char* lds, const Gemm g, const Sched& S, const Epi& E) {
    int tid_ = threadIdx.x; asm volatile("" : "+v"(tid_));
    const int tid = tid_, wid = __builtin_amdgcn_readfirstlane(tid >> 6), lane = tid & 63, wr = wid >> 2, wc = wid & 3, fr = lane & 15, fq = lane >> 4;
    constexpr int K = KK, nt = K / BK;
    unsigned voffA[2], voffB[2];
#pragma unroll
    for (int i = 0; i < 2; ++i) { int R, C; stage_rc(tid * 16 + i * 8192, R, C); const int Rb = Epi::PERM ? ((R & ~31) + perm32(R & 31)) : R;
        voffA[i] = (unsigned)(R * LDA + C) * 2u; voffB[i] = (unsigned)(Rb * LDB + C) * 2u; }
    constexpr size_t kstep = (size_t)(BK * 2);
    constexpr size_t hstepA = (size_t)HALF * LDA * 2, hstepB = (size_t)HALF * LDB * 2;
    constexpr size_t tstepA = 2 * hstepA, tstepB = 2 * hstepB;
    const unsigned ldsw = (unsigned)wid * 1024u;
    const int aoff = lds_byte(wr * 64 + fr, fq * 8), boff = lds_byte(wc * 32 + fr, fq * 8);
#define PG8_SA(b, h) (((b) * 2 + (h)) * HTB)
#define PG8_SB(b, h) ((4 + (b) * 2 + (h)) * HTB)
#define PG8_STAGE(bufoff, gbase, voff) do { _Pragma("unroll") for (int _i = 0; _i < 2; ++_i) \
        __builtin_amdgcn_global_load_lds((const unsigned*)((const char*)(gbase) + (voff)[_i]), (PG8_LAS unsigned*)(lds + (bufoff) + ldsw + _i * 8192), 16, 0, 0); } while (0)
#define PG8_LDA(dst, b, h) do { _Pragma("unroll") for (int m = 0; m < 4; ++m) _Pragma("unroll") for (int k = 0; k < 2; ++k) dst[m][k] = *(const PG8_LAS bf16x8*)(lds + PG8_SA(b, h) + aoff + m * 2048 + k * 1024); } while (0)
#define PG8_LDB(dst, b, h) do { _Pragma("unroll") for (int n = 0; n < 2; ++n) _Pragma("unroll") for (int k = 0; k < 2; ++k) dst[n][k] = *(const PG8_LAS bf16x8*)(lds + PG8_SB(b, h) + boff + n * 2048 + k * 1024); } while (0)
#define PG8_MMA(ai, bj, At, Bt) do { __builtin_amdgcn_s_setprio(1); _Pragma("unroll") for (int m = 0; m < 4; ++m) _Pragma("unroll") for (int n = 0; n < 2; ++n) _Pragma("unroll") for (int k = 0; k < 2; ++k) \
        acc[ai][bj][m][n] = __builtin_amdgcn_mfma_f32_16x16x32_bf16(Bt[n][k], At[m][k], acc[ai][bj][m][n], 0, 0, 0); __builtin_amdgcn_s_setprio(0); } while (0)
#define PG8_WAIT_V(n) asm volatile("s_waitcnt vmcnt(" #n ")" ::: "memory")
#define PG8_WAIT_L(n) asm volatile("s_waitcnt lgkmcnt(" #n ")" ::: "memory")
#define PG8_BAR __builtin_amdgcn_s_barrier()
#define PG8_SCHED __builtin_amdgcn_sched_barrier(0)
    Unit cur, nxt; int ui = 0;
    if (!S.next(0, cur)) return;
    f32x4 acc[2][2][4][2];
#pragma unroll
    for (int a = 0; a < 2; ++a)
#pragma unroll
        for (int b = 0; b < 2; ++b)
#pragma unroll
            for (int m = 0; m < 4; ++m)
#pragma unroll
                for (int n = 0; n < 2; ++n) acc[a][b][m][n] = (f32x4){0.f, 0.f, 0.f, 0.f};
    bf16x8 At[4][2], B0[2][2], B1[2][2];
    const char* cA = (const char*)g.A + (size_t)cur.z * g.zA * 2 + (size_t)cur.pm * tstepA; const char* cB = (const char*)g.Bt + (size_t)cur.z * g.zB * 2 + (size_t)cur.pn * tstepB;
    S.a_ready(cur);
    if constexpr (SP2) {
        PG8_STAGE(PG8_SB(0, 0), cB, voffB); PG8_STAGE(PG8_SB(0, 1), cB + hstepB, voffB); PG8_STAGE(PG8_SA(0, 0), cA, voffA); PG8_STAGE(PG8_SA(0, 1), cA + hstepA, voffA);
        if (wr == 1) PG8_BAR;
        PG8_WAIT_V(2); PG8_BAR;
        PG8_STAGE(PG8_SB(1, 0), cB + kstep, voffB); PG8_STAGE(PG8_SA(1, 0), cA + kstep, voffA); PG8_STAGE(PG8_SB(1, 1), cB + hstepB + kstep, voffB);
        PG8_WAIT_V(6); PG8_BAR;
    } else {
        PG8_STAGE(PG8_SB(0, 0), cB, voffB); PG8_STAGE(PG8_SA(0, 0), cA, voffA); PG8_STAGE(PG8_SB(0, 1), cB + hstepB, voffB); PG8_STAGE(PG8_SA(0, 1), cA + hstepA, voffA);
        if (wr == 1) PG8_BAR;
        PG8_WAIT_V(4); PG8_BAR;
        PG8_STAGE(PG8_SB(1, 0), cB + kstep, voffB); PG8_STAGE(PG8_SA(1, 0), cA + kstep, voffA); PG8_STAGE(PG8_SB(1, 1), cB + hstepB + kstep, voffB);
        PG8_WAIT_V(6); PG8_BAR;
    }
    for (;;) {
        const bool has_next = S.next(ui + 1, nxt);
        const char* nA = has_next ? (const char*)g.A + (size_t)nxt.z * g.zA * 2 + (size_t)nxt.pm * tstepA : cA; const char* nB = has_next ? (const char*)g.Bt + (size_t)nxt.z * g.zB * 2 + (size_t)nxt.pn * tstepB : cB;
        for (int t = 0; t < nt; t += 2) {
            const bool last = (t == nt - 2);
            const char* a1 = cA + (size_t)(t + 1) * kstep;
            const char* a2 = last ? nA : cA + (size_t)(t + 2) * kstep; const char* b2 = last ? nB : cB + (size_t)(t + 2) * kstep;
            const char* a3 = a2 + kstep; const char* b3 = b2 + kstep;
            if (last && has_next) S.a_ready(nxt);
            if constexpr (SP2) {
            PG8_LDB(B0, 0, 0); PG8_LDB(B1, 0, 1); PG8_SCHED; PG8_LDA(At, 0, 0); PG8_STAGE(PG8_SA(1, 1), a1 + hstepA, voffA);
            PG8_WAIT_V(8); PG8_WAIT_L(0); PG8_BAR; PG8_MMA(0, 0, At, B0); PG8_MMA(0, 1, At, B1); PG8_BAR; PG8_SCHED;
            PG8_LDA(At, 0, 1); PG8_STAGE(PG8_SB(0, 0), b2, voffB); PG8_STAGE(PG8_SB(0, 1), b2 + hstepB, voffB); PG8_STAGE(PG8_SA(0, 0), a2, voffA);
            PG8_WAIT_V(8); PG8_WAIT_L(0); PG8_BAR; PG8_MMA(1, 0, At, B0); PG8_MMA(1, 1, At, B1); PG8_BAR; PG8_SCHED;
            PG8_LDB(B0, 1, 0); PG8_LDB(B1, 1, 1); PG8_SCHED; PG8_LDA(At, 1, 0); PG8_STAGE(PG8_SA(0, 1), a2 + hstepA, voffA);
            PG8_WAIT_V(8); PG8_WAIT_L(0); PG8_BAR; PG8_MMA(0, 0, At, B0); PG8_MMA(0, 1, At, B1); PG8_BAR; PG8_SCHED;
            PG8_LDA(At, 1, 1); PG8_STAGE(PG8_SB(1, 0), b3, voffB); PG8_STAGE(PG8_SB(1, 1), b3 + hstepB, voffB); PG8_STAGE(PG8_SA(1, 0), a3, voffA);
            PG8_WAIT_V(8); PG8_WAIT_L(0); PG8_BAR; PG8_MMA(1, 0, At, B0); PG8_MMA(1, 1, At, B1); PG8_BAR; PG8_SCHED;
            } else {
            PG8_LDB(B0, 0, 0); PG8_SCHED; PG8_LDA(At, 0, 0); PG8_STAGE(PG8_SA(1, 1), a1 + hstepA, voffA);
            PG8_WAIT_L(8); PG8_BAR; PG8_WAIT_L(0); PG8_MMA(0, 0, At, B0); PG8_BAR; PG8_SCHED;
            PG8_LDB(B1, 0, 1); PG8_STAGE(PG8_SB(0, 0), b2, voffB);
            PG8_BAR; PG8_WAIT_L(0); PG8_MMA(0, 1, At, B1); PG8_BAR;
            PG8_LDA(At, 0, 1); PG8_STAGE(PG8_SA(0, 0), a2, voffA);
            PG8_BAR; PG8_WAIT_L(0); PG8_MMA(1, 0, At, B0); PG8_BAR; PG8_SCHED;
            PG8_STAGE(PG8_SB(0, 1), b2 + hstepB, voffB);
            PG8_WAIT_V(6); PG8_BAR; PG8_MMA(1, 1, At, B1); PG8_BAR;
            PG8_LDB(B0, 1, 0); PG8_SCHED; PG8_LDA(At, 1, 0); PG8_STAGE(PG8_SA(0, 1), a2 + hstepA, voffA);
            PG8_WAIT_L(8); PG8_BAR; PG8_WAIT_L(0); PG8_MMA(0, 0, At, B0); PG8_BAR; PG8_SCHED;
            PG8_LDB(B1, 1, 1); PG8_STAGE(PG8_SB(1, 0), b3, voffB);
            PG8_BAR; PG8_WAIT_L(0); PG8_MMA(0, 1, At, B1); PG8_BAR;
            PG8_LDA(At, 1, 1); PG8_STAGE(PG8_SA(1, 0), a3, voffA);
            PG8_BAR; PG8_WAIT_L(0); PG8_MMA(1, 0, At, B0); PG8_BAR; PG8_SCHED;
            PG8_STAGE(PG8_SB(1, 1), b3 + hstepB, voffB);
            PG8_WAIT_V(6); PG8_BAR; PG8_MMA(1, 1, At, B1); PG8_BAR;
            }
        }
        if constexpr (ALIGN_EPI) { if (wr == 0) PG8_BAR; }
        if constexpr (!Epi::AFTER_DRAIN) { E(acc, cur, wr, wc, fr, fq); S.done(cur); }
        if (!has_next) break;
#pragma unroll
        for (int a = 0; a < 2; ++a)
#pragma unroll
            for (int b = 0; b < 2; ++b)
#pragma unroll
                for (int m = 0; m < 4; ++m)
#pragma unroll
                    for (int n = 0; n < 2; ++n) acc[a][b][m][n] = (f32x4){0.f, 0.f, 0.f, 0.f};
        cur = nxt; cA = nA; cB = nB; ++ui;
        if constexpr (ALIGN_EPI) { if (wr == 1) PG8_BAR; }
    }
    PG8_WAIT_V(0);
    if constexpr (!ALIGN_EPI) { if (wr == 0) PG8_BAR; }
    PG8_BAR;
    if constexpr (Epi::AFTER_DRAIN) { E.fused(acc, cur, wr, wc, fr, fq, lds, wid, lane); S.done(cur); }
#undef PG8_SA
#undef PG8_SB
#undef PG8_STAGE
#undef PG8_LDA
#undef PG8_LDB
#undef PG8_MMA
#undef PG8_WAIT_V
#undef PG8_WAIT_L
#undef PG8_BAR
#undef PG8_SCHED
}
}
#define DEV __device__ __forceinline__
#define LAS __attribute__((address_space(3)))
typedef unsigned short bf16;
typedef float f32x4 __attribute__((ext_vector_type(4)));
typedef float f32x2 __attribute__((ext_vector_type(2)));
typedef float f32x16 __attribute__((ext_vector_type(16)));
typedef unsigned u32x4 __attribute__((ext_vector_type(4)));
typedef unsigned u32x2 __attribute__((ext_vector_type(2)));
typedef short bf16x8 __attribute__((ext_vector_type(8)));
typedef short s16x4 __attribute__((ext_vector_type(4)));
typedef __bf16 bf16x2_t __attribute__((ext_vector_type(2)));

constexpr int DM = 1024, DFF = 2816, MTOK = 81920, MP = 65536, SP = 4096, SS = 8192;
constexpr int PROJW = 2048;
constexpr float LOG2E = 1.4426950408889634f;
constexpr float QSCALE = 0.125f * LOG2E;
constexpr float ALPHA = 1.4142135623730951f;
constexpr size_t MiB = 1u << 20;
constexpr size_t WS_PAR = 0;
constexpr size_t WS_NRM = 256 * 1024;
constexpr int NRM_KN = 2 * 320 * 8;
constexpr size_t WS_BAR = 512 * 1024;
constexpr size_t WS_WGU = 1 * MiB;
constexpr size_t WS_WD = 45 * MiB;
constexpr size_t WS_WIN = 67 * MiB;
constexpr size_t WS_WF = 75 * MiB;
constexpr size_t WS_WOUT = 77 * MiB;
constexpr size_t WS_WG = 81 * MiB;
constexpr size_t WS_DFT = 82 * MiB;
constexpr size_t WS_AGG = 210 * MiB;
constexpr size_t WS_STATS = 215 * MiB;
constexpr size_t WS_ONES = WS_STATS + 768 * 1024;
constexpr size_t WS_PROJ = 216 * MiB;
constexpr size_t WS_BTF = 536 * MiB;
constexpr size_t WS_XC = 632 * MiB;
constexpr size_t WS_YMIX = 672 * MiB;
constexpr size_t WS_AU = 832 * MiB;
constexpr size_t WS_XB = WS_AU;
constexpr size_t WS_H = WS_PROJ;
constexpr size_t WS_PART = 992 * MiB;
constexpr size_t WS_END = 1008 * MiB;
static_assert(WS_H + (size_t)MTOK * DFF * 2 <= WS_YMIX, "H overlay");
constexpr int LDS_BYTES = 147456;

DEV unsigned pk2(float lo, float hi) { f32x2 v = {lo, hi}; bf16x2_t b = __builtin_convertvector(v, bf16x2_t); return __builtin_bit_cast(unsigned, b); }
DEV float bf2f(unsigned short b) { return __uint_as_float((unsigned)b << 16); }
DEV float bflo(unsigned w) { return __uint_as_float(w << 16); }
DEV float bfhi(unsigned w) { return __uint_as_float(w & 0xffff0000u); }
DEV float lane_xor(float v, int lane, int o) { return __int_as_float(__builtin_amdgcn_ds_bpermute((lane ^ o) << 2, __float_as_int(v))); }
DEV float wave_sum(float v, int lane) {
#pragma unroll
    for (int o = 1; o < 64; o <<= 1) v += lane_xor(v, lane, o);
    return v;
}
DEV float sigmoidf_(float x) { return __builtin_amdgcn_rcpf(1.f + __builtin_amdgcn_exp2f(-LOG2E * x)); }

namespace epi {
using pg8::Unit; using pg8::HALF; using pg8::BM;
struct SwiGLU {
    static constexpr bool PERM = true, AFTER_DRAIN = false;
    bf16* H;
    DEV void operator()(const f32x4 (&acc)[2][2][4][2], const Unit& u, int wr, int wc, int fr_, int fq_) const {
        int t__ = threadIdx.x; asm volatile("" : "+v"(t__)); const int fr = t__ & 15, fq = (t__ >> 4) & 3; (void)fr_; (void)fq_;
        const int col0 = u.pn * 128 + wc * 32 + 8 * fq;
#pragma unroll
        for (int ai = 0; ai < 2; ++ai)
#pragma unroll
            for (int m = 0; m < 4; ++m) {
                const int row = u.pm * BM + ai * HALF + wr * 64 + m * 16 + fr;
                float o[8];
#pragma unroll
                for (int n = 0; n < 2; ++n)
#pragma unroll
                    for (int e = 0; e < 4; ++e) { const float g = acc[ai][0][m][n][e], up = acc[ai][1][m][n][e]; o[4 * n + e] = g * sigmoidf_(g) * up; }
                u32x4 w; w.x = pk2(o[0], o[1]); w.y = pk2(o[2], o[3]); w.z = pk2(o[4], o[5]); w.w = pk2(o[6], o[7]);
                *(u32x4*)(H + (size_t)row * DFF + col0) = w; asm volatile("" ::: "memory");
            }
    }
};
struct Resid {
    static constexpr bool PERM = true, AFTER_DRAIN = false;
    float* X; float s; const float* stats; const float* g; const float* b; const float* r0; const float* r1; float al = ALPHA;
    DEV void operator()(const f32x4 (&acc)[2][2][4][2], const Unit& u, int wr, int wc, int fr_, int fq_) const {
        int t__ = threadIdx.x; asm volatile("" : "+v"(t__)); const int fr = t__ & 15, fq = (t__ >> 4) & 3; (void)fr_; (void)fq_;
        const int colb = u.pn * BM + wc * 32 + 8 * fq;
        const float* rsrc = (u.pm * BM < MP) ? r0 : r1 - (size_t)MP * DM;
        f32x4 gv[2][2], bv[2][2];
#pragma unroll
        for (int bj = 0; bj < 2; ++bj)
#pragma unroll
            for (int n = 0; n < 2; ++n) { gv[bj][n] = *(const f32x4*)(g + colb + bj * HALF + n * 4); bv[bj][n] = *(const f32x4*)(b + colb + bj * HALF + n * 4); }
#pragma unroll
        for (int ai = 0; ai < 2; ++ai)
#pragma unroll
            for (int m = 0; m < 4; ++m) {
                const size_t row = (size_t)(u.pm * BM + ai * HALF + wr * 64 + m * 16 + fr);
                const f32x2 st = *(const f32x2*)(stats + row * 2);
                float* rp = X + row * DM + colb; const float* rq = rsrc + row * DM + colb;
#pragma unroll
                for (int bj = 0; bj < 2; ++bj)
#pragma unroll
                    for (int n = 0; n < 2; ++n) { f32x4* p = (f32x4*)(rp + bj * HALF + n * 4); const f32x4 yv = *(const f32x4*)(rq + bj * HALF + n * 4); const f32x4 x = ((yv - st[0]) * st[1]) * gv[bj][n] + bv[bj][n]; *p = x * al + acc[ai][bj][m][n] * s; }
                asm volatile("" ::: "memory");
            }
    }
};
struct Proj {
    static constexpr bool PERM = true, AFTER_DRAIN = false;
    bf16* P;
    DEV void operator()(const f32x4 (&acc)[2][2][4][2], const Unit& u, int wr, int wc, int fr_, int fq_) const {
        int t__ = threadIdx.x; asm volatile("" : "+v"(t__)); const int fr = t__ & 15, fq = (t__ >> 4) & 3; (void)fr_; (void)fq_;
        const float sc = (u.pn == 2 || u.pn == 3) ? QSCALE : 1.f;
        const int col0 = u.pn * BM + wc * 32 + 8 * fq;
#pragma unroll
        for (int ai = 0; ai < 2; ++ai)
#pragma unroll
            for (int m = 0; m < 4; ++m) {
                bf16* rp = P + (size_t)(u.pm * BM + ai * HALF + wr * 64 + m * 16 + fr) * PROJW + col0;
#pragma unroll
                for (int bj = 0; bj < 2; ++bj) { const f32x4 v0 = acc[ai][bj][m][0] * sc, v1 = acc[ai][bj][m][1] * sc;
                    u32x4 w; w.x = pk2(v0[0], v0[1]); w.y = pk2(v0[2], v0[3]); w.z = pk2(v1[0], v1[1]); w.w = pk2(v1[2], v1[3]);
                    *(u32x4*)(rp + bj * HALF) = w; }
                asm volatile("" ::: "memory");
            }
    }
};
struct FT {
    static constexpr bool PERM = true, AFTER_DRAIN = false;
    bf16* BP;
    DEV void operator()(const f32x4 (&acc)[2][2][4][2], const Unit& u, int wr, int wc, int fr_, int fq_) const {
        int t__ = threadIdx.x; asm volatile("" : "+v"(t__)); const int fr = t__ & 15, fq = (t__ >> 4) & 3; (void)fr_; (void)fq_;
        const int which = u.pm;
#pragma unroll
        for (int ai = 0; ai < 2; ++ai)
#pragma unroll
            for (int m = 0; m < 4; ++m) {
                const int n = ai * HALF + wr * 64 + m * 16 + fr;
#pragma unroll
                for (int bj = 0; bj < 2; ++bj) {
                    const int t0 = u.pn * BM + bj * HALF + wc * 32 + 8 * fq;
                    const f32x4 v0 = acc[ai][bj][m][0], v1 = acc[ai][bj][m][1];
                    if (t0 < MP) {
                        const int seq = t0 >> 12, s = t0 & 4095;
                        u32x4 w; w.x = pk2(v0[0], v0[1]); w.y = pk2(v0[2], v0[3]); w.z = pk2(v1[0], v1[1]); w.w = pk2(v1[2], v1[3]);
                        *(u32x4*)(BP + ((size_t)seq * 256 + n) * 8192 + which * 4096 + s) = w;
                    } else {
                        const int tt = t0 - MP, seq2 = tt >> 13, s = tt & 8191;
                        u32x2 ev, od; ev.x = pk2(v0[0], v0[2]); ev.y = pk2(v1[0], v1[2]); od.x = pk2(v0[1], v0[3]); od.y = pk2(v1[1], v1[3]);
                        bf16* be = BP + ((size_t)(16 + seq2 * 2) * 256 + n) * 8192 + which * 4096 + (s >> 1);
                        *(u32x2*)be = ev; *(u32x2*)(be + (size_t)256 * 8192) = od;
                    }
                }
                asm volatile("" ::: "memory");
            }
    }
};
struct DFT {
    static constexpr bool PERM = true, AFTER_DRAIN = false;
    bf16* Y; float* PART; float scale;
    DEV void operator()(const f32x4 (&acc)[2][2][4][2], const Unit& u, int wr, int wc, int fr_, int fq_) const {
        int t__ = threadIdx.x; asm volatile("" : "+v"(t__)); const int fr = t__ & 15, fq = (t__ >> 4) & 3; (void)fr_; (void)fq_;
        const int col0 = wc * 32 + 8 * fq;
        if (u.z < 16) {
#pragma unroll
            for (int ai = 0; ai < 2; ++ai)
#pragma unroll
                for (int m = 0; m < 4; ++m) {
                    bf16* rp = Y + (size_t)(u.z * SP + u.pm * BM + ai * HALF + wr * 64 + m * 16 + fr) * DM + 768 + col0;
#pragma unroll
                    for (int bj = 0; bj < 2; ++bj) { const f32x4 v0 = acc[ai][bj][m][0] * scale, v1 = acc[ai][bj][m][1] * scale;
                        u32x4 w; w.x = pk2(v0[0], v0[1]); w.y = pk2(v0[2], v0[3]); w.z = pk2(v1[0], v1[1]); w.w = pk2(v1[2], v1[3]);
                        *(u32x4*)(rp + bj * HALF) = w; }
                    asm volatile("" ::: "memory");
                }
        } else {
#pragma unroll
            for (int ai = 0; ai < 2; ++ai)
#pragma unroll
                for (int m = 0; m < 4; ++m) {
                    float* rp = PART + ((size_t)(u.z - 16) * 4096 + (u.pm & 15) * BM + ai * HALF + wr * 64 + m * 16 + fr) * 256 + col0;
#pragma unroll
                    for (int bj = 0; bj < 2; ++bj) { *(f32x4*)(rp + bj * HALF) = acc[ai][bj][m][0]; *(f32x4*)(rp + bj * HALF + 4) = acc[ai][bj][m][1]; }
                    asm volatile("" ::: "memory");
                }
        }
    }
};
struct DftOrder {
    int G, c;
    DEV bool next(int i, Unit& u) const { const int L = i * G + c; if (L >= 320) return false; u.pn = 0;
        if (L < 288) { const int pmA = L / 18, zi = L - pmA * 18; u.pm = pmA; u.z = zi < 16 ? zi : 16 + 2 * (zi - 16); }
        else { const int L2 = L - 288; u.pm = 16 + (L2 >> 1); u.z = 17 + 2 * (L2 & 1); }
        return true; }
    DEV void a_ready(const Unit&) const {}
    DEV void done(const Unit&) const {}
};
struct Raw {
    static constexpr bool PERM = true, AFTER_DRAIN = false;
    bf16* P;
    DEV void operator()(const f32x4 (&acc)[2][2][4][2], const Unit& u, int wr, int wc, int fr_, int fq_) const {
        int t__ = threadIdx.x; asm volatile("" : "+v"(t__)); const int fr = t__ & 15, fq = (t__ >> 4) & 3; (void)fr_; (void)fq_;
        const int col0 = u.pn * BM + wc * 32 + 8 * fq;
#pragma unroll
        for (int ai = 0; ai < 2; ++ai)
#pragma unroll
            for (int m = 0; m < 4; ++m) {
                bf16* rp = P + (size_t)(u.pm * BM + ai * HALF + wr * 64 + m * 16 + fr) * 1024 + col0;
#pragma unroll
                for (int bj = 0; bj < 2; ++bj) { const f32x4 v0 = acc[ai][bj][m][0], v1 = acc[ai][bj][m][1];
                    u32x4 w; w.x = pk2(v0[0], v0[1]); w.y = pk2(v0[2], v0[3]); w.z = pk2(v1[0], v1[1]); w.w = pk2(v1[2], v1[3]);
                    *(u32x4*)(rp + bj * HALF) = w; }
                asm volatile("" ::: "memory");
            }
    }
};
struct BatchOrder {
    int lz, nM, G, c;
    DEV bool next(int i, Unit& u) const { const int L = i * G + c; if (L >= (nM << lz)) return false; u.pm = L >> lz; u.z = L & ((1 << lz) - 1); u.pn = 0; return true; }
    DEV void a_ready(const Unit&) const {}
    DEV void done(const Unit&) const {}
};
}
struct Ctx {
    const float* const* in; float* out; unsigned char* ws;
    int tid, lane, wave, G, bid;
};
#ifndef RPA
#define RPA 1
#endif
#ifndef RPB
#define RPB 1
#endif
#ifndef RPE
#define RPE 1
#endif
#ifndef RPF
#define RPF 1
#endif
DEV void transpose_item(const float* W, int ldw, int srccol0, bf16* WT, int ldo, int dstrow0, int k0, LAS float* scr, int lane) {
#pragma unroll 8
    for (int i = 0; i < 32; ++i) { const int kk = 2 * i + (lane >> 5); scr[kk * 33 + (lane & 31)] = W[(size_t)(k0 + kk) * ldw + srccol0 + (lane & 31)]; }
    asm volatile("s_waitcnt lgkmcnt(0)" ::: "memory");
    const int c = lane & 7;
#pragma unroll
    for (int j = 0; j < 4; ++j) { const int n = (lane >> 3) + 8 * j; const LAS float* s = scr + (8 * c) * 33 + n;
        u32x4 o; o.x = pk2(s[0 * 33], s[1 * 33]); o.y = pk2(s[2 * 33], s[3 * 33]); o.z = pk2(s[4 * 33], s[5 * 33]); o.w = pk2(s[6 * 33], s[7 * 33]);
        *(u32x4*)(WT + (size_t)(dstrow0 + n) * ldo + k0 + 8 * c) = o; }
    asm volatile("s_waitcnt lgkmcnt(0)" ::: "memory");
}
DEV void phase_prologue(const Ctx& C, LAS unsigned char* lds) {
    const int gw = C.bid * 8 + C.wave, NGW = C.G * 8;
    const long gt = (long)C.bid * 512 + C.tid, NGT = (long)C.G * 512;
    unsigned char* ws = C.ws;
for (int rp_ = 0; rp_ < RPA; ++rp_) {
    {
        LAS float* scr = (LAS float*)(lds + C.wave * 16384);
        for (int it = gw; it < 2 * 9984; it += NGW) {
            const int l = it / 9984, r = it % 9984; int j, q;
            if (r < 8448) { j = r / 1408; q = r % 1408; } else if (r < 9472) { j = 6; q = r - 8448; } else { j = 7; q = r - 9472; }
            const float* src; int ldw, K, N; bf16* dst; int inter = 0, ioff = 0;
            if (j == 0 || j == 1 || j == 3 || j == 4) { const int f = j >= 3; const int up = (j == 1 || j == 4);
                src = C.in[(f ? 7 : 4) + up] + (size_t)l * DM * DFF; ldw = DFF; K = DM; N = DFF; dst = (bf16*)(ws + WS_WGU) + (size_t)(l * 2 + f) * 5632 * 1024; inter = 1; ioff = up ? 128 : 0; }
            else if (j == 2 || j == 5) { const int f = j == 5; src = C.in[f ? 9 : 6] + (size_t)l * DFF * DM; ldw = DM; K = DFF; N = DM; dst = (bf16*)(ws + WS_WD) + (size_t)(l * 2 + f) * 1024 * 2816; }
            else if (j == 6) { src = C.in[10] + (size_t)l * DM * 2304; ldw = 2304; K = DM; N = 2048; dst = (bf16*)(ws + WS_WIN) + (size_t)l * 2048 * 1024; }
            else { src = C.in[20] + (size_t)l * DM * DM; ldw = DM; K = DM; N = DM; dst = (bf16*)(ws + WS_WOUT) + (size_t)l * 1024 * 1024; }
            const int nblk = N / 32, kb = q / nblk, nb = q % nblk, n0 = 32 * nb;
            const int drow = inter ? (256 * (n0 >> 7) + (n0 & 127) + ioff) : n0;
            transpose_item(src, ldw, n0, dst, K, drow, 64 * kb, scr, C.lane);
        }
    }
}
    for (int rp_ = 0; rp_ < RPB; ++rp_) {
    {
        LAS float* tw = (LAS float*)(lds + 8 * 16384);
        if (C.tid < 64) { float sn, cs; sincospif((float)C.tid * (1.0f / 32.0f), &sn, &cs); tw[C.tid] = cs; tw[64 + C.tid] = sn; }
        __syncthreads();
        for (long it = gt; it < 2L * 512 * 128; it += NGT) {
            const int l = (int)(it / (512 * 128)), r = (int)(it % (512 * 128)), nrow = r >> 7, k0 = (r & 127) * 8;
            const int which = nrow >> 8, g = (nrow >> 6) & 3, cp = nrow & 63;
            const float* wsrc = C.in[10] + (size_t)l * DM * 2304 + 2048 + 64 * g;
            float o[8];
#pragma unroll
            for (int kk = 0; kk < 8; ++kk) {
                const float* wr_ = wsrc + (size_t)(k0 + kk) * 2304; float a = 0.f;
                for (int c = 0; c < 64; c += 4) { const f32x4 w4 = *(const f32x4*)(wr_ + c);
                    a += w4[0] * tw[which * 64 + (((c + 0) * cp) & 63)] + w4[1] * tw[which * 64 + (((c + 1) * cp) & 63)] + w4[2] * tw[which * 64 + (((c + 2) * cp) & 63)] + w4[3] * tw[which * 64 + (((c + 3) * cp) & 63)]; }
                o[kk] = a;
            }
            u32x4 w; w.x = pk2(o[0], o[1]); w.y = pk2(o[2], o[3]); w.z = pk2(o[4], o[5]); w.w = pk2(o[6], o[7]);
            *(u32x4*)((bf16*)(ws + WS_WF) + ((size_t)l * 512 + nrow) * 1024 + k0) = w;
        }
    }
}
    for (long it = gt; it < 2L * 1024 * 32; it += NGT) {
        const int l = (int)(it / (1024 * 32)), r = (int)(it % (1024 * 32)), n = r >> 5, k0 = (r & 31) * 8;
        const int tn = n >> 8, dir = tn >> 1, chh = tn & 1, within = n & 255, gate = within >> 7, ch = chh * 128 + (within & 127), hb = ch >> 6, jj = ch & 63;
        u32x4 w = {0u, 0u, 0u, 0u};
        if ((k0 >> 6) == hb) {
            const float* src = C.in[gate ? 15 : 13] + ((size_t)((l * 2 + dir) * 4 + hb) * 64) * 64 + jj;
            float o[8];
#pragma unroll
            for (int kk = 0; kk < 8; ++kk) o[kk] = src[(size_t)((k0 & 63) + kk) * 64];
            w.x = pk2(o[0], o[1]); w.y = pk2(o[2], o[3]); w.z = pk2(o[4], o[5]); w.w = pk2(o[6], o[7]);
        }
        *(u32x4*)((bf16*)(ws + WS_WG) + ((size_t)l * 1024 + n) * 256 + k0) = w;
    }
    if (gt < 1024) { const float lam = C.in[17][gt]; ((float*)(ws + WS_PAR))[gt] = 8.f * log1pf(expf(-lam)); }
    if (gt >= 1024 && gt < 1026) { const int l = (int)gt - 1024; const float* lq = C.in[18] + l * 256; float s1 = 0.f, s2 = 0.f;
        for (int i = 0; i < 64; ++i) { s1 += lq[i] * lq[64 + i]; s2 += lq[128 + i] * lq[192 + i]; }
        const float li = 0.8f - 0.6f * expf(-0.3f * (float)l);
        ((float*)(ws + WS_PAR))[1024 + l] = expf(s1) - expf(s2) + li; ((float*)(ws + WS_PAR))[1026 + l] = li; }
    if (gt < NRM_KN + 2 * 18 * 8) ((unsigned*)(ws + WS_NRM))[gt] = 0u;
    if (gt < MTOK) *(f32x2*)((float*)(ws + WS_STATS) + gt * 2) = (f32x2){0.f, 1.f};
    if (gt < 2048) ((float*)(ws + WS_ONES))[gt] = gt < 1024 ? 1.f : 0.f;
for (int rp_ = 0; rp_ < RPE; ++rp_) {
for (int rp_ = 0; rp_ < RPE; ++rp_) {
    for (long it = gt; it < 8192L * 1024; it += NGT) {
        const int row = (int)(it >> 10), k0 = (int)(it & 1023) * 8, odd = row >> 12, sp = row & 4095, neg = k0 >> 12, nb = k0 & 4095;
        float o[8];
#pragma unroll
        for (int e = 0; e < 8; ++e) { const int n = nb + e; float sn, cs;
            if (!odd) { const int idx = (n * sp) & 4095; sincospif((float)idx * (1.0f / 2048.0f), &sn, &cs); }
            else { const int idx = ((2 * n + 1) * sp) & 8191; sincospif((float)idx * (1.0f / 4096.0f), &sn, &cs); }
            o[e] = neg ? -sn : cs; }
        u32x4 w; w.x = pk2(o[0], o[1]); w.y = pk2(o[2], o[3]); w.z = pk2(o[4], o[5]); w.w = pk2(o[6], o[7]);
        __builtin_nontemporal_store(w, (u32x4*)((bf16*)(ws + WS_DFT) + (size_t)row * 8192 + k0));
    }
}
    {
        const f32x4* xp = (const f32x4*)C.in[0]; const f32x4* xs = (const f32x4*)C.in[1]; u32x2* xb = (u32x2*)(ws + WS_XB);
        const long NP = (long)MP * 256, NT = (long)MTOK * 256;
        for (long it = gt; it < NT; it += NGT) { const f32x4 v = __builtin_nontemporal_load(it < NP ? xp + it : xs + (it - NP));     u32x2 w; w.x = pk2(v[0], v[1]); w.y = pk2(v[2], v[3]); xb[it] = w; }
    }
}
}
DEV void ln_row(const f32x4 (&cur)[4], const f32x4 (&gv)[4], const f32x4 (&bv)[4], int m, int lane, float* out, unsigned char* ws, bool final_) {
    float s = 0.f, q = 0.f;
#pragma unroll
    for (int j = 0; j < 4; ++j) { s += (cur[j][0] + cur[j][1]) + (cur[j][2] + cur[j][3]); q += (cur[j][0] * cur[j][0] + cur[j][1] * cur[j][1]) + (cur[j][2] * cur[j][2] + cur[j][3] * cur[j][3]); }
#pragma unroll
    for (int o = 1; o < 64; o <<= 1) { const float s2 = lane_xor(s, lane, o), q2 = lane_xor(q, lane, o); s += s2; q += q2; }
    const float mean = s * (1.f / DM), var = __builtin_fmaxf(q * (1.f / DM) - mean * mean, 0.f), rstd = 1.f / sqrtf(var + 1e-5f);
    if (final_) {
        f32x4* xr = (f32x4*)(out + (size_t)m * DM) + lane;
#pragma unroll
        for (int j = 0; j < 4; ++j) __builtin_nontemporal_store((cur[j] - mean) * rstd * gv[j] + bv[j], xr + 64 * j);
    } else {
        u32x2* o8 = (u32x2*)((bf16*)(ws + WS_XB) + (size_t)m * DM) + lane;
#pragma unroll
        for (int j = 0; j < 4; ++j) { const f32x4 y = (cur[j] - mean) * rstd * gv[j] + bv[j]; u32x2 w; w.x = pk2(y[0], y[1]); w.y = pk2(y[2], y[3]); o8[64 * j] = w; }
        if (lane == 0) *(f32x2*)((float*)(ws + WS_STATS) + (size_t)m * 2) = (f32x2){mean, rstd};
    }
}
DEV void phase_ln(const Ctx& C, const float* g, const float* b, bool final_) {
    const int gw = C.bid * 8 + C.wave, NGW = C.G * 8, lane = C.lane;
    f32x4 gv[4], bv[4];
#pragma unroll
    for (int j = 0; j < 4; ++j) { gv[j] = ((const f32x4*)g)[lane + 64 * j]; bv[j] = ((const f32x4*)b)[lane + 64 * j]; }
    f32x4 c0[4], c1[4], n0[4], n1[4];
    auto ld = [&](f32x4 (&d)[4], int m) { const int mm = m < MTOK ? m : gw;
#pragma unroll
        for (int j = 0; j < 4; ++j) d[j] = __builtin_nontemporal_load((const f32x4*)(C.out + (size_t)mm * DM) + lane + 64 * j); };
    ld(c0, gw); ld(c1, gw + NGW);
    for (int m = gw; m < MTOK; m += 2 * NGW) {
        ld(n0, m + 2 * NGW); ld(n1, m + 3 * NGW);
        ln_row(c0, gv, bv, m, lane, C.out, C.ws, final_);
        if (m + NGW < MTOK) ln_row(c1, gv, bv, m + NGW, lane, C.out, C.ws, final_);
#pragma unroll
        for (int j = 0; j < 4; ++j) { c0[j] = n0[j]; c1[j] = n1[j]; }
    }
}
DEV void phase_dft_combine(const Ctx& C) {
    const long gt = (long)C.bid * 512 + C.tid, NGT = (long)C.G * 512;
    const float* PART = (const float*)(C.ws + WS_PART); bf16* Y = (bf16*)(C.ws + WS_YMIX); const float sc = 0.001381067932004976f;
    for (long it = gt; it < 2L * 4096 * 64; it += NGT) {
        const int seq2 = (int)(it >> 18), r = (int)(it & 262143), sp = r >> 6, c = (r & 63) * 4;
        const f32x4 p1 = *(const f32x4*)(PART + ((size_t)(seq2 * 2) * 4096 + sp) * 256 + c), p2 = *(const f32x4*)(PART + ((size_t)(seq2 * 2 + 1) * 4096 + sp) * 256 + c);
        const f32x4 lo = (p1 + p2) * sc, hi = (p1 - p2) * sc;
        u32x2 wl, wh; wl.x = pk2(lo[0], lo[1]); wl.y = pk2(lo[2], lo[3]); wh.x = pk2(hi[0], hi[1]); wh.y = pk2(hi[2], hi[3]);
        bf16* yl = Y + (size_t)(MP + seq2 * SS + sp) * DM + 768 + c;
        *(u32x2*)yl = wl; *(u32x2*)(yl + (size_t)4096 * DM) = wh;
    }
}
DEV void phase_conv(const Ctx& C, int l) {
    const long gt = (long)C.bid * 512 + C.tid, NGT = (long)C.G * 512;
    const bf16* P = (const bf16*)(C.ws + WS_PROJ); bf16* XC = (bf16*)(C.ws + WS_XC);
    const float* cw = C.in[11] + l * 4 * 256; const float* cb = C.in[12] + l * 256;
    for (long it = gt; it < (long)MTOK * 32; it += NGT) {
        const int tok = (int)(it >> 5), c0 = (int)(it & 31) * 8;
        const int pos = tok < MP ? (tok & 4095) : ((tok - MP) & 8191), S = tok < MP ? SP : SS;
        float a[8];
        { const f32x4 b0 = *(const f32x4*)(cb + c0), b1 = *(const f32x4*)(cb + c0 + 4); a[0] = b0[0]; a[1] = b0[1]; a[2] = b0[2]; a[3] = b0[3]; a[4] = b1[0]; a[5] = b1[1]; a[6] = b1[2]; a[7] = b1[3]; }
#pragma unroll
        for (int j = 0; j < 4; ++j) { const int tt = pos - 2 + j;
            if (tt >= 0 && tt < S) { const u32x4 xw = *(const u32x4*)(P + (size_t)(tok - 2 + j) * PROJW + c0);
                const f32x4 w0 = *(const f32x4*)(cw + j * 256 + c0), w1 = *(const f32x4*)(cw + j * 256 + c0 + 4);
                a[0] += w0[0] * bflo(xw.x); a[1] += w0[1] * bfhi(xw.x); a[2] += w0[2] * bflo(xw.y); a[3] += w0[3] * bfhi(xw.y);
                a[4] += w1[0] * bflo(xw.z); a[5] += w1[1] * bfhi(xw.z); a[6] += w1[2] * bflo(xw.w); a[7] += w1[3] * bfhi(xw.w); } }
        u32x4 w; w.x = pk2(a[0], a[1]); w.y = pk2(a[2], a[3]); w.z = pk2(a[4], a[5]); w.w = pk2(a[6], a[7]);
        *(u32x4*)(XC + (size_t)tok * 256 + c0) = w;
    }
    unsigned* QN = (unsigned*)(C.ws + WS_NRM) + l * 320 * 8; unsigned* KN = (unsigned*)(C.ws + WS_NRM) + NRM_KN + l * 18 * 8;
    for (long it = gt; it < (long)MTOK * 8; it += NGT) {
        const int tok = (int)(it >> 3), hm = (int)(it & 7);
        const bf16* qp = P + (size_t)tok * PROJW + 512 + hm * 64; float sq = 0.f, sk = 0.f;
#pragma unroll
        for (int j = 0; j < 8; ++j) { const u32x4 a = *(const u32x4*)(qp + 8 * j), k4 = *(const u32x4*)(qp + 512 + 8 * j);
            sq += bflo(a.x) * bflo(a.x) + bfhi(a.x) * bfhi(a.x) + bflo(a.y) * bflo(a.y) + bfhi(a.y) * bfhi(a.y) + bflo(a.z) * bflo(a.z) + bfhi(a.z) * bfhi(a.z) + bflo(a.w) * bflo(a.w) + bfhi(a.w) * bfhi(a.w);
            sk += bflo(k4.x) * bflo(k4.x) + bfhi(k4.x) * bfhi(k4.x) + bflo(k4.y) * bflo(k4.y) + bfhi(k4.y) * bfhi(k4.y) + bflo(k4.z) * bflo(k4.z) + bfhi(k4.z) * bfhi(k4.z) + bflo(k4.w) * bflo(k4.w) + bfhi(k4.w) * bfhi(k4.w); }
#pragma unroll
        for (int o = 8; o < 64; o <<= 1) { sq = fmaxf(sq, lane_xor(sq, C.lane, o)); sk = fmaxf(sk, lane_xor(sk, C.lane, o)); }
        if (C.lane < 8) { const int seq = tok < MP ? (tok >> 12) : 16 + ((tok - MP) >> 13);
            atomicMax(QN + (tok >> 8) * 8 + hm, __float_as_uint(sq)); atomicMax(KN + seq * 8 + hm, __float_as_uint(sk)); }
    }
}
DEV float fsig(float x) { return __builtin_amdgcn_rcpf(1.f + __builtin_amdgcn_exp2f(-LOG2E * x)); }
DEV void gate_eval(float rp, float ip, float xc, float ba, float bx, float sp8, float& la2, float& u) {
    const float r = fsig(rp + ba), ig = fsig(ip + bx);
    la2 = -sp8 * r * LOG2E;
    const float em = __builtin_fmaxf(1.f - __builtin_amdgcn_exp2f(2.f * la2), 0.f);
    u = __builtin_amdgcn_sqrtf(em) * ig * xc;
}
DEV float gelu_tanh(float x) { const float z = 0.7978845608028654f * (x + 0.044715f * x * x * x); const float e = __builtin_amdgcn_exp2f(2.f * LOG2E * z); return 0.5f * x * (2.f - 2.f * __builtin_amdgcn_rcpf(e + 1.f)); }
constexpr int SROW = 68;
typedef _Float16 h16x2 __attribute__((ext_vector_type(2)));
DEV unsigned pkh(float a, float b) { return __builtin_bit_cast(unsigned, __builtin_amdgcn_cvt_pkrtz(a, b)); }
template <int DIRV> DEV void gate_stage(const bf16* gbase, const bf16* xcb, int chb, int tl, int cg, LAS unsigned* sl, const float* pba, const float* pbx, const float* par) {
    const int col = (DIRV * 2 + (chb >> 7)) * 256 + (chb & 127);
    float ba[8], bx[8], sp[8];
#pragma unroll
    for (int q = 0; q < 2; ++q) { const f32x4 a = *(const f32x4*)(pba + DIRV * 256 + chb + 4 * q), b = *(const f32x4*)(pbx + DIRV * 256 + chb + 4 * q), s = *(const f32x4*)(par + DIRV * 256 + chb + 4 * q);
#pragma unroll
        for (int e = 0; e < 4; ++e) { ba[4 * q + e] = a[e]; bx[4 * q + e] = b[e]; sp[4 * q + e] = s[e]; } }
#pragma unroll
    for (int j = 0; j < 8; ++j) {
        const int t = 8 * j + tl;
        const u32x4 rw = *(const u32x4*)(gbase + (size_t)t * 1024 + col), iw = *(const u32x4*)(gbase + (size_t)t * 1024 + col + 128), xw = *(const u32x4*)(xcb + (size_t)t * 256);
        const float rp[8] = {bflo(rw.x), bfhi(rw.x), bflo(rw.y), bfhi(rw.y), bflo(rw.z), bfhi(rw.z), bflo(rw.w), bfhi(rw.w)};
        const float ip[8] = {bflo(iw.x), bfhi(iw.x), bflo(iw.y), bfhi(iw.y), bflo(iw.z), bfhi(iw.z), bflo(iw.w), bfhi(iw.w)};
        const float xc[8] = {bflo(xw.x), bfhi(xw.x), bflo(xw.y), bfhi(xw.y), bflo(xw.z), bfhi(xw.z), bflo(xw.w), bfhi(xw.w)};
        unsigned w[8];
#pragma unroll
        for (int e = 0; e < 8; ++e) { float la, u; gate_eval(rp[e], ip[e], xc[e], ba[e], bx[e], sp[e], la, u); w[e] = pkh(la, u); }
        LAS u32x4* dst = (LAS u32x4*)(sl + t * SROW + cg * 8);
        dst[0] = (u32x4){w[0], w[1], w[2], w[3]}; dst[1] = (u32x4){w[4], w[5], w[6], w[7]};
    }
    asm volatile("s_waitcnt lgkmcnt(0)" ::: "memory");
}
template <bool FINAL> DEV void phase_scan(const Ctx& C, int l, LAS unsigned char* lds) {
    const int gw = C.bid * 8 + C.wave, NGW = C.G * 8, lane = C.lane, tl = lane >> 3, cg = lane & 7;
    const bf16* GP = (const bf16*)(C.ws + WS_AU); float* AGG = (float*)(C.ws + WS_AGG); const bf16* XC = (const bf16*)(C.ws + WS_XC);
    const bf16* P = (const bf16*)(C.ws + WS_PROJ); bf16* Y = (bf16*)(C.ws + WS_YMIX);
    const float* par = (const float*)(C.ws + WS_PAR) + l * 512; const float* pba = C.in[14] + l * 512; const float* pbx = C.in[16] + l * 512;
    LAS unsigned* sl = (LAS unsigned*)(lds + C.wave * (64 * SROW * 4));
    for (int it = gw; it < 1280 * 4; it += NGW) {
        const int cidx = it >> 2, g4 = it & 3, ch = g4 * 64 + lane, chb = g4 * 64 + cg * 8;
        const bf16* gbase = GP + (size_t)cidx * 64 * 1024; const bf16* xcb = XC + (size_t)cidx * 64 * 256 + chb;
        if (!FINAL) {
            gate_stage<0>(gbase, xcb, chb, tl, cg, sl, pba, pbx, par);
            { float Ps = 0.f, h = 0.f;
#pragma unroll 16
              for (int t = 0; t < 64; ++t) { const h16x2 w = __builtin_bit_cast(h16x2, sl[t * SROW + lane]); const float la = (float)w[0]; h = __builtin_amdgcn_exp2f(la) * h + (float)w[1]; Ps += la; }
              *(f32x2*)(AGG + ((size_t)(cidx * 2 + 0) * 256 + ch) * 2) = (f32x2){Ps, h}; }
            asm volatile("s_waitcnt lgkmcnt(0)" ::: "memory");
            gate_stage<1>(gbase, xcb, chb, tl, cg, sl, pba, pbx, par);
            { float Ps = 0.f, h = 0.f;
#pragma unroll 16
              for (int t = 63; t >= 0; --t) { const h16x2 w = __builtin_bit_cast(h16x2, sl[t * SROW + lane]); const float la = (float)w[0]; h = __builtin_amdgcn_exp2f(la) * h + (float)w[1]; Ps += la; }
              *(f32x2*)(AGG + ((size_t)(cidx * 2 + 1) * 256 + ch) * 2) = (f32x2){Ps, h}; }
            asm volatile("s_waitcnt lgkmcnt(0)" ::: "memory");
        } else {
            int c0, c1; if (cidx < 1024) { c0 = cidx & ~63; c1 = c0 + 64; } else { c0 = 1024 + ((cidx - 1024) & ~127); c1 = c0 + 128; }
            float hin = 0.f, hbin = 0.f;
#pragma unroll 16
            for (int c = c0; c < cidx; ++c) { const f32x2 a = *(const f32x2*)(AGG + ((size_t)(c * 2 + 0) * 256 + ch) * 2); hin = __builtin_amdgcn_exp2f(a[0]) * hin + a[1]; }
#pragma unroll 16
            for (int c = c1 - 1; c > cidx; --c) { const f32x2 a = *(const f32x2*)(AGG + ((size_t)(c * 2 + 1) * 256 + ch) * 2); hbin = __builtin_amdgcn_exp2f(a[0]) * hbin + a[1]; }
            gate_stage<0>(gbase, xcb, chb, tl, cg, sl, pba, pbx, par);
            float hf[64]; float h = hin;
#pragma unroll
            for (int t = 0; t < 64; ++t) { const h16x2 w = __builtin_bit_cast(h16x2, sl[t * SROW + lane]); h = __builtin_amdgcn_exp2f((float)w[0]) * h + (float)w[1]; hf[t] = h; }
            asm volatile("s_waitcnt lgkmcnt(0)" ::: "memory");
            gate_stage<1>(gbase, xcb, chb, tl, cg, sl, pba, pbx, par);
            h = hbin;
#pragma unroll
            for (int t = 63; t >= 0; --t) { const h16x2 w = __builtin_bit_cast(h16x2, sl[t * SROW + lane]); h = __builtin_amdgcn_exp2f((float)w[0]) * h + (float)w[1]; sl[t * SROW + lane] = __float_as_uint(hf[t] + h); }
            asm volatile("s_waitcnt lgkmcnt(0)" ::: "memory");
#pragma unroll
            for (int j = 0; j < 8; ++j) {
                const int t = 8 * j + tl; const size_t tok = (size_t)cidx * 64 + t;
                const LAS u32x4* src = (const LAS u32x4*)(sl + t * SROW + cg * 8); const u32x4 s0 = src[0], s1 = src[1];
                const u32x4 gw_ = *(const u32x4*)(P + tok * PROJW + 256 + chb);
                u32x4 o;
                o.x = pk2(gelu_tanh(bflo(gw_.x)) * __uint_as_float(s0.x), gelu_tanh(bfhi(gw_.x)) * __uint_as_float(s0.y));
                o.y = pk2(gelu_tanh(bflo(gw_.y)) * __uint_as_float(s0.z), gelu_tanh(bfhi(gw_.y)) * __uint_as_float(s0.w));
                o.z = pk2(gelu_tanh(bflo(gw_.z)) * __uint_as_float(s1.x), gelu_tanh(bfhi(gw_.z)) * __uint_as_float(s1.y));
                o.w = pk2(gelu_tanh(bflo(gw_.w)) * __uint_as_float(s1.z), gelu_tanh(bfhi(gw_.w)) * __uint_as_float(s1.w));
                *(u32x4*)(Y + tok * DM + chb) = o;
            }
            asm volatile("s_waitcnt lgkmcnt(0)" ::: "memory");
        }
    }
}
namespace att {
constexpr int KROW = 272, VROW = 320, KBUF = 32 * KROW, VBUF = 32 * VROW, LDS_K = 0, LDS_V = 2 * KBUF, LDS_Q = 2 * KBUF + 2 * VBUF;
static_assert(LDS_Q + 256 * KROW + 16 <= LDS_BYTES, "attention LDS");
typedef short v4i16_t __attribute__((ext_vector_type(4)));
DEV s16x4 vtr(const LAS unsigned char* p) { return __builtin_bit_cast(s16x4, __builtin_amdgcn_ds_read_tr16_b64_v4i16((LAS v4i16_t*)p)); }


DEV void attn_unit(const bf16* PROJ, bf16* YMIX, int tok0, int S, int head, int qb, float lam, float oscale, const float* subg, float Bnd, LAS unsigned char* lds) {
    int tid_ = threadIdx.x; asm volatile("" : "+v"(tid_));
    const int tid = tid_, lane = tid & 63, r32 = lane & 31, hi = lane >> 5, wid = __builtin_amdgcn_readfirstlane(tid >> 6);
    const int qpos = qb * 256 + wid * 32 + r32;
    LAS unsigned char* qlds = lds + LDS_Q + wid * 32 * KROW;
    { const bf16* qg = PROJ + (size_t)(tok0 + qb * 256 + wid * 32) * PROJW + 512 + head * 128;
#pragma unroll
      for (int i = 0; i < 8; ++i) { const int ch = lane + 64 * i, row = ch >> 4, c16 = ch & 15; const u32x4 v = *(const u32x4*)(qg + (size_t)row * PROJW + c16 * 8); *(LAS u32x4*)(qlds + row * KROW + c16 * 16) = v; } }
    const LAS unsigned char* qfb = qlds + r32 * KROW + hi * 16;
    const float sl2 = __builtin_amdgcn_exp2f(-2.f * (float)(head + 1)) * LOG2E;
    const int srow = tid >> 4, sc16 = tid & 15;
    const bf16* kg = PROJ + (size_t)(tok0 + srow) * PROJW + 1024 + head * 128 + sc16 * 8;
    const bf16* vg = kg + 512;
    LAS unsigned char* kst = lds + LDS_K + srow * KROW + sc16 * 16;
    LAS unsigned char* vst = lds + LDS_V + srow * VROW + sc16 * 16;
    const LAS unsigned char* kfb = lds + LDS_K + r32 * KROW + hi * 16;
    const int i16 = lane & 15, gq = i16 >> 2, gp = i16 & 3, g1 = (lane >> 4) & 1;
    const LAS unsigned char* vfb = lds + LDS_V + (4 * hi + gq) * VROW + (16 * g1 + 4 * gp) * 2;
    u32x4 kr0, vr0;
    { const size_t go0 = (size_t)(qb * 8) * 32 * PROJW; kr0 = *(const u32x4*)(kg + go0); vr0 = *(const u32x4*)(vg + go0); }
    *(LAS u32x4*)kst = kr0; *(LAS u32x4*)vst = vr0;
    __syncthreads();
    f32x16 O[2][4];
#pragma unroll
    for (int c = 0; c < 2; ++c)
#pragma unroll
        for (int d = 0; d < 4; ++d)
#pragma unroll
            for (int r = 0; r < 16; ++r) O[c][d][r] = 0.f;
    float mrun[2] = {-1e30f, -1e30f}, lrun[2] = {0.f, 0.f};
    const int ts = qb * 8, qw0 = qb * 256 + wid * 32;
    int t_lo = 0, t_hi = (S >> 5) - 1;
    { const float Df = (2.f * Bnd + 138.f) / sl2;     if (Df < (float)S) { const int D = (int)Df + 1; const int a_ = (qb * 256 - D) >> 5, b_ = (qb * 256 + 255 + D) >> 5; t_lo = a_ > 0 ? a_ : 0; t_hi = b_ < t_hi ? b_ : t_hi; } }
    const int NT = t_hi - t_lo + 1;
    f32x16 bcv; float csign = 1.f;
#pragma unroll
    for (int r = 0; r < 16; ++r) { float cr_ = (float)((r & 3) + 8 * (r >> 2)); asm volatile("" : "+v"(cr_)); bcv[r] = sl2 * cr_; }
    for (int i = 0; i < NT; ++i) {
        int t = ts + i; if (t > t_hi) t -= NT;
        int tn = t + 1; if (tn > t_hi) tn -= NT;
        const int cur = i & 1, k0 = t * 32;
        const LAS unsigned char* kb = kfb + cur * KBUF; const LAS unsigned char* vb = vfb + cur * VBUF;
        const float dqf = (float)(qpos - k0 - 4 * hi);
        const bool diag = (k0 == qw0);
        if (!diag) { const float want = (k0 < qw0) ? 1.f : -1.f;
            if (want != csign) { csign = want;
#pragma unroll
                for (int r = 0; r < 16; ++r) bcv[r] = -bcv[r]; } }
        const float lt = diag ? 0.f : -csign * sl2 * dqf;
        if (i + 1 < NT) { const size_t go = (size_t)tn * 32 * PROJW; kr0 = *(const u32x4*)(kg + go); vr0 = *(const u32x4*)(vg + go); }
        bf16x8 pf[2][2];
        f32x16 pp[2]; pp[0] = bcv; pp[1] = bcv;
#pragma unroll
        for (int c = 0; c < 2; ++c) {
            bf16x8 kf[4], qf[4];
#pragma unroll
            for (int ds = 0; ds < 4; ++ds) { kf[ds] = *(const LAS bf16x8*)(kb + (c * 64 + ds * 16) * 2); qf[ds] = *(const LAS bf16x8*)(qfb + (c * 64 + ds * 16) * 2); }
            __builtin_amdgcn_sched_barrier(0);
#pragma unroll
            for (int ds = 0; ds < 4; ++ds) pp[c] = __builtin_amdgcn_mfma_f32_32x32x16_bf16(kf[ds], qf[ds], pp[c], 0, 0, 0);
        }
        if (diag) {
#pragma unroll
            for (int r = 0; r < 16; ++r) { float cr = (float)((r & 3) + 8 * (r >> 2)); asm volatile("" : "+v"(cr)); const float fx = bcv[r] + sl2 * __builtin_fabsf(dqf - cr); pp[0][r] -= fx; pp[1][r] -= fx; }
        }
        float rm[2];
#pragma unroll
        for (int c = 0; c < 2; ++c) {
            float m_ = pp[c][0];
#pragma unroll
            for (int r = 1; r < 16; ++r) m_ = __builtin_fmaxf(m_, pp[c][r]);
            m_ += lt;
            auto rr = __builtin_amdgcn_permlane32_swap(__float_as_uint(m_), __float_as_uint(m_), false, false); rm[c] = __builtin_fmaxf(__uint_as_float(rr[0]), __uint_as_float(rr[1]));
        }
        if (__any(rm[0] > mrun[0] + 8.f || rm[1] > mrun[1] + 8.f)) {
#pragma unroll
            for (int c = 0; c < 2; ++c) {
                const float mnew = rm[c] > mrun[c] + 8.f ? rm[c] : mrun[c], alpha = __builtin_amdgcn_exp2f(mrun[c] - mnew);
                mrun[c] = mnew; lrun[c] *= alpha;
#pragma unroll
                for (int d = 0; d < 4; ++d)
#pragma unroll
                    for (int r = 0; r < 16; ++r) O[c][d][r] *= alpha;
            }
        }
#pragma unroll
        for (int c = 0; c < 2; ++c) {
            const float mm = mrun[c] - lt;
            float rs = 0.f;
#pragma unroll
            for (int r = 0; r < 16; ++r) { pp[c][r] = __builtin_amdgcn_exp2f(pp[c][r] - mm); rs += pp[c][r]; }
            lrun[c] += rs;
#pragma unroll
            for (int s = 0; s < 2; ++s) {
                u32x4 a;
                a.x = pk2(pp[c][8 * s + 0], pp[c][8 * s + 1]); a.y = pk2(pp[c][8 * s + 2], pp[c][8 * s + 3]); a.z = pk2(pp[c][8 * s + 4], pp[c][8 * s + 5]); a.w = pk2(pp[c][8 * s + 6], pp[c][8 * s + 7]);
                pf[c][s] = __builtin_bit_cast(bf16x8, a);
            }
        }
#pragma unroll
        for (int xs = 0; xs < 2; ++xs) { __builtin_amdgcn_sched_barrier(0);
            s16x4 vlo[4], vhi[4];
#pragma unroll
            for (int d = 0; d < 4; ++d) { vlo[d] = vtr(vb + (16 * xs) * VROW + d * 64); vhi[d] = vtr(vb + (16 * xs + 8) * VROW + d * 64); }
            __builtin_amdgcn_sched_barrier(0);
#pragma unroll
            for (int d = 0; d < 4; ++d) {
                const bf16x8 vf = {vlo[d][0], vlo[d][1], vlo[d][2], vlo[d][3], vhi[d][0], vhi[d][1], vhi[d][2], vhi[d][3]};
                O[0][d] = __builtin_amdgcn_mfma_f32_32x32x16_bf16(vf, pf[0][xs], O[0][d], 0, 0, 0);
                O[1][d] = __builtin_amdgcn_mfma_f32_32x32x16_bf16(vf, pf[1][xs], O[1][d], 0, 0, 0);
            }
        }
        if (i + 1 < NT) { const int nb = cur ^ 1; *(LAS u32x4*)(kst + nb * KBUF) = kr0; *(LAS u32x4*)(vst + nb * VBUF) = vr0; }
        __syncthreads();
    }
    const float l0 = lrun[0] + lane_xor(lrun[0], lane, 32), l1 = lrun[1] + lane_xor(lrun[1], lane, 32);
    const float i0 = 1.f / l0, i1 = lam / l1;
    float ss = 0.f;
#pragma unroll
    for (int d = 0; d < 4; ++d)
#pragma unroll
        for (int r = 0; r < 16; ++r) { const float o = O[0][d][r] * i0 - O[1][d][r] * i1; O[0][d][r] = o; ss += o * o; }
    ss += lane_xor(ss, lane, 32);
    const float rn = oscale / sqrtf(ss * (1.f / 128.f) + 1e-5f);
    bf16* yrow = YMIX + (size_t)(tok0 + qpos) * DM + 256 + head * 128;
#pragma unroll
    for (int d = 0; d < 4; ++d)
#pragma unroll
        for (int rg = 0; rg < 4; ++rg) { const int d0 = 32 * d + 8 * rg + 4 * hi; const f32x4 g4 = *(const f32x4*)(subg + d0);
            u32x2 w; w.x = pk2(O[0][d][4 * rg + 0] * rn * g4[0], O[0][d][4 * rg + 1] * rn * g4[1]); w.y = pk2(O[0][d][4 * rg + 2] * rn * g4[2], O[0][d][4 * rg + 3] * rn * g4[3]);
            *(u32x2*)(yrow + d0) = w; }
}
DEV void attn_phase(const Ctx& C, int l, LAS unsigned char* lds, int rep = 0) {
    const bf16* P = (const bf16*)(C.ws + WS_PROJ); bf16* Y = (bf16*)(C.ws + WS_YMIX);
    const float lam = ((const float*)(C.ws + WS_PAR))[1024 + l], li = ((const float*)(C.ws + WS_PAR))[1026 + l];
    const float* subg = C.in[19] + l * 128;
    const float* QN = (const float*)(C.ws + WS_NRM) + l * 320 * 8; const float* KN = (const float*)(C.ws + WS_NRM) + NRM_KN + l * 18 * 8;
    unsigned* qcnt = (unsigned*)(C.ws + WS_BAR) + 16 + 16 * l + 4 * rep;
    volatile LAS int* ubox = (volatile LAS int*)(lds + LDS_Q + 256 * KROW);
    for (;;) {
        if (C.tid == 0) ubox[0] = (int)__hip_atomic_fetch_add(qcnt, 1u, __ATOMIC_RELAXED, __HIP_MEMORY_SCOPE_AGENT);
        __syncthreads();
        const int u = ubox[0];
        if (u >= 1280) break;
        const int head = 3 - u / 320, r = u % 320;
        int tok0, S, qb, seq;
        if (r < 64) { seq = 16 + (r >> 5); qb = r & 31; tok0 = MP + (r >> 5) * SS; S = SS; }
        else { const int v = r - 64; seq = v >> 4; qb = v & 15; tok0 = seq * SP; S = SP; }
        const int blk = (tok0 >> 8) + qb;
        const float b0 = sqrtf(QN[blk * 8 + head * 2] * KN[seq * 8 + head * 2]), b1 = sqrtf(QN[blk * 8 + head * 2 + 1] * KN[seq * 8 + head * 2 + 1]);
        const float Bnd = 1.02f * fmaxf(b0, b1) + 0.5f;
        attn_unit(P, Y, tok0, S, head, qb, lam, 1.f - li, subg, Bnd, lds);
    }
}
}
DEV void grid_barrier(unsigned* bar, unsigned epoch, unsigned G) {
    asm volatile("s_waitcnt vmcnt(0)" ::: "memory");
    __syncthreads();
    if (threadIdx.x == 0) {
        __builtin_amdgcn_fence(__ATOMIC_RELEASE, "agent");
        asm volatile("s_waitcnt vmcnt(0)" ::: "memory");
        __hip_atomic_fetch_add(bar, 1u, __ATOMIC_RELAXED, __HIP_MEMORY_SCOPE_AGENT);
        const unsigned target = epoch * G;
        while (__hip_atomic_load(bar, __ATOMIC_RELAXED, __HIP_MEMORY_SCOPE_AGENT) < target) __builtin_amdgcn_s_sleep(2);
        __builtin_amdgcn_fence(__ATOMIC_ACQUIRE, "agent");
        asm volatile("s_waitcnt vmcnt(0)" ::: "memory");
    }
    __syncthreads();
}
#ifndef REP_ATT
#define REP_ATT 1
#endif
#ifndef REP_FFNUP
#define REP_FFNUP 1
#endif
#ifndef REP_DFT
#define REP_DFT 1
#endif
#ifndef REP_BAR
#define REP_BAR 1
#endif
#ifndef REP_FFNDN
#define REP_FFNDN 1
#endif
#ifndef REP_GATE
#define REP_GATE 1
#endif
#ifndef REP_OUT
#define REP_OUT 1
#endif
#ifndef REP_LN
#define REP_LN 1
#endif
#ifndef REP_PROJ
#define REP_PROJ 1
#endif
#ifndef REP_SCANA
#define REP_SCANA 1
#endif
#ifndef REP_SCANC
#define REP_SCANC 1
#endif
#ifndef REP_CONV
#define REP_CONV 1
#endif
#ifndef REP_BAR
#define REP_BAR 1
#endif
#ifndef REP_FFNDN
#define REP_FFNDN 1
#endif
#ifndef REP_GATE
#define REP_GATE 1
#endif
#ifndef REP_OUT
#define REP_OUT 1
#endif
#ifndef REP_LN
#define REP_LN 1
#endif
#ifndef REP_PRO
#define REP_PRO 1
#endif
struct Args { const float* in[21]; float* out; unsigned char* ws; int ph_lo, ph_hi; };
constexpr int NPHASES = 27;
__global__ void __launch_bounds__(512, 2) mk_fwd(Args a) {
    extern __shared__ __attribute__((aligned(16))) unsigned char lds_raw[];
    LAS unsigned char* lds = (LAS unsigned char*)lds_raw;
    cg::grid_group grid = cg::this_grid();
    Ctx C;
C.in = a.in; C.out = a.out; C.ws = a.ws; C.tid = threadIdx.x; C.lane = C.tid & 63; C.wave = __builtin_amdgcn_readfirstlane(C.tid >> 6); C.G = gridDim.x; C.bid = blockIdx.x;
    unsigned char* ws = a.ws;
    const int lo = a.ph_lo, hi = a.ph_hi;
    int ph = 0; unsigned epoch = 0;
#define PH_BEGIN if (ph >= lo && ph < hi) { { int t_ = threadIdx.x; asm volatile("" : "+v"(t_)); C.tid = t_; C.lane = t_ & 63; C.wave = __builtin_amdgcn_readfirstlane(t_ >> 6); size_t z_ = 0; asm volatile("" : "+s"(z_)); ws = a.ws + z_; C.ws = ws; C.out = a.out + z_;     int g_ = gridDim.x, b_ = blockIdx.x; asm volatile("" : "+s"(g_), "+s"(b_)); C.G = g_; C.bid = b_; }
#define PH_END   if (ph + 1 < hi) { for (int rb_ = 0; rb_ < REP_BAR; ++rb_) grid_barrier((unsigned*)(a.ws + WS_BAR), ++epoch, gridDim.x); } } ++ph;
#define XB ((bf16*)(ws + WS_XB))
#define H ((bf16*)(ws + WS_H))
#define PROJ ((bf16*)(ws + WS_PROJ))
#define YMIX ((bf16*)(ws + WS_YMIX))
    if (ph >= lo && ph < hi) { { int t_ = threadIdx.x; asm volatile("" : "+v"(t_)); C.tid = t_; C.lane = t_ & 63; C.wave = __builtin_amdgcn_readfirstlane(t_ >> 6); }
#ifndef NO_PRO
 for (int rep_ = 0; rep_ < REP_PRO; ++rep_) { phase_prologue(C, lds); __syncthreads(); }
#endif
 __syncthreads(); if (ph + 1 < hi) grid.sync(); } ++ph;
    for (int l = 0; l < 2; ++l) {
        for (int f = 0; f < 2; ++f) {
            if (f == 1) {
                PH_BEGIN
                { pg8::Gemm g{XB, (const bf16*)(ws + WS_WIN) + (size_t)l * 2048 * 1024, 1024, 1024, 1024, 0, 0}; pg8::StaticOrder S; S.init(MTOK, 2048, C.G, C.bid);
                  epi::Proj E{PROJ};
#ifndef NO_PROJ
 for (int rep_ = 0; rep_ < REP_PROJ; ++rep_) pg8::gemm_phase<epi::Proj, pg8::StaticOrder, true, true, 1024, 1024, 1024>(lds, g, S, E);
#endif
 }
                { pg8::Gemm g{(const bf16*)(ws + WS_WF) + (size_t)l * 512 * 1024, XB, 1024, 1024, 1024, 0, 0}; pg8::StaticOrder S; S.init(512, MTOK, C.G, C.bid);
                  epi::FT E{(bf16*)(ws + WS_BTF)};
#ifndef NO_FT
 for (int rep_ = 0; rep_ < REP_PROJ; ++rep_) pg8::gemm_phase<epi::FT, pg8::StaticOrder, true, true, 1024, 1024, 1024>(lds, g, S, E);
#endif
 }
                PH_END
                PH_BEGIN for (int rep_ = 0; rep_ < REP_CONV; ++rep_) phase_conv(C, l); PH_END
                PH_BEGIN
                { pg8::Gemm g{(const bf16*)(ws + WS_XC), (const bf16*)(ws + WS_WG) + (size_t)l * 1024 * 256, 256, 256, 256, 0, 0}; pg8::StaticOrder S; S.init(MTOK, 1024, C.G, C.bid);
                  epi::Raw E{(bf16*)(ws + WS_AU)};
#ifndef NO_GATE
 for (int rep_ = 0; rep_ < REP_GATE; ++rep_) pg8::gemm_phase<epi::Raw, pg8::StaticOrder, true, true, 256, 256, 256>(lds, g, S, E);
#endif
 }
                PH_END
                PH_BEGIN
#ifndef NO_SCANA
 for (int rep_ = 0; rep_ < REP_SCANA; ++rep_) phase_scan<false>(C, l, lds);
 __syncthreads();
#endif
                { pg8::Gemm g{(const bf16*)(ws + WS_DFT), (const bf16*)(ws + WS_BTF), 8192, 8192, 8192, 0, (size_t)256 * 8192}; epi::DftOrder S{C.G, C.bid};
                  epi::DFT E{YMIX, (float*)(ws + WS_PART), 0.001953125f  };
#ifndef NO_DFT
 for (int rep_ = 0; rep_ < REP_DFT; ++rep_) pg8::gemm_phase<epi::DFT, epi::DftOrder, true, true, 8192, 8192, 8192>(lds, g, S, E);
#endif
 }
#ifndef NO_ATT
 for (int rep_ = 0; rep_ < REP_ATT; ++rep_) att::attn_phase(C, l, lds, rep_);
#endif
 PH_END
                PH_BEGIN
phase_dft_combine(C);
#ifndef NO_SCANC
 for (int rep_ = 0; rep_ < REP_SCANC; ++rep_) phase_scan<true>(C, l, lds);
#endif
 PH_END
                PH_BEGIN
                { pg8::Gemm g{YMIX, (const bf16*)(ws + WS_WOUT) + (size_t)l * 1024 * 1024, 1024, 1024, 1024, 0, 0}; pg8::StaticOrder S; S.init(MTOK, 1024, C.G, C.bid); S.rev = 1;
                  epi::Resid E{C.out, 1.0f, (const float*)(ws + WS_STATS), C.in[2] + (l * 3 + 0) * 1024, C.in[3] + (l * 3 + 0) * 1024, C.out, C.out + (size_t)MP * DM};
#ifndef NO_OUT
 for (int rep_ = 1; rep_ < REP_OUT; ++rep_) { epi::Resid E0{C.out, 0.f, (const float*)(ws + WS_STATS), (const float*)(ws + WS_ONES), (const float*)(ws + WS_ONES) + 1024, C.out, C.out + (size_t)MP * DM, 1.f}; pg8::gemm_phase<epi::Resid, pg8::StaticOrder, true, true, 1024, 1024, 1024>(lds, g, S, E0); }
 pg8::gemm_phase<epi::Resid, pg8::StaticOrder, true, true, 1024, 1024, 1024>(lds, g, S, E);
#endif
 }
                PH_END
                PH_BEGIN for (int rep_ = 0; rep_ < REP_LN; ++rep_) phase_ln(C, C.in[2] + (l * 3 + 1) * 1024, C.in[3] + (l * 3 + 1) * 1024, false); PH_END
            }
            PH_BEGIN
            { pg8::Gemm g{XB, (const bf16*)(ws + WS_WGU) + (size_t)(l * 2 + f) * 5632 * 1024, 1024, 1024, 1024, 0, 0}; pg8::StaticOrder S; S.init(MTOK, 5632, C.G, C.bid);
              epi::SwiGLU E{H};
#ifndef NO_FFNUP
 for (int rep_ = 0; rep_ < REP_FFNUP; ++rep_) pg8::gemm_phase<epi::SwiGLU, pg8::StaticOrder, true, true, 1024, 1024, 1024>(lds, g, S, E);
#endif
 }
            PH_END
            PH_BEGIN
            { pg8::Gemm g{H, (const bf16*)(ws + WS_WD) + (size_t)(l * 2 + f) * 1024 * 2816, 2816, 2816, 2816, 0, 0}; pg8::StaticOrder S; S.init(MTOK, 1024, C.G, C.bid); S.rev = 1;
              const bool ident_ = (l == 0 && f == 0); const int pidx_ = f == 1 ? l * 3 + 1 : (l - 1) * 3 + 2;
              epi::Resid E{C.out, 0.5f, (const float*)(ws + WS_STATS), ident_ ? (const float*)(ws + WS_ONES) : C.in[2] + pidx_ * 1024, ident_ ? (const float*)(ws + WS_ONES) + 1024 : C.in[3] + pidx_ * 1024, ident_ ? C.in[0] : C.out, ident_ ? C.in[1] : C.out + (size_t)MP * DM};
#ifndef NO_FFNDN
 for (int rep_ = 1; rep_ < REP_FFNDN; ++rep_) { epi::Resid E0{C.out, 0.f, (const float*)(ws + WS_STATS), (const float*)(ws + WS_ONES), (const float*)(ws + WS_ONES) + 1024, C.out, C.out + (size_t)MP * DM, 1.f}; pg8::gemm_phase<epi::Resid, pg8::StaticOrder, true, true, 2816, 2816, 2816>(lds, g, S, E0); }
 pg8::gemm_phase<epi::Resid, pg8::StaticOrder, true, true, 2816, 2816, 2816>(lds, g, S, E);
#endif
 }
            PH_END
            PH_BEGIN for (int rep_ = 0; rep_ < ((l == 1 && f == 1) ? 1 : REP_LN); ++rep_) phase_ln(C, C.in[2] + (l * 3 + 2 * f) * 1024, C.in[3] + (l * 3 + 2 * f) * 1024, l == 1 && f == 1); PH_END
        }
    }
}

#ifndef MK_COOP
#define MK_COOP 1
#endif
extern "C" void kernel_launch(void* const* d_in, const int* in_sizes, int n_in, void* d_out, int out_size, void* d_ws, size_t ws_size, hipStream_t stream) {
    static int grid = 0;
    if (grid == 0) {
        if (n_in != 21 || out_size != MTOK * DM || ws_size < WS_END) { fprintf(stderr, "kernel_launch: unexpected shapes (n_in %d out %d ws %zu)\n", n_in, out_size, ws_size); grid = -1; return; }
        int dev = 0, cus = 0, per_cu = 0;
        hipGetDevice(&dev); hipDeviceGetAttribute(&cus, hipDeviceAttributeMultiprocessorCount, dev);
        hipFuncSetAttribute((const void*)mk_fwd, hipFuncAttributeMaxDynamicSharedMemorySize, LDS_BYTES);
        hipOccupancyMaxActiveBlocksPerMultiprocessor(&per_cu, (const void*)mk_fwd, 512, LDS_BYTES);
        (void)hipGetLastError();
        if (per_cu < 1) per_cu = 1;
        grid = cus;
    }
    if (grid < 0) return;
    if (MK_COOP) (void)hipMemsetAsync((char*)d_ws + WS_BAR, 0, 256, stream);
    Args a{};
    for (int i = 0; i < 21; ++i) a.in[i] = (const float*)d_in[i];
    a.out = (float*)d_out; a.ws = (unsigned char*)d_ws;
#if MK_COOP
    a.ph_lo = 0; a.ph_hi = NPHASES;
    void* args[] = {&a};
    hipError_t e = hipLaunchCooperativeKernel((const void*)mk_fwd, dim3(grid), dim3(512), args, LDS_BYTES, stream);
    if (e != hipSuccess) fprintf(stderr, "cooperative launch failed: %s (grid %d)\n", hipGetErrorString(e), grid);
#else
    for (int p = 0; p < NPHASES; ++p) { a.ph_lo = p; a.ph_hi = p + 1; hipLaunchKernelGGL(mk_fwd, dim3(grid), dim3(512), LDS_BYTES, stream, a); }
#endif
}
```
